# Optimizing an MI355X kernel written in HIP

```python
import math
import jax, jax.numpy as jnp
from jax import lax
import numpy as np

D_MODEL = 2048
BATCH = 4
SEQ = 4096
DEPTH = 2

N_EVEN = (DEPTH + 1) // 2
N_ODD = DEPTH // 2
EPS = 1e-6
D_FF = 5632

A_WIDTH = D_MODEL // 2
A_CHUNK = 128
A_GROUPS = 8
A_GROUP_DIM = A_WIDTH // A_GROUPS

B_HEADS = 4
B_WIDTH = D_MODEL // 2
B_HEAD_DIM = B_WIDTH // B_HEADS
B_CHUNK = 128
B_CONV = 4

P_AB = 2 * A_WIDTH + 4 * B_WIDTH + 2 * B_HEADS

C_HEADS = 16
C_KV = 4
C_REP = C_HEADS // C_KV
C_HEAD_DIM = D_MODEL // C_HEADS
CMP_LEN = 32
CMP_STRIDE = 16
SEL_LEN = 64
SEL_TOPK = 16
WINDOW = 512
C_QBLOCK = 32
P_C = C_HEADS * C_HEAD_DIM + 3 * 2 * C_KV * C_HEAD_DIM + 3 * C_HEADS

ROPE_THETA = 500000.0
ROPE_DIMS = C_HEAD_DIM // 4

NEG_INF = -1e30
BIG = 1e9

kernel_name = "hybrid_gmlp_mlstm_nsa_macaron"


def rmsnorm(x, g):
    xf = x.astype(jnp.float32)
    y = xf * lax.rsqrt(jnp.mean(xf * xf, axis=-1, keepdims=True) + EPS)
    return (y * g.astype(jnp.float32)).astype(x.dtype)


def swiglu(x, w_gate, w_up, w_down):
    return (jax.nn.silu(x @ w_gate) * (x @ w_up)) @ w_down


def partial_rope(x):
    S = x.shape[1]
    half = ROPE_DIMS // 2
    inv = 1.0 / (ROPE_THETA ** (jnp.arange(half, dtype=jnp.float32) / half))
    ang = jnp.arange(S, dtype=jnp.float32)[:, None] * inv[None, :]
    cos = jnp.cos(ang)[None, :, None, :]
    sin = jnp.sin(ang)[None, :, None, :]
    xr = x[..., :ROPE_DIMS].astype(jnp.float32)
    x1, x2 = xr[..., :half], xr[..., half:]
    rot = jnp.concatenate([x1 * cos - x2 * sin, x1 * sin + x2 * cos], axis=-1).astype(x.dtype)
    return jnp.concatenate([rot, x[..., ROPE_DIMS:]], axis=-1)


def causal_depthwise_conv(x, w):
    K, C = w.shape
    return lax.conv_general_dilated(x, w[:, None, :].astype(x.dtype), window_strides=(1,),
                                    padding=[(K - 1, 0)], dimension_numbers=('NWC', 'WIO', 'NWC'),
                                    feature_group_count=C)


def masked_softmax(s, valid):
    p = jax.nn.softmax(jnp.where(valid, s, NEG_INF), axis=-1)
    return jnp.where(valid, p, 0.0)


def gmlp_chunk_gating(z, norm_g, w_s, b_s):
    B_, S, _ = z.shape
    z = jax.nn.gelu(z)
    u, v = jnp.split(z, 2, axis=-1)
    v = rmsnorm(v, norm_g)
    nc = S // A_CHUNK
    v = v.reshape(B_, nc, A_CHUNK, A_GROUPS, A_GROUP_DIM)
    mask = jnp.tril(jnp.ones((A_CHUNK, A_CHUNK), dtype=bool))
    w = jnp.where(mask, w_s, 0.0).astype(v.dtype)
    sv = jnp.einsum('gts,bcsge->bctge', w, v) + b_s.T.astype(v.dtype)[None, None, :, :, None]
    return u * sv.reshape(B_, S, A_WIDTH)


def mlstm_chunkwise(q, k, v, i_pre, f_pre):
    B_, S, H, d = q.shape
    L = B_CHUNK
    nc = S // L
    f32 = jnp.float32
    def chunks(a):
        return a.astype(f32).reshape(B_, nc, L, H, d).transpose(1, 0, 3, 2, 4)
    def gchunks(a):
        return a.astype(f32).reshape(B_, nc, L, H).transpose(1, 0, 3, 2)
    qc, kc, vc = chunks(q), chunks(k) * (d ** -0.5), chunks(v)
    ic, lfc = gchunks(i_pre), gchunks(jax.nn.log_sigmoid(f_pre.astype(f32)))
    causal = jnp.tril(jnp.ones((L, L), dtype=bool))

    def step(carry, inp):
        C, n, m = carry
        qb, kb, vb, ib, lfb = inp
        b = jnp.cumsum(lfb, axis=-1)
        logD = jnp.where(causal, b[..., :, None] - b[..., None, :] + ib[..., None, :], -jnp.inf)
        inter = b + m[..., None]
        m_t = jnp.maximum(jnp.max(logD, axis=-1), inter)
        Dm = jnp.exp(logD - m_t[..., None])
        w_inter = jnp.exp(inter - m_t)
        s = jnp.einsum('bhtd,bhsd->bhts', qb, kb) * Dm
        num = jnp.einsum('bhts,bhse->bhte', s, vb) + w_inter[..., None] * jnp.einsum('bhed,bhtd->bhte', C, qb)
        den = jnp.sum(s, axis=-1) + w_inter * jnp.einsum('bhd,bhtd->bht', n, qb)
        h = num / jnp.maximum(jnp.abs(den), jnp.exp(-m_t))[..., None]
        m_new = m_t[..., -1]
        w_s = jnp.exp(b[..., -1:] - b + ib - m_new[..., None])
        w_prev = jnp.exp(b[..., -1] + m - m_new)
        C_new = w_prev[..., None, None] * C + jnp.einsum('bhs,bhse,bhsd->bhed', w_s, vb, kb)
        n_new = w_prev[..., None] * n + jnp.einsum('bhs,bhsd->bhd', w_s, kb)
        return (C_new, n_new, m_new), h

    init = (jnp.zeros((B_, H, d, d), f32), jnp.zeros((B_, H, d), f32), jnp.zeros((B_, H), f32))
    _, hs = lax.scan(step, init, (qc, kc, vc, ic, lfc))
    return hs.transpose(1, 0, 3, 2, 4).reshape(B_, S, H, d)


def gmlp_mlstm_mixer(h, w_in, gate_b, g_norm, g_ws, g_bs, conv_w, m_norm, w_out):
    B_, S, _ = h.shape
    p = h @ w_in
    o1 = 2 * A_WIDTH
    o2 = o1 + 2 * B_WIDTH
    o3 = o2 + B_WIDTH
    o4 = o3 + B_WIDTH
    z_a, qk, v, o, gates = jnp.split(p, [o1, o2, o3, o4], axis=-1)
    y_a = gmlp_chunk_gating(z_a, g_norm, g_ws, g_bs)
    qk = jax.nn.silu(causal_depthwise_conv(qk, conv_w))
    q, k = jnp.split(qk, 2, axis=-1)
    gates = gates.reshape(B_, S, 2, B_HEADS) + gate_b.astype(gates.dtype)
    shp = (B_, S, B_HEADS, B_HEAD_DIM)
    ht = mlstm_chunkwise(q.reshape(shp), k.reshape(shp), v.reshape(shp), gates[:, :, 0], gates[:, :, 1])
    ht = rmsnorm(ht, m_norm.reshape(B_HEADS, B_HEAD_DIM)).reshape(B_, S, B_WIDTH)
    y_b = (jax.nn.sigmoid(o.astype(jnp.float32)) * ht).astype(h.dtype)
    return jnp.concatenate([y_a, y_b], axis=-1) @ w_out


def compress_blocks(x, pos_emb, w1, w2):
    B_, S, G, dh = x.shape
    n_cmp = (S - CMP_LEN) // CMP_STRIDE + 1
    idx = jnp.arange(n_cmp)[:, None] * CMP_STRIDE + jnp.arange(CMP_LEN)[None, :]
    blocks = x[:, idx] + pos_emb.astype(x.dtype)[None, None, :, None, :]
    flat = blocks.transpose(0, 1, 3, 2, 4).reshape(B_, n_cmp, G, CMP_LEN * dh)
    return jax.nn.gelu(flat @ w1) @ w2


def gather_blocks(blocks, idx):
    return jax.vmap(jax.vmap(lambda bl, ix: bl[ix]))(blocks, idx)


def nsa_mixer(h, w_in, cmp_pos, cmp_w1, cmp_w2, w_out):
    B_, S, _ = h.shape
    G, R, dh = C_KV, C_REP, C_HEAD_DIM
    f32 = jnp.float32
    p = h @ w_in
    q, kvs, g = jnp.split(p, [C_HEADS * dh, C_HEADS * dh + 6 * G * dh], axis=-1)
    q = partial_rope(q.reshape(B_, S, C_HEADS, dh)) * (dh ** -0.5)
    kvs = kvs.reshape(B_, S, 3, 2, G, dh)
    gates = jax.nn.sigmoid(g.astype(f32)).reshape(B_, S, 3, G, R).astype(h.dtype)

    k_cmp = compress_blocks(partial_rope(kvs[:, :, 0, 0]), cmp_pos[0], cmp_w1[0], cmp_w2[0])
    v_cmp = compress_blocks(kvs[:, :, 0, 1], cmp_pos[1], cmp_w1[1], cmp_w2[1])
    n_cmp = k_cmp.shape[1]
    cmp_end = jnp.arange(n_cmp) * CMP_STRIDE + CMP_LEN - 1

    n_slc = S // SEL_LEN
    n_top = min(SEL_TOPK, n_slc)
    k_sel = partial_rope(kvs[:, :, 1, 0]).reshape(B_, n_slc, SEL_LEN, G, dh).transpose(0, 3, 1, 2, 4)
    v_sel = kvs[:, :, 1, 1].reshape(B_, n_slc, SEL_LEN, G, dh).transpose(0, 3, 1, 2, 4)
    ci = jnp.arange(n_cmp)[:, None] * CMP_STRIDE
    sj = jnp.arange(n_slc)[None, :] * SEL_LEN
    overlap = jnp.clip(jnp.minimum(ci + CMP_LEN, sj + SEL_LEN) - jnp.maximum(ci, sj), 0).astype(f32) / CMP_LEN
    blk = jnp.arange(n_slc)

    pad = ((0, 0), (WINDOW, 0), (0, 0), (0, 0))
    k_win = jnp.pad(partial_rope(kvs[:, :, 2, 0]), pad)
    v_win = jnp.pad(kvs[:, :, 2, 1], pad)

    def q_block(i):
        t0 = i * C_QBLOCK
        pos = t0 + jnp.arange(C_QBLOCK)
        qb = lax.dynamic_slice_in_dim(q, t0, C_QBLOCK, axis=1).reshape(B_, C_QBLOCK, G, R, dh)
        gb = lax.dynamic_slice_in_dim(gates, t0, C_QBLOCK, axis=1)
        s_c = jnp.einsum('bqgrd,bcgd->bgrqc', qb, k_cmp).astype(f32)
        p_c = masked_softmax(s_c, cmp_end[None, :] <= pos[:, None])
        o_c = jnp.einsum('bgrqc,bcgd->bqgrd', p_c.astype(v_cmp.dtype), v_cmp)
        imp = jnp.einsum('bgrqc,cj->bgqj', p_c, overlap)
        cur = pos // SEL_LEN
        forced = (blk[None, :] == 0) | (blk[None, :] == cur[:, None]) | (blk[None, :] == cur[:, None] - 1)
        future = blk[None, :] > cur[:, None]
        imp = jnp.where(forced, BIG, jnp.where(future, -BIG, imp))
        _, top = lax.top_k(imp, n_top)
        ks = gather_blocks(k_sel, top).reshape(B_, G, C_QBLOCK, n_top * SEL_LEN, dh)
        vs = gather_blocks(v_sel, top).reshape(B_, G, C_QBLOCK, n_top * SEL_LEN, dh)
        tok = (top[..., None] * SEL_LEN + jnp.arange(SEL_LEN)).reshape(B_, G, C_QBLOCK, n_top * SEL_LEN)
        valid_s = (tok <= pos[None, None, :, None])[:, :, None]
        s_s = jnp.einsum('bqgrd,bgqnd->bgrqn', qb, ks).astype(f32)
        p_s = masked_softmax(s_s, valid_s)
        o_s = jnp.einsum('bgrqn,bgqnd->bqgrd', p_s.astype(vs.dtype), vs)
        kw = lax.dynamic_slice_in_dim(k_win, t0, WINDOW + C_QBLOCK, axis=1)
        vw = lax.dynamic_slice_in_dim(v_win, t0, WINDOW + C_QBLOCK, axis=1)
        kpos = t0 - WINDOW + jnp.arange(WINDOW + C_QBLOCK)
        valid_w = (kpos[None, :] <= pos[:, None]) & (pos[:, None] - kpos[None, :] < WINDOW) & (kpos[None, :] >= 0)
        s_w = jnp.einsum('bqgrd,bkgd->bgrqk', qb, kw).astype(f32)
        p_w = masked_softmax(s_w, valid_w)
        o_w = jnp.einsum('bgrqk,bkgd->bqgrd', p_w.astype(vw.dtype), vw)
        out = gb[:, :, 0, :, :, None] * o_c + gb[:, :, 1, :, :, None] * o_s + gb[:, :, 2, :, :, None] * o_w
        return out.reshape(B_, C_QBLOCK, C_HEADS * dh)

    outs = lax.map(q_block, jnp.arange(S // C_QBLOCK))
    y = outs.transpose(1, 0, 2, 3).reshape(B_, S, C_HEADS * dh)
    return y @ w_out


def setup_inputs(seed: int = 0) -> dict:
    key = jax.random.key(seed)
    ks = jax.random.split(key, 24)
    nrm = lambda k, shape, s: jax.random.normal(k, shape, jnp.float32) * s
    f_bias = jnp.broadcast_to(jnp.linspace(3.0, 6.0, B_HEADS, dtype=jnp.float32), (N_EVEN, B_HEADS))
    return {
        "x": nrm(ks[0], (BATCH, SEQ, D_MODEL), 1.0),
        "ffn_norm": 1.0 + nrm(ks[1], (DEPTH, 2, D_MODEL), 0.01),
        "ffn_w_gate": nrm(ks[2], (DEPTH, 2, D_MODEL, D_FF), D_MODEL ** -0.5),
        "ffn_w_up": nrm(ks[3], (DEPTH, 2, D_MODEL, D_FF), D_MODEL ** -0.5),
        "ffn_w_down": nrm(ks[4], (DEPTH, 2, D_FF, D_MODEL), D_FF ** -0.5),
        "mix_norm": 1.0 + nrm(ks[5], (DEPTH, D_MODEL), 0.01),
        "ab_w_in": nrm(ks[6], (N_EVEN, D_MODEL, P_AB), D_MODEL ** -0.5),
        "mlstm_gate_bias": jnp.stack([nrm(ks[7], (N_EVEN, B_HEADS), 0.1),
                                      f_bias + nrm(ks[8], (N_EVEN, B_HEADS), 0.1)], axis=1),
        "gmlp_norm": 1.0 + nrm(ks[9], (N_EVEN, A_WIDTH), 0.01),
        "gmlp_w_s": nrm(ks[10], (N_EVEN, A_GROUPS, A_CHUNK, A_CHUNK), A_CHUNK ** -0.5),
        "gmlp_b_s": 1.0 + nrm(ks[11], (N_EVEN, A_GROUPS, A_CHUNK), 0.02),
        "mlstm_conv": nrm(ks[12], (N_EVEN, B_CONV, 2 * B_WIDTH), B_CONV ** -0.5),
        "mlstm_norm": 1.0 + nrm(ks[13], (N_EVEN, B_WIDTH), 0.01),
        "ab_w_out": nrm(ks[14], (N_EVEN, A_WIDTH + B_WIDTH, D_MODEL), (A_WIDTH + B_WIDTH) ** -0.5),
        "nsa_w_in": nrm(ks[15], (N_ODD, D_MODEL, P_C), D_MODEL ** -0.5),
        "nsa_cmp_pos": nrm(ks[16], (N_ODD, 2, CMP_LEN, C_HEAD_DIM), 0.02),
        "nsa_cmp_w1": nrm(ks[17], (N_ODD, 2, CMP_LEN * C_HEAD_DIM, C_HEAD_DIM), (CMP_LEN * C_HEAD_DIM) ** -0.5),
        "nsa_cmp_w2": nrm(ks[18], (N_ODD, 2, C_HEAD_DIM, C_HEAD_DIM), C_HEAD_DIM ** -0.5),
        "nsa_w_out": nrm(ks[19], (N_ODD, C_HEADS * C_HEAD_DIM, D_MODEL), (C_HEADS * C_HEAD_DIM) ** -0.5),
        "final_norm": 1.0 + nrm(ks[20], (D_MODEL,), 0.01),
    }


def reference(x, ffn_norm, ffn_w_gate, ffn_w_up, ffn_w_down, mix_norm, ab_w_in, mlstm_gate_bias,
              gmlp_norm, gmlp_w_s, gmlp_b_s, mlstm_conv, mlstm_norm, ab_w_out, nsa_w_in, nsa_cmp_pos,
              nsa_cmp_w1, nsa_cmp_w2, nsa_w_out, final_norm):
    h = x
    for layer in range(DEPTH):
        j = layer // 2
        h = h + 0.5 * swiglu(rmsnorm(h, ffn_norm[layer, 0]), ffn_w_gate[layer, 0], ffn_w_up[layer, 0], ffn_w_down[layer, 0])
        hn = rmsnorm(h, mix_norm[layer])
        if layer % 2 == 0:
            h = h + gmlp_mlstm_mixer(hn, ab_w_in[j], mlstm_gate_bias[j], gmlp_norm[j], gmlp_w_s[j], gmlp_b_s[j],
                                     mlstm_conv[j], mlstm_norm[j], ab_w_out[j])
        else:
            h = h + nsa_mixer(hn, nsa_w_in[j], nsa_cmp_pos[j], nsa_cmp_w1[j], nsa_cmp_w2[j], nsa_w_out[j])
        h = h + 0.5 * swiglu(rmsnorm(h, ffn_norm[layer, 1]), ffn_w_gate[layer, 1], ffn_w_up[layer, 1], ffn_w_down[layer, 1])
    return rmsnorm(h, final_norm)
```

```cpp
#include <hip/hip_runtime.h>
#include <hip/hip_cooperative_groups.h>
#include <cstdio>
namespace cg = cooperative_groups;
namespace pg8 {
#define PG8_LAS __attribute__((address_space(3)))
typedef unsigned short bf16_t;
typedef short bf16x8 __attribute__((ext_vector_type(8)));
typedef float f32x4 __attribute__((ext_vector_type(4)));
typedef unsigned u32x4 __attribute__((ext_vector_type(4)));
constexpr int BM = 256, BK = 64, HALF = 128, HTB = HALF * BK * 2  , STAGE_BYTES = 8 * HTB, NXCD = 8, WGM = 8;

__host__ __device__ __forceinline__ int lds_byte(int r, int c) { const int st = (r >> 4) * 2 + (c >> 5), rr = r & 15, cc = c & 31, ob = rr * 64 + cc * 2; return st * 1024 + (ob ^ (((ob >> 9) & 1) << 5)); }
__host__ __device__ __forceinline__ void stage_rc(int b, int& R, int& C) { const int st = b / 1024, sb = b % 1024, swz = sb ^ (((sb >> 9) & 1) << 5); R = (st >> 1) * 16 + swz / 64; C = (st & 1) * 32 + (swz % 64) / 2; }
__host__ __device__ __forceinline__ int perm32(int rho) { const int n = rho >> 4, i = rho & 15; return 8 * (i >> 2) + 4 * n + (i & 3); }

struct Unit { int pm, pn; };
struct Gemm { const bf16_t* A; const bf16_t* Bt; int M, N, K; };

struct StaticOrder {
    int nM, nN, nwg, G, c;
    __host__ __device__ void init(int M, int N, int G_, int c_) { nM = M / BM; nN = N / BM; nwg = nM * nN; G = G_; c = c_; }
    __host__ __device__ bool next(int i, Unit& u) const {
        const long L = (long)i * G + c; if (L >= nwg) return false;
        int wgid = (int)L; { const int q = nwg / NXCD, r = nwg % NXCD, xcd = wgid % NXCD, off = wgid / NXCD; wgid = (xcd < r ? xcd * (q + 1) : r * (q + 1) + (xcd - r) * q) + off; }
        const int nig = WGM * nN, gid = wgid / nig, fm = gid * WGM, gsz = (nM - fm) < WGM ? (nM - fm) : WGM;
        u.pm = fm + ((wgid % nig) % gsz); u.pn = (wgid % nig) / gsz; return true;
    }
    __device__ __forceinline__ void a_ready(const Unit&) const {}
    __device__ __forceinline__ void done(const Unit&) const {}
};
template <class Epi, class Sched, bool STAMP = false>
__device__ __forceinline__ void gemm_phase(PG8_LAS unsigned char* lds, const Gemm g, const Sched& S, const Epi& E, unsigned long long* stamps) {
    int tid_ = threadIdx.x; asm volatile("" : "+v"(tid_)); const int tid = tid_, wid = __builtin_amdgcn_readfirstlane(tid >> 6), lane = tid & 63, wr = wid >> 2, wc = wid & 3, fr = lane & 15, fq = lane >> 4;
    const int K = g.K, nt = K / BK;
#define PG8_STAMP() do {} while (0)
    PG8_STAMP();
    unsigned voffA[2], voffB[2];
#pragma unroll
    for (int i = 0; i < 2; ++i) { int R, C; stage_rc(tid * 16 + i * 8192, R, C); const int Rb = Epi::PERM ? ((R & ~31) + perm32(R & 31)) : R;
        voffA[i] = (unsigned)(R * K + C) * 2u; voffB[i] = (unsigned)(Rb * K + C) * 2u; }
    const size_t kstep = (size_t)(BK * 2);
    const size_t hstep = (size_t)HALF * K * 2;
    const size_t tstep = 2 * hstep;
    const unsigned ldsw = (unsigned)wid * 1024u;
    const int aoff = lds_byte(wr * 64 + fr, fq * 8), boff = lds_byte(wc * 32 + fr, fq * 8);
#define PG8_SA(b, h) (((b) * 2 + (h)) * HTB)
#define PG8_SB(b, h) ((4 + (b) * 2 + (h)) * HTB)
#define PG8_STAGE(bufoff, gbase, voff) do { _Pragma("unroll") for (int _i = 0; _i < 2; ++_i) \
        __builtin_amdgcn_global_load_lds((const unsigned*)((const char*)(gbase) + (voff)[_i]), (PG8_LAS unsigned*)(lds + (bufoff) + ldsw + _i * 8192), 16, 0, 0); } while (0)
#define PG8_LDA(dst, b, h) do { _Pragma("unroll") for (int m = 0; m < 4; ++m) _Pragma("unroll") for (int k = 0; k < 2; ++k) dst[m][k] = *(const PG8_LAS bf16x8*)(lds + PG8_SA(b, h) + aoff + m * 2048 + k * 1024); } while (0)
#define PG8_LDB(dst, b, h) do { _Pragma("unroll") for (int n = 0; n < 2; ++n) _Pragma("unroll") for (int k = 0; k < 2; ++k) dst[n][k] = *(const PG8_LAS bf16x8*)(lds + PG8_SB(b, h) + boff + n * 2048 + k * 1024); } while (0)
#define PG8_MMA(ai, bj, At, Bt) do { __builtin_amdgcn_s_setprio(1); _Pragma("unroll") for (int m = 0; m < 4; ++m) _Pragma("unroll") for (int n = 0; n < 2; ++n) _Pragma("unroll") for (int k = 0; k < 2; ++k) \
        acc[ai][bj][m][n] = __builtin_amdgcn_mfma_f32_16x16x32_bf16(Bt[n][k], At[m][k], acc[ai][bj][m][n], 0, 0, 0); __builtin_amdgcn_s_setprio(0); } while (0)
#define PG8_WAIT_V(n) asm volatile("s_waitcnt vmcnt(" #n ")" ::: "memory")
#define PG8_WAIT_L(n) asm volatile("s_waitcnt lgkmcnt(" #n ")" ::: "memory")
#define PG8_BAR __builtin_amdgcn_s_barrier()
#define PG8_SCHED __builtin_amdgcn_sched_barrier(0)
    Unit cur, nxt; int ui = 0;
    if (!S.next(0, cur)) return;
    f32x4 acc[2][2][4][2];
#pragma unroll
    for (int a = 0; a < 2; ++a)
#pragma unroll
        for (int b = 0; b < 2; ++b)
#pragma unroll
            for (int m = 0; m < 4; ++m)
#pragma unroll
                for (int n = 0; n < 2; ++n) acc[a][b][m][n] = (f32x4){0.f, 0.f, 0.f, 0.f};
    bf16x8 At[4][2], B0[2][2], B1[2][2];
    const char* cA = (const char*)g.A + (size_t)cur.pm * tstep; const char* cB = (const char*)g.Bt + (size_t)cur.pn * tstep;
    S.a_ready(cur);
    PG8_STAGE(PG8_SB(0, 0), cB, voffB); PG8_STAGE(PG8_SA(0, 0), cA, voffA); PG8_STAGE(PG8_SB(0, 1), cB + hstep, voffB); PG8_STAGE(PG8_SA(0, 1), cA + hstep, voffA);
    if (wr == 1) PG8_BAR;
    PG8_WAIT_V(4); PG8_BAR;
    PG8_STAGE(PG8_SB(1, 0), cB + kstep, voffB); PG8_STAGE(PG8_SA(1, 0), cA + kstep, voffA); PG8_STAGE(PG8_SB(1, 1), cB + hstep + kstep, voffB);
    PG8_WAIT_V(6); PG8_BAR;
    PG8_STAMP();
    for (;;) {
        const bool has_next = S.next(ui + 1, nxt);
        const char* nA = has_next ? (const char*)g.A + (size_t)nxt.pm * tstep : cA; const char* nB = has_next ? (const char*)g.Bt + (size_t)nxt.pn * tstep : cB;
        for (int t = 0; t < nt; t += 2) {
            const bool last = (t == nt - 2);
            const char* a1 = cA + (size_t)(t + 1) * kstep;
            const char* a2 = last ? nA : cA + (size_t)(t + 2) * kstep; const char* b2 = last ? nB : cB + (size_t)(t + 2) * kstep;
            const char* a3 = a2 + kstep; const char* b3 = b2 + kstep;
            if (last && has_next) S.a_ready(nxt);
            PG8_LDB(B0, 0, 0); PG8_SCHED; PG8_LDA(At, 0, 0); PG8_STAGE(PG8_SA(1, 1), a1 + hstep, voffA);
            PG8_WAIT_L(8); PG8_BAR; PG8_WAIT_L(0); PG8_MMA(0, 0, At, B0); PG8_BAR; PG8_SCHED;
            PG8_LDB(B1, 0, 1); PG8_STAGE(PG8_SB(0, 0), b2, voffB);
            PG8_BAR; PG8_WAIT_L(0); PG8_MMA(0, 1, At, B1); PG8_BAR;
            PG8_LDA(At, 0, 1); PG8_STAGE(PG8_SA(0, 0), a2, voffA);
            PG8_BAR; PG8_WAIT_L(0); PG8_MMA(1, 0, At, B0); PG8_BAR; PG8_SCHED;
            PG8_STAGE(PG8_SB(0, 1), b2 + hstep, voffB);
            PG8_WAIT_V(6); PG8_BAR; PG8_MMA(1, 1, At, B1); PG8_BAR;
            PG8_LDB(B0, 1, 0); PG8_SCHED; PG8_LDA(At, 1, 0); PG8_STAGE(PG8_SA(0, 1), a2 + hstep, voffA);
            PG8_WAIT_L(8); PG8_BAR; PG8_WAIT_L(0); PG8_MMA(0, 0, At, B0); PG8_BAR; PG8_SCHED;
            PG8_LDB(B1, 1, 1); PG8_STAGE(PG8_SB(1, 0), b3, voffB);
            PG8_BAR; PG8_WAIT_L(0); PG8_MMA(0, 1, At, B1); PG8_BAR;
            PG8_LDA(At, 1, 1); PG8_STAGE(PG8_SA(1, 0), a3, voffA);
            PG8_BAR; PG8_WAIT_L(0); PG8_MMA(1, 0, At, B0); PG8_BAR; PG8_SCHED;
            PG8_STAGE(PG8_SB(1, 1), b3 + hstep, voffB);
            PG8_WAIT_V(6); PG8_BAR; PG8_MMA(1, 1, At, B1); PG8_BAR;
        }
        PG8_STAMP();
        if constexpr (!Epi::AFTER_DRAIN) { E(acc, cur, wr, wc, fr, fq); S.done(cur); }
        PG8_STAMP();
        if (!has_next) break;
#pragma unroll
        for (int a = 0; a < 2; ++a)
#pragma unroll
            for (int b = 0; b < 2; ++b)
#pragma unroll
                for (int m = 0; m < 4; ++m)
#pragma unroll
                    for (int n = 0; n < 2; ++n) acc[a][b][m][n] = (f32x4){0.f, 0.f, 0.f, 0.f};
        cur = nxt; cA = nA; cB = nB; ++ui;
    }
    PG8_WAIT_V(0);
    if (wr == 0) PG8_BAR;
    PG8_BAR;
    if constexpr (Epi::AFTER_DRAIN) { E.fused(acc, cur, wr, wc, fr, fq, lds, wid, lane); S.done(cur); }
    PG8_STAMP();
#undef PG8_STAMP
#undef PG8_SA
#undef PG8_SB
#undef PG8_STAGE
#undef PG8_LDA
#undef PG8_LDB
#undef PG8_MMA
#undef PG8_WAIT_V
#undef PG8_WAIT_L
#undef PG8_BAR
#undef PG8_SCHED
}
}
using pg8::bf16_t; using pg8::bf16x8; using pg8::f32x4; using pg8::u32x4; using pg8::Unit;
#define LAS __attribute__((address_space(3)))
typedef unsigned u32x2 __attribute__((ext_vector_type(2)));

constexpr int MTOK = 16384, DM = 2048, DFF = 5632, SEQL = 4096;
constexpr float EPSN = 1e-6f;

struct Params { const float* in[20]; float* out; unsigned char* ws; int ph_lo, ph_hi; };

constexpr size_t SZ_GU = (size_t)11264 * 2048 * 2, SZ_DN = (size_t)2048 * 5632 * 2;
constexpr size_t OFF_WGU = 0;
constexpr size_t OFF_WDN = OFF_WGU + 4 * SZ_GU;
constexpr size_t OFF_WABIN = OFF_WDN + 4 * SZ_DN;
constexpr size_t OFF_WABOUT = OFF_WABIN + (size_t)6208 * 2048 * 2;
constexpr size_t OFF_WNSAIN = OFF_WABOUT + (size_t)2048 * 2048 * 2;
constexpr size_t OFF_WNSAOUT = OFF_WNSAIN + (size_t)5184 * 2048 * 2;
constexpr size_t OFF_WC1 = OFF_WNSAOUT + (size_t)2048 * 2048 * 2;
constexpr size_t OFF_WC2 = OFF_WC1 + (size_t)2 * 128 * 4096 * 2;
constexpr size_t OFF_ABUF = OFF_WC2 + (size_t)2 * 128 * 128 * 2;
constexpr size_t OFF_BIG = OFF_ABUF + (size_t)MTOK * 2048 * 2;
constexpr size_t OFF_AUX1 = OFF_BIG + (size_t)MTOK * 6144 * 2 + 262144;
constexpr size_t OFF_AUX2 = OFF_AUX1 + (size_t)MTOK * 2048 * 2;
constexpr size_t OFF_KT = OFF_AUX2 + (size_t)MTOK * 1024 * 4;
constexpr size_t OFF_GATES = OFF_KT + (size_t)MTOK * 1024 * 2;
constexpr size_t OFF_ROPE = OFF_GATES + (size_t)MTOK * 48 * 4;
constexpr size_t OFF_KCMP = OFF_ROPE + (size_t)4096 * 32 * 4;
constexpr size_t OFF_VCMPT = OFF_KCMP + (size_t)16 * 256 * 128 * 2;
constexpr size_t WS_END = OFF_VCMPT + (size_t)16 * 128 * 256 * 2;

__device__ __forceinline__ int otid() { int t = threadIdx.x; asm volatile("" : "+v"(t)); return t; }
__device__ __forceinline__ unsigned f2bf(float f) { unsigned u = __float_as_uint(f); u += 0x7FFFu + ((u >> 16) & 1u); return u >> 16; }
__device__ __forceinline__ unsigned pack2(float a, float b) { return f2bf(a) | (f2bf(b) << 16); }
__device__ __forceinline__ float bflo(unsigned u) { return __uint_as_float(u << 16); }
__device__ __forceinline__ float bfhi(unsigned u) { return __uint_as_float(u & 0xFFFF0000u); }
__device__ __forceinline__ float bfs(short s) { return __uint_as_float(((unsigned)(unsigned short)s) << 16); }
__device__ __forceinline__ f32x4 mfma16(bf16x8 x, bf16x8 y, f32x4 c) { return __builtin_amdgcn_mfma_f32_16x16x32_bf16(x, y, c, 0, 0, 0); }
__device__ __forceinline__ bf16x8 ld8(const bf16_t* p) { return *(const bf16x8*)p; }
__device__ __forceinline__ bf16x8 lds8(const LAS bf16_t* p) { return *(const LAS bf16x8*)p; }
__device__ __forceinline__ bf16x8 mk8(float a, float b, float c, float d, float e, float f, float g, float h) {
    u32x4 u = {pack2(a, b), pack2(c, d), pack2(e, f), pack2(g, h)}; return __builtin_bit_cast(bf16x8, u); }
__device__ __forceinline__ float wave_sum(float v) { for (int o = 32; o; o >>= 1) v += __shfl_xor(v, o); return v; }
__device__ __forceinline__ float sigm(float x) { return 1.f / (1.f + __expf(-x)); }
__device__ __forceinline__ float silu(float x) { return x / (1.f + __expf(-x)); }
__device__ __forceinline__ float gelu_t(float x) { return x / (1.f + __expf(-1.5957691216f * (x + 0.044715f * x * x * x))); }

struct EpiSwiGLU {
    static constexpr bool PERM = true, AFTER_DRAIN = false;
    bf16_t* O;
    __device__ __forceinline__ void operator()(const f32x4 (&acc)[2][2][4][2], const Unit& u, int wr, int wc, int fr, int fq) const {
        const int row0 = u.pm * 256 + wr * 64 + fr, col0 = u.pn * 128 + wc * 32 + 8 * fq;
#pragma unroll
        for (int ai = 0; ai < 2; ++ai)
#pragma unroll
            for (int m = 0; m < 4; ++m) {
                float h[8];
#pragma unroll
                for (int n = 0; n < 2; ++n)
#pragma unroll
                    for (int j = 0; j < 4; ++j) h[4 * n + j] = silu(acc[ai][0][m][n][j]) * acc[ai][1][m][n][j];
                u32x4 o = {pack2(h[0], h[1]), pack2(h[2], h[3]), pack2(h[4], h[5]), pack2(h[6], h[7])};
                *(u32x4*)(O + (size_t)(row0 + ai * 128 + m * 16) * DFF + col0) = o;
            }
    }
};
struct EpiResid {
    static constexpr bool PERM = false, AFTER_DRAIN = false;
    const float* R; float* O; float scale;
    __device__ __forceinline__ void operator()(const f32x4 (&acc)[2][2][4][2], const Unit& u, int wr, int wc, int fr, int fq) const {
        const int row0 = u.pm * 256 + wr * 64 + fr, col0 = u.pn * 256 + wc * 32 + 4 * fq;
#pragma unroll
        for (int ai = 0; ai < 2; ++ai)
#pragma unroll
            for (int m = 0; m < 4; ++m) {
                const size_t ro = (size_t)(row0 + ai * 128 + m * 16) * DM + col0;
#pragma unroll
                for (int bj = 0; bj < 2; ++bj)
#pragma unroll
                    for (int n = 0; n < 2; ++n) {
                        const f32x4 r = *(const f32x4*)(R + ro + bj * 128 + n * 16);
                        *(f32x4*)(O + ro + bj * 128 + n * 16) = r + acc[ai][bj][m][n] * scale;
                    }
            }
    }
};
struct EpiProj0 {
    static constexpr bool PERM = true, AFTER_DRAIN = false;
    bf16_t* O;
    __device__ __forceinline__ void operator()(const f32x4 (&acc)[2][2][4][2], const Unit& u, int wr, int wc, int fr, int fq) const {
        const int row0 = u.pm * 256 + wr * 64 + fr, col0 = u.pn * 256 + wc * 32 + 8 * fq;
        const bool g = u.pn < 8;
#pragma unroll
        for (int ai = 0; ai < 2; ++ai)
#pragma unroll
            for (int m = 0; m < 4; ++m)
#pragma unroll
                for (int bj = 0; bj < 2; ++bj) {
                    float h[8];
#pragma unroll
                    for (int n = 0; n < 2; ++n)
#pragma unroll
                        for (int j = 0; j < 4; ++j) { const float v = acc[ai][bj][m][n][j]; h[4 * n + j] = g ? gelu_t(v) : v; }
                    u32x4 o = {pack2(h[0], h[1]), pack2(h[2], h[3]), pack2(h[4], h[5]), pack2(h[6], h[7])};
                    *(u32x4*)(O + (size_t)(row0 + ai * 128 + m * 16) * 6144 + col0 + bj * 128) = o;
                }
    }
};
struct EpiProj1 {
    static constexpr bool PERM = false, AFTER_DRAIN = false;
    bf16_t* O; const float* rope;
    __device__ __forceinline__ void operator()(const f32x4 (&acc)[2][2][4][2], const Unit& u, int wr, int wc, int fr, int fq) const {
        const int row0 = u.pm * 256 + wr * 64 + fr, col0 = u.pn * 256 + wc * 32 + 4 * fq;
#pragma unroll
        for (int bj = 0; bj < 2; ++bj) {
            const int head = u.pn * 2 + bj;
            const bool isq = head < 16;
            const bool dorope = (wc == 0) && (isq || ((((head - 16) >> 2) & 1) == 0));
            const float sc = isq ? 0.08838834764831845f : 1.f;
#pragma unroll
            for (int ai = 0; ai < 2; ++ai)
#pragma unroll
                for (int m = 0; m < 4; ++m) {
                    const int row = row0 + ai * 128 + m * 16;
                    f32x4 v0 = acc[ai][bj][m][0], v1 = acc[ai][bj][m][1];
                    if (dorope) {
                        const float* rp = rope + (size_t)(row & 4095) * 32 + 4 * fq;
                        const f32x4 c = *(const f32x4*)rp, s = *(const f32x4*)(rp + 16);
                        const f32x4 a = v0 * c - v1 * s, b = v0 * s + v1 * c; v0 = a; v1 = b;
                    }
                    v0 *= sc; v1 *= sc;
                    bf16_t* op = O + (size_t)row * 5120 + col0 + bj * 128;
                    u32x2 o0 = {pack2(v0[0], v0[1]), pack2(v0[2], v0[3])}, o1 = {pack2(v1[0], v1[1]), pack2(v1[2], v1[3])};
                    *(u32x2*)op = o0; *(u32x2*)(op + 16) = o1;
                }
        }
    }
};

struct Job { const float* src; bf16_t* dst; int K, ldn, nvalid, ntn, remap, off; };
__device__ __forceinline__ void make_job(const Params& P, int j, Job& J) {
    unsigned char* ws = P.ws;
    if (j < 12) {
        const int fi = j / 3, kind = j - 3 * fi;
        if (kind < 2) { J.src = P.in[2 + kind] + (size_t)fi * 2048 * 5632; J.dst = (bf16_t*)(ws + OFF_WGU + fi * SZ_GU); J.K = 2048; J.ldn = 5632; J.nvalid = 5632; J.ntn = 88; J.remap = 1; J.off = kind * 128; }
        else { J.src = P.in[4] + (size_t)fi * 5632 * 2048; J.dst = (bf16_t*)(ws + OFF_WDN + fi * SZ_DN); J.K = 5632; J.ldn = 2048; J.nvalid = 2048; J.ntn = 32; J.remap = 0; J.off = 0; }
    } else if (j == 12) { J.src = P.in[6]; J.dst = (bf16_t*)(ws + OFF_WABIN); J.K = 2048; J.ldn = 6152; J.nvalid = 6152; J.ntn = 97; J.remap = 0; J.off = 0; }
    else if (j == 13) { J.src = P.in[13]; J.dst = (bf16_t*)(ws + OFF_WABOUT); J.K = 2048; J.ldn = 2048; J.nvalid = 2048; J.ntn = 32; J.remap = 0; J.off = 0; }
    else if (j == 14) { J.src = P.in[14]; J.dst = (bf16_t*)(ws + OFF_WNSAIN); J.K = 2048; J.ldn = 5168; J.nvalid = 5168; J.ntn = 81; J.remap = 0; J.off = 0; }
    else if (j == 15) { J.src = P.in[18]; J.dst = (bf16_t*)(ws + OFF_WNSAOUT); J.K = 2048; J.ldn = 2048; J.nvalid = 2048; J.ntn = 32; J.remap = 0; J.off = 0; }
    else if (j < 18) { const int kv = j - 16; J.src = P.in[16] + (size_t)kv * 4096 * 128; J.dst = (bf16_t*)(ws + OFF_WC1) + (size_t)kv * 128 * 4096; J.K = 4096; J.ldn = 128; J.nvalid = 128; J.ntn = 2; J.remap = 0; J.off = 0; }
    else { const int kv = j - 18; J.src = P.in[17] + (size_t)kv * 128 * 128; J.dst = (bf16_t*)(ws + OFF_WC2) + (size_t)kv * 128 * 128; J.K = 128; J.ldn = 128; J.nvalid = 128; J.ntn = 2; J.remap = 0; J.off = 0; }
}
constexpr int NT_CONVERT = 12 * 1408 + 16 * 97 + 16 * 32 + 16 * 81 + 16 * 32 + 2 * 64 + 2 * 2;
__device__ __forceinline__ void phase_prep(const Params& P, LAS unsigned char* lds) {
    LAS float* tile = (LAS float*)lds;
    const int tid = otid();
    {
        const int idx = blockIdx.x * 512 + tid;
        if (idx < 4096 * 16) {
            const int pos = idx >> 4, i = idx & 15;
            const float inv = 1.0f / powf(500000.0f, (float)i * (1.0f / 16.0f));
            const float ang = (float)pos * inv;
            float s, c; sincosf(ang, &s, &c);
            float* rp = (float*)(P.ws + OFF_ROPE) + (size_t)pos * 32;
            rp[i] = c; rp[16 + i] = s;
        }
    }
    for (int t = blockIdx.x; t < NT_CONVERT; t += gridDim.x) {
        Job J; int lt = t, j = 0;
        for (;; ++j) { make_job(P, j, J); const int n = (J.K >> 7) * J.ntn; if (lt < n) break; lt -= n; }
        const int nkt = J.K >> 7, kt = lt % nkt, nt = lt / nkt, k0 = kt * 128, n0 = nt * 64;
#pragma unroll
        for (int i = 0; i < 4; ++i) {
            const int idx = tid + 512 * i, k = idx >> 4, c4 = idx & 15, n = n0 + 4 * c4;
            float4 v = make_float4(0.f, 0.f, 0.f, 0.f);
            if (n < J.nvalid) v = *(const float4*)(J.src + (size_t)(k0 + k) * J.ldn + n);
            LAS float* tp = tile + k * 65 + 4 * c4; tp[0] = v.x; tp[1] = v.y; tp[2] = v.z; tp[3] = v.w;
        }
        __syncthreads();
#pragma unroll
        for (int i = 0; i < 2; ++i) {
            const int idx = tid + 512 * i, n = idx >> 4, kg = idx & 15;
            float f[8];
#pragma unroll
            for (int jj = 0; jj < 8; ++jj) f[jj] = tile[(8 * kg + jj) * 65 + n];
            u32x4 o = {pack2(f[0], f[1]), pack2(f[2], f[3]), pack2(f[4], f[5]), pack2(f[6], f[7])};
            const int nn = n0 + n, row = J.remap ? ((nn >> 7) * 256 + J.off + (nn & 127)) : nn;
            *(u32x4*)(J.dst + (size_t)row * J.K + k0 + 8 * kg) = o;
        }
        __syncthreads();
    }
}

__device__ __forceinline__ void phase_norm(const float* src, const float* g, bf16_t* dst) {
    const int wave = otid() >> 6, lane = otid() & 63;
    for (int row = blockIdx.x * 8 + wave; row < MTOK; row += gridDim.x * 8) {
        const float4* s = (const float4*)(src + (size_t)row * DM);
        float4 v[8]; float ss = 0.f;
#pragma unroll
        for (int i = 0; i < 8; ++i) { v[i] = s[lane + 64 * i]; ss += v[i].x * v[i].x + v[i].y * v[i].y + v[i].z * v[i].z + v[i].w * v[i].w; }
        ss = wave_sum(ss);
        const float r = rsqrtf(ss * (1.0f / 2048.0f) + EPSN);
#pragma unroll
        for (int i = 0; i < 8; ++i) {
            const float4 gg = ((const float4*)g)[lane + 64 * i];
            u32x2 o = {pack2(v[i].x * r * gg.x, v[i].y * r * gg.y), pack2(v[i].z * r * gg.z, v[i].w * r * gg.w)};
            *(u32x2*)(dst + (size_t)row * DM + 4 * (lane + 64 * i)) = o;
        }
    }
}
__device__ __forceinline__ void phase_final_norm(float* io, const float* g) {
    const int wave = otid() >> 6, lane = otid() & 63;
    for (int row = blockIdx.x * 8 + wave; row < MTOK; row += gridDim.x * 8) {
        float4* s = (float4*)(io + (size_t)row * DM);
        float4 v[8]; float ss = 0.f;
#pragma unroll
        for (int i = 0; i < 8; ++i) { v[i] = s[lane + 64 * i]; ss += v[i].x * v[i].x + v[i].y * v[i].y + v[i].z * v[i].z + v[i].w * v[i].w; }
        ss = wave_sum(ss);
        const float r = rsqrtf(ss * (1.0f / 2048.0f) + EPSN);
#pragma unroll
        for (int i = 0; i < 8; ++i) {
            const float4 gg = ((const float4*)g)[lane + 64 * i];
            s[lane + 64 * i] = make_float4(v[i].x * r * gg.x, v[i].y * r * gg.y, v[i].z * r * gg.z, v[i].w * r * gg.w);
        }
    }
}

template <int NT, int MODE>
__device__ __forceinline__ void phase_skinny(const bf16_t* A, const bf16_t* Bt, float* G, const float* bias) {
    const int wave = otid() >> 6, lane = otid() & 63, fr = lane & 15, fq = lane >> 4;
    for (int rt = blockIdx.x * 8 + wave; rt < MTOK / 16; rt += gridDim.x * 8) {
        f32x4 acc[NT];
#pragma unroll
        for (int n = 0; n < NT; ++n) acc[n] = (f32x4){0.f, 0.f, 0.f, 0.f};
        const bf16_t* ap = A + (size_t)(rt * 16 + fr) * DM + 8 * fq;
        const bf16_t* bp = Bt + (size_t)fr * DM + 8 * fq;
#pragma unroll 4
        for (int ks = 0; ks < 64; ++ks) {
            const bf16x8 a = ld8(ap + 32 * ks);
#pragma unroll
            for (int n = 0; n < NT; ++n) { const bf16x8 b = ld8(bp + (size_t)n * 16 * DM + 32 * ks); acc[n] = mfma16(b, a, acc[n]); }
        }
        const int token = rt * 16 + fr;
        if (MODE == 0) {
            if (fq < 2) { const f32x4 b = *(const f32x4*)(bias + 4 * fq); *(f32x4*)(G + (size_t)token * 8 + 4 * fq) = acc[0] + b; }
        } else {
#pragma unroll
            for (int n = 0; n < NT; ++n) { f32x4 o; for (int j = 0; j < 4; ++j) o[j] = sigm(acc[n][j]); *(f32x4*)(G + (size_t)token * 48 + 16 * n + 4 * fq) = o; }
        }
    }
}

__device__ __forceinline__ void conv_wave_item(const Params& P, int item, int lane) {
    const bf16_t* BIG = (const bf16_t*)(P.ws + OFF_BIG); bf16_t* QK = (bf16_t*)(P.ws + OFF_AUX1); bf16_t* KT = (bf16_t*)(P.ws + OFF_KT);
    const float* cw = P.in[11];
    const int tgp = item >> 5, cgp = item & 31, tg = lane & 7, cg = lane >> 3;
    const int tok0 = tgp * 64 + 8 * tg, c0 = cgp * 64 + 8 * cg, pos0 = tok0 & 4095;
    float w[4][8];
#pragma unroll
    for (int jj = 0; jj < 4; ++jj) { const float4 a = *(const float4*)(cw + jj * 2048 + c0), b = *(const float4*)(cw + jj * 2048 + c0 + 4);
        w[jj][0] = a.x; w[jj][1] = a.y; w[jj][2] = a.z; w[jj][3] = a.w; w[jj][4] = b.x; w[jj][5] = b.y; w[jj][6] = b.z; w[jj][7] = b.w; }
    bf16x8 xr[11];
#pragma unroll
    for (int r = 0; r < 11; ++r) {
        const bool ok = (r >= 3) || (pos0 != 0);
        const int t = ok ? (tok0 - 3 + r) : tok0;
        const bf16x8 v = ld8(BIG + (size_t)t * 6144 + 2048 + c0);
        xr[r] = ok ? v : (bf16x8){0, 0, 0, 0, 0, 0, 0, 0};
    }
    const float ksc = (c0 >= 1024) ? 0.0625f : 1.0f;
    float o[8][8];
#pragma unroll
    for (int i = 0; i < 8; ++i)
#pragma unroll
        for (int j = 0; j < 8; ++j) {
            float a = 0.f;
#pragma unroll
            for (int jj = 0; jj < 4; ++jj) a += w[jj][j] * bfs(xr[i + jj][j]);
            o[i][j] = silu(a) * ksc;
        }
#pragma unroll
    for (int i = 0; i < 8; ++i) {
        u32x4 v = {pack2(o[i][0], o[i][1]), pack2(o[i][2], o[i][3]), pack2(o[i][4], o[i][5]), pack2(o[i][6], o[i][7])};
        *(u32x4*)(QK + (size_t)(tok0 + i) * 2048 + c0) = v;
    }
    if (c0 >= 1024) {
        const int b = tok0 >> 12;
#pragma unroll
        for (int j = 0; j < 8; ++j) {
            u32x4 v = {pack2(o[0][j], o[1][j]), pack2(o[2][j], o[3][j]), pack2(o[4][j], o[5][j]), pack2(o[6][j], o[7][j])};
            *(u32x4*)(KT + (size_t)(b * 1024 + (c0 - 1024) + j) * 4096 + pos0) = v;
        }
    }
}

__device__ __forceinline__ void gmlp_item(const Params& P, LAS unsigned char* lds, int item) {
    const int tid = otid(), wave = tid >> 6, lane = tid & 63, fr = lane & 15, fq = lane >> 4;
    LAS bf16_t* VT = (LAS bf16_t*)lds;
    LAS float* rstd = (LAS float*)(lds + 34816);
    const bf16_t* BIG = (const bf16_t*)(P.ws + OFF_BIG); bf16_t* ABUF = (bf16_t*)(P.ws + OFF_ABUF);
    const float* gn = P.in[8]; const float* wsp = P.in[9]; const float* bsp = P.in[10];
    const int T0 = item * 128;
    for (int r = 0; r < 16; ++r) {
        const int row = wave * 16 + r;
        const bf16_t* p = BIG + (size_t)(T0 + row) * 6144 + 1024 + 16 * lane;
        const bf16x8 a = ld8(p), b = ld8(p + 8);
        float ss = 0.f;
#pragma unroll
        for (int j = 0; j < 8; ++j) { const float x = bfs(a[j]), y = bfs(b[j]); ss += x * x + y * y; }
        ss = wave_sum(ss);
        if (lane == 0) rstd[row] = rsqrtf(ss * (1.0f / 1024.0f) + EPSN);
    }
    __syncthreads();
    for (int g = 0; g < 8; ++g) {
        {
            const int s = tid & 127, eg0 = tid >> 7; const float rs = rstd[s];
#pragma unroll
            for (int it = 0; it < 4; ++it) {
                const int eg = eg0 + 4 * it;
                const bf16x8 v = ld8(BIG + (size_t)(T0 + s) * 6144 + 1024 + g * 128 + 8 * eg);
                const float4 g0 = *(const float4*)(gn + g * 128 + 8 * eg), g1 = *(const float4*)(gn + g * 128 + 8 * eg + 4);
                const float gg[8] = {g0.x, g0.y, g0.z, g0.w, g1.x, g1.y, g1.z, g1.w};
#pragma unroll
                for (int jj = 0; jj < 8; ++jj) VT[(8 * eg + jj) * 136 + s] = (bf16_t)f2bf(bfs(v[jj]) * rs * gg[jj]);
            }
        }
        __syncthreads();
        f32x4 acc[8];
#pragma unroll
        for (int e = 0; e < 8; ++e) acc[e] = (f32x4){0.f, 0.f, 0.f, 0.f};
        const int t = wave * 16 + fr;
        for (int ks = 0; ks < 4; ++ks) {
            if (32 * ks <= wave * 16 + 15) {
                const float* wp = wsp + ((size_t)(g * 128 + t)) * 128 + 32 * ks + 8 * fq;
                const float4 w0 = *(const float4*)wp, w1 = *(const float4*)(wp + 4);
                const int s0 = 32 * ks + 8 * fq;
                const bf16x8 Y = mk8(s0 + 0 <= t ? w0.x : 0.f, s0 + 1 <= t ? w0.y : 0.f, s0 + 2 <= t ? w0.z : 0.f, s0 + 3 <= t ? w0.w : 0.f,
                                     s0 + 4 <= t ? w1.x : 0.f, s0 + 5 <= t ? w1.y : 0.f, s0 + 6 <= t ? w1.z : 0.f, s0 + 7 <= t ? w1.w : 0.f);
#pragma unroll
                for (int e = 0; e < 8; ++e) { const bf16x8 X = lds8(VT + (16 * e + fr) * 136 + 32 * ks + 8 * fq); acc[e] = mfma16(X, Y, acc[e]); }
            }
        }
        const float bsv = bsp[g * 128 + t]; const size_t tok = (size_t)(T0 + t);
#pragma unroll
        for (int e = 0; e < 8; ++e) {
            const int e0 = 16 * e + 4 * fq;
            const u32x2 uu = *(const u32x2*)(BIG + tok * 6144 + g * 128 + e0);
            u32x2 o = {pack2(bflo(uu.x) * (acc[e][0] + bsv), bfhi(uu.x) * (acc[e][1] + bsv)), pack2(bflo(uu.y) * (acc[e][2] + bsv), bfhi(uu.y) * (acc[e][3] + bsv))};
            *(u32x2*)(ABUF + tok * 2048 + g * 128 + e0) = o;
        }
        __syncthreads();
    }
}

__device__ __forceinline__ void phase_conv_gmlp(const Params& P, LAS unsigned char* lds) {
    const int nbg = gridDim.x >> 1;
    if ((int)blockIdx.x < nbg) { for (int it = blockIdx.x; it < 128; it += nbg) gmlp_item(P, lds, it); }
    else {
        const int wave = otid() >> 6, lane = otid() & 63, nbc = gridDim.x - nbg;
        for (int it = (blockIdx.x - nbg) * 8 + wave; it < 8192; it += nbc * 8) conv_wave_item(P, it, lane);
    }
}

constexpr int ML_KS = 0, ML_PS = 67584, ML_VT = 102400, ML_VTW = 106752, ML_CB = 111104, ML_N = 119552, ML_A = 120576, ML_MT = 121088, ML_B = 121600, ML_WS = 122112;
__device__ __forceinline__ void mlstm_item(const Params& P, LAS unsigned char* lds, int item) {
    const int tid = otid(), wave = tid >> 6, lane = tid & 63, fr = lane & 15, fq = lane >> 4;
    LAS bf16_t* Ks = (LAS bf16_t*)(lds + ML_KS);
    LAS bf16_t* Ps = (LAS bf16_t*)(lds + ML_PS);
    LAS bf16_t* VT = (LAS bf16_t*)(lds + ML_VT);
    LAS bf16_t* VTW = (LAS bf16_t*)(lds + ML_VTW);
    LAS bf16_t* Cb = (LAS bf16_t*)(lds + ML_CB);
    LAS float* nvec = (LAS float*)(lds + ML_N);
    LAS float* sa = (LAS float*)(lds + ML_A); LAS float* sMt = (LAS float*)(lds + ML_MT); LAS float* sb = (LAS float*)(lds + ML_B); LAS float* sws = (LAS float*)(lds + ML_WS);
    const bf16_t* BIG = (const bf16_t*)(P.ws + OFF_BIG); const bf16_t* QK = (const bf16_t*)(P.ws + OFF_AUX1);
    const float* G0 = (const float*)(P.ws + OFF_GATES); float* HT = (float*)(P.ws + OFF_AUX2);
    const int es = item & 15, h = (item >> 4) & 3, b = item >> 6;
    for (int i = tid; i < 16 * 264; i += 512) Cb[i] = 0;
    if (tid < 256) nvec[tid] = 0.f;
    f32x4 Cacc[2] = {(f32x4){0.f, 0.f, 0.f, 0.f}, (f32x4){0.f, 0.f, 0.f, 0.f}};
    float m = 0.f;
    __syncthreads();
    for (int c = 0; c < 32; ++c) {
        const int T0 = b * 4096 + c * 128;
        if (wave == 0) {
            const float f0 = G0[(size_t)(T0 + 2 * lane) * 8 + 4 + h], f1 = G0[(size_t)(T0 + 2 * lane + 1) * 8 + 4 + h];
            const float i0 = G0[(size_t)(T0 + 2 * lane) * 8 + h], i1 = G0[(size_t)(T0 + 2 * lane + 1) * 8 + h];
            const float l0 = (f0 >= 0.f) ? -log1pf(__expf(-f0)) : (f0 - log1pf(__expf(f0)));
            const float l1 = (f1 >= 0.f) ? -log1pf(__expf(-f1)) : (f1 - log1pf(__expf(f1)));
            float v = l0 + l1;
#pragma unroll
            for (int o = 1; o < 64; o <<= 1) { const float y = __shfl_up(v, o); if (lane >= o) v += y; }
            const float excl = v - (l0 + l1);
            const float b0 = excl + l0, b1 = excl + l0 + l1;
            const float a0 = i0 - b0, a1 = i1 - b1;
            float q = fmaxf(a0, a1);
#pragma unroll
            for (int o = 1; o < 64; o <<= 1) { const float y = __shfl_up(q, o); if (lane >= o) q = fmaxf(q, y); }
            float qe = __shfl_up(q, 1); if (lane == 0) qe = -3.0e38f;
            const float pm0 = fmaxf(qe, a0), pm1 = fmaxf(pm0, a1);
            sa[2 * lane] = a0; sa[2 * lane + 1] = a1; sb[2 * lane] = b0; sb[2 * lane + 1] = b1;
            sMt[2 * lane] = fmaxf(pm0, m); sMt[2 * lane + 1] = fmaxf(pm1, m);
        }
        __syncthreads();
        const float MtL = sMt[127];
        if (tid < 128) sws[tid] = __expf(sa[tid] - MtL);
#pragma unroll
        for (int i = 0; i < 8; ++i) {
            const int idx = tid + 512 * i, s = idx >> 5, dp = idx & 31;
            const bf16x8 v = ld8(QK + (size_t)(T0 + s) * 2048 + 1024 + h * 256 + 8 * dp);
            *(LAS bf16x8*)(Ks + s * 264 + 8 * dp) = v;
        }
        if (tid < 256) {
            const int s = tid & 127, hf = tid >> 7;
            const bf16x8 v = ld8(BIG + (size_t)(T0 + s) * 6144 + 4096 + h * 256 + es * 16 + 8 * hf);
            const float w = __expf(sa[s] - MtL);
#pragma unroll
            for (int jj = 0; jj < 8; ++jj) { VT[(8 * hf + jj) * 136 + s] = (bf16_t)v[jj]; VTW[(8 * hf + jj) * 136 + s] = (bf16_t)f2bf(bfs(v[jj]) * w); }
        }
        bf16x8 qf[8];
#pragma unroll
        for (int ks = 0; ks < 8; ++ks) qf[ks] = ld8(QK + (size_t)(T0 + 16 * wave + fr) * 2048 + h * 256 + 32 * ks + 8 * fq);
        __syncthreads();
        const int t = 16 * wave + fr;
        const float Mt_t = sMt[t];
        float rsum = 0.f;
        const int ctmax = wave | 1;
        for (int ct = 0; ct <= ctmax; ++ct) {
            f32x4 acc = (f32x4){0.f, 0.f, 0.f, 0.f};
#pragma unroll
            for (int ks = 0; ks < 8; ++ks) { const bf16x8 X = lds8(Ks + (16 * ct + fr) * 264 + 32 * ks + 8 * fq); acc = mfma16(X, qf[ks], acc); }
            const int s0 = 16 * ct + 4 * fq;
            const f32x4 av = *(const LAS f32x4*)(sa + s0);
            float pv[4];
#pragma unroll
            for (int j = 0; j < 4; ++j) { const float d = (s0 + j <= t) ? __expf(av[j] - Mt_t) : 0.f; pv[j] = acc[j] * d; rsum += pv[j]; }
            u32x2 o = {pack2(pv[0], pv[1]), pack2(pv[2], pv[3])};
            *(LAS u32x2*)(Ps + t * 136 + s0) = o;
        }
        rsum += __shfl_xor(rsum, 16); rsum += __shfl_xor(rsum, 32);
        __syncthreads();
        {
            f32x4 a1 = (f32x4){0.f, 0.f, 0.f, 0.f}, a2 = (f32x4){0.f, 0.f, 0.f, 0.f};
            for (int kk = 0; kk <= (wave >> 1); ++kk) {
                const bf16x8 X = lds8(VT + fr * 136 + 32 * kk + 8 * fq), Y = lds8(Ps + t * 136 + 32 * kk + 8 * fq);
                a1 = mfma16(X, Y, a1);
            }
            float qn = 0.f;
#pragma unroll
            for (int ks = 0; ks < 8; ++ks) {
                const bf16x8 X = lds8(Cb + fr * 264 + 32 * ks + 8 * fq);
                a2 = mfma16(X, qf[ks], a2);
                const f32x4 n0 = *(const LAS f32x4*)(nvec + 32 * ks + 8 * fq), n1 = *(const LAS f32x4*)(nvec + 32 * ks + 8 * fq + 4);
#pragma unroll
                for (int jj = 0; jj < 4; ++jj) qn += bfs(qf[ks][jj]) * n0[jj] + bfs(qf[ks][4 + jj]) * n1[jj];
            }
            qn += __shfl_xor(qn, 16); qn += __shfl_xor(qn, 32);
            const float wi = __expf(m - Mt_t);
            const float den = rsum + wi * qn;
            const float dn = fmaxf(fabsf(den), __expf(-(sb[t] + Mt_t)));
            const float inv = 1.0f / dn;
            f32x4 o; for (int j = 0; j < 4; ++j) o[j] = (a1[j] + wi * a2[j]) * inv;
            *(f32x4*)(HT + (size_t)(T0 + t) * 1024 + h * 256 + es * 16 + 4 * fq) = o;
        }
        __syncthreads();
        {
            const float wprev = __expf(m - MtL);
#pragma unroll
            for (int dt = 0; dt < 2; ++dt) {
                Cacc[dt] *= wprev;
                const int dcol = 16 * (2 * wave + dt) + fr;
#pragma unroll
                for (int kk = 0; kk < 4; ++kk) {
                    const bf16x8 X = lds8(VTW + fr * 136 + 32 * kk + 8 * fq);
                    bf16x8 Y;
#pragma unroll
                    for (int jj = 0; jj < 8; ++jj) Y[jj] = (short)Ks[(32 * kk + 8 * fq + jj) * 264 + dcol];
                    Cacc[dt] = mfma16(X, Y, Cacc[dt]);
                }
#pragma unroll
                for (int j = 0; j < 4; ++j) Cb[(4 * fq + j) * 264 + dcol] = (bf16_t)f2bf(Cacc[dt][j]);
            }
            if (tid < 256) {
                float nv = nvec[tid] * wprev;
                for (int s = 0; s < 128; ++s) nv += sws[s] * __uint_as_float(((unsigned)Ks[s * 264 + tid]) << 16);
                nvec[tid] = nv;
            }
            m = sb[127] + MtL;
        }
        __syncthreads();
    }
}
__device__ __forceinline__ void phase_mlstm(const Params& P, LAS unsigned char* lds) {
    for (int it = blockIdx.x; it < 256; it += gridDim.x) { mlstm_item(P, lds, it); __syncthreads(); }
}

__device__ __forceinline__ void phase_htnorm(const Params& P) {
    const int wave = otid() >> 6, lane = otid() & 63;
    const float* HT = (const float*)(P.ws + OFF_AUX2); const bf16_t* BIG = (const bf16_t*)(P.ws + OFF_BIG); bf16_t* ABUF = (bf16_t*)(P.ws + OFF_ABUF);
    const float* mn = P.in[12];
    for (int row = blockIdx.x * 8 + wave; row < MTOK; row += gridDim.x * 8) {
#pragma unroll
        for (int h = 0; h < 4; ++h) {
            const float4 v = *(const float4*)(HT + (size_t)row * 1024 + h * 256 + 4 * lane);
            float ss = v.x * v.x + v.y * v.y + v.z * v.z + v.w * v.w;
            ss = wave_sum(ss);
            const float r = rsqrtf(ss * (1.0f / 256.0f) + EPSN);
            const float4 g = *(const float4*)(mn + h * 256 + 4 * lane);
            const u32x2 oo = *(const u32x2*)(BIG + (size_t)row * 6144 + 5120 + h * 256 + 4 * lane);
            u32x2 o = {pack2(sigm(bflo(oo.x)) * v.x * r * g.x, sigm(bfhi(oo.x)) * v.y * r * g.y), pack2(sigm(bflo(oo.y)) * v.z * r * g.z, sigm(bfhi(oo.y)) * v.w * r * g.w)};
            *(u32x2*)(ABUF + (size_t)row * 2048 + 1024 + h * 256 + 4 * lane) = o;
        }
    }
}

__device__ __forceinline__ int kv_col(int br, int kv, int g) { return 2048 + ((br * 2 + kv) * 4 + g) * 128; }

__device__ __forceinline__ void vt_wave_item(const Params& P, int item, int lane) {
    const bf16_t* BIG = (const bf16_t*)(P.ws + OFF_BIG); bf16_t* VTG = (bf16_t*)(P.ws + OFF_KT);
    const int tgp = item >> 4, cgp = item & 15;
    const int brm = cgp >> 3, g = (cgp >> 1) & 3, half = cgp & 1;
    const int tg = lane & 7, cg = lane >> 3;
    const int tok0 = tgp * 64 + 8 * tg, b = tok0 >> 12, pos0 = tok0 & 4095;
    const int col = kv_col(brm + 1, 1, g) + half * 64 + 8 * cg;
    bf16x8 x[8];
#pragma unroll
    for (int i = 0; i < 8; ++i) x[i] = ld8(BIG + (size_t)(tok0 + i) * 5120 + col);
    const size_t rb = (size_t)(((b * 2 + brm) * 4 + g) * 128 + half * 64 + 8 * cg);
#pragma unroll
    for (int j = 0; j < 8; ++j) {
        bf16x8 v; for (int i = 0; i < 8; ++i) v[i] = x[i][j];
        *(bf16x8*)(VTG + (rb + j) * 4096 + pos0) = v;
    }
}

__device__ __forceinline__ void cmp_item(const Params& P, LAS unsigned char* lds, int item) {
    const int tid = otid(), wave = tid >> 6, lane = tid & 63, fr = lane & 15, fq = lane >> 4;
    LAS float* pos = (LAS float*)lds;
    LAS bf16_t* H = (LAS bf16_t*)(lds + 16384);
    const bf16_t* BIG = (const bf16_t*)(P.ws + OFF_BIG);
    const int rt = item & 15, g = (item >> 4) & 3, b = (item >> 6) & 3, kv = item >> 8;
    const bf16_t* W1 = (const bf16_t*)(P.ws + OFF_WC1) + (size_t)kv * 128 * 4096;
    const bf16_t* W2 = (const bf16_t*)(P.ws + OFF_WC2) + (size_t)kv * 128 * 128;
    const float* pe = P.in[15] + (size_t)kv * 4096;
    for (int i = tid; i < 1024; i += 512) *(LAS f32x4*)(pos + 4 * i) = *(const f32x4*)(pe + 4 * i);
    __syncthreads();
    int cr = rt * 16 + fr; if (cr > 254) cr = 254;
    const bf16_t* ap = BIG + (size_t)(b * 4096 + 16 * cr) * 5120 + kv_col(0, kv, g) + 8 * fq;
    const bf16_t* wp = W1 + (size_t)(16 * wave + fr) * 4096 + 8 * fq;
    f32x4 acc = (f32x4){0.f, 0.f, 0.f, 0.f};
#pragma unroll 4
    for (int ks = 0; ks < 128; ++ks) {
        const int l = ks >> 2, d0 = (ks & 3) * 32;
        const bf16x8 xv = ld8(ap + (size_t)l * 5120 + d0);
        const f32x4 p0 = *(const LAS f32x4*)(pos + l * 128 + d0 + 8 * fq), p1 = *(const LAS f32x4*)(pos + l * 128 + d0 + 8 * fq + 4);
        const bf16x8 Y = mk8(bfs(xv[0]) + p0[0], bfs(xv[1]) + p0[1], bfs(xv[2]) + p0[2], bfs(xv[3]) + p0[3], bfs(xv[4]) + p1[0], bfs(xv[5]) + p1[1], bfs(xv[6]) + p1[2], bfs(xv[7]) + p1[3]);
        const bf16x8 X = ld8(wp + 32 * ks);
        acc = mfma16(X, Y, acc);
    }
    { u32x2 o = {pack2(gelu_t(acc[0]), gelu_t(acc[1])), pack2(gelu_t(acc[2]), gelu_t(acc[3]))}; *(LAS u32x2*)(H + fr * 136 + 16 * wave + 4 * fq) = o; }
    __syncthreads();
    f32x4 a2 = (f32x4){0.f, 0.f, 0.f, 0.f};
    if (kv == 0) {
#pragma unroll
        for (int ks = 0; ks < 4; ++ks) { const bf16x8 X = ld8(W2 + (size_t)(16 * wave + fr) * 128 + 32 * ks + 8 * fq), Y = lds8(H + fr * 136 + 32 * ks + 8 * fq); a2 = mfma16(X, Y, a2); }
        bf16_t* KC = (bf16_t*)(P.ws + OFF_KCMP);
        u32x2 o = {pack2(a2[0], a2[1]), pack2(a2[2], a2[3])};
        *(u32x2*)(KC + (size_t)((b * 4 + g) * 256 + rt * 16 + fr) * 128 + 16 * wave + 4 * fq) = o;
    } else {
#pragma unroll
        for (int ks = 0; ks < 4; ++ks) { const bf16x8 Y = ld8(W2 + (size_t)(16 * wave + fr) * 128 + 32 * ks + 8 * fq), X = lds8(H + fr * 136 + 32 * ks + 8 * fq); a2 = mfma16(X, Y, a2); }
        bf16_t* VC = (bf16_t*)(P.ws + OFF_VCMPT);
        u32x2 o = {pack2(a2[0], a2[1]), pack2(a2[2], a2[3])};
        *(u32x2*)(VC + (size_t)((b * 4 + g) * 128 + 16 * wave + fr) * 256 + rt * 16 + 4 * fq) = o;
    }
    __syncthreads();
}
__device__ __forceinline__ void phase_compress(const Params& P, LAS unsigned char* lds) {
    for (int it = blockIdx.x; it < 512; it += gridDim.x) cmp_item(P, lds, it);
    const int wave = otid() >> 6, lane = otid() & 63;
    for (int it = blockIdx.x * 8 + wave; it < 4096; it += gridDim.x * 8) vt_wave_item(P, it, lane);
}

constexpr int AT_KB = 0, AT_VT = 17408, AT_PS = 35840, AT_IMP = 54272, AT_SEL = 87040;
struct AttnState { float mrun, lrun; f32x4 o[8]; };
__device__ __forceinline__ void at_load_k(LAS unsigned char* lds, const bf16_t* src, size_t pitch) {
    LAS bf16_t* Kb = (LAS bf16_t*)(lds + AT_KB);
#pragma unroll
    for (int i = 0; i < 2; ++i) { const int p = otid() + 512 * i, row = p >> 4, ch = p & 15; *(LAS bf16x8*)(Kb + row * 136 + 8 * ch) = ld8(src + (size_t)row * pitch + 8 * ch); }
}
__device__ __forceinline__ void at_load_vt(LAS unsigned char* lds, const bf16_t* src, size_t pitch) {
    LAS bf16_t* Vb = (LAS bf16_t*)(lds + AT_VT);
#pragma unroll
    for (int i = 0; i < 2; ++i) { const int p = otid() + 512 * i, row = p >> 3, ch = p & 7; *(LAS bf16x8*)(Vb + row * 72 + 8 * ch) = ld8(src + (size_t)row * pitch + 8 * ch); }
}
__device__ __forceinline__ void at_scores(LAS unsigned char* lds, const bf16x8 (&qf)[4], f32x4 (&sc)[4], int fr, int fq) {
    const LAS bf16_t* Kb = (const LAS bf16_t*)(lds + AT_KB);
#pragma unroll
    for (int kt = 0; kt < 4; ++kt) {
        f32x4 a = (f32x4){0.f, 0.f, 0.f, 0.f};
#pragma unroll
        for (int ks = 0; ks < 4; ++ks) a = mfma16(lds8(Kb + (16 * kt + fr) * 136 + 32 * ks + 8 * fq), qf[ks], a);
        sc[kt] = a;
    }
}
__device__ __forceinline__ void at_pv(LAS unsigned char* lds, const f32x4 (&p)[4], f32x4 (&o)[8], int wave, int fr, int fq) {
    LAS bf16_t* Pw = (LAS bf16_t*)(lds + AT_PS) + wave * 16 * 72;
    const LAS bf16_t* Vb = (const LAS bf16_t*)(lds + AT_VT);
#pragma unroll
    for (int kt = 0; kt < 4; ++kt) { u32x2 v = {pack2(p[kt][0], p[kt][1]), pack2(p[kt][2], p[kt][3])}; *(LAS u32x2*)(Pw + fr * 72 + 16 * kt + 4 * fq) = v; }
    __builtin_amdgcn_s_waitcnt(0xc07f);
    __builtin_amdgcn_wave_barrier();
#pragma unroll
    for (int kk = 0; kk < 2; ++kk) {
        const bf16x8 Y = lds8(Pw + fr * 72 + 32 * kk + 8 * fq);
#pragma unroll
        for (int dt = 0; dt < 8; ++dt) o[dt] = mfma16(lds8(Vb + (16 * dt + fr) * 72 + 32 * kk + 8 * fq), Y, o[dt]);
    }
}
__device__ __forceinline__ void at_online(LAS unsigned char* lds, const bf16x8 (&qf)[4], AttnState& st, const unsigned (&valid)[4], int wave, int fr, int fq) {
    f32x4 sc[4];
    at_scores(lds, qf, sc, fr, fq);
    float bm = -3.0e38f;
#pragma unroll
    for (int kt = 0; kt < 4; ++kt)
#pragma unroll
        for (int j = 0; j < 4; ++j) if ((valid[kt] >> j) & 1u) bm = fmaxf(bm, sc[kt][j]);
    bm = fmaxf(bm, __shfl_xor(bm, 16)); bm = fmaxf(bm, __shfl_xor(bm, 32));
    const float mnew = fmaxf(st.mrun, bm);
    const float alpha = __expf(st.mrun - mnew);
    float ps = 0.f;
#pragma unroll
    for (int kt = 0; kt < 4; ++kt)
#pragma unroll
        for (int j = 0; j < 4; ++j) { const float e = ((valid[kt] >> j) & 1u) ? __expf(sc[kt][j] - mnew) : 0.f; sc[kt][j] = e; ps += e; }
    ps += __shfl_xor(ps, 16); ps += __shfl_xor(ps, 32);
    st.lrun = st.lrun * alpha + ps; st.mrun = mnew;
#pragma unroll
    for (int dt = 0; dt < 8; ++dt) st.o[dt] *= alpha;
    at_pv(lds, sc, st.o, wave, fr, fq);
}

__device__ __forceinline__ void attn_item(const Params& P, LAS unsigned char* lds, int item) {
    const int tid = otid(), wave = tid >> 6, lane = tid & 63, fr = lane & 15, fq = lane >> 4;
    const bf16_t* BIG = (const bf16_t*)(P.ws + OFF_BIG); const bf16_t* VTG = (const bf16_t*)(P.ws + OFF_KT);
    const bf16_t* KC = (const bf16_t*)(P.ws + OFF_KCMP); const bf16_t* VC = (const bf16_t*)(P.ws + OFF_VCMPT);
    const float* GT = (const float*)(P.ws + OFF_GATES); bf16_t* Y = (bf16_t*)(P.ws + OFF_ABUF);
    LAS float* impW = (LAS float*)(lds + AT_IMP);
    LAS unsigned* selw = (LAS unsigned*)(lds + AT_SEL);
    const int qt = item & 127, g = (item >> 7) & 3, b = item >> 9;
    const int t0 = qt * 32, tokb = b * 4096;
    const int head = g * 4 + (wave >> 1), qoff = 16 * (wave & 1);
    const int pos = t0 + qoff + fr;
    const size_t tok = (size_t)(tokb + pos);
    const int cur = t0 >> 6;
    bf16x8 qf[4];
#pragma unroll
    for (int ks = 0; ks < 4; ++ks) qf[ks] = ld8(BIG + tok * 5120 + head * 128 + 32 * ks + 8 * fq);
    f32x4 outacc[8];
#pragma unroll
    for (int dt = 0; dt < 8; ++dt) outacc[dt] = (f32x4){0.f, 0.f, 0.f, 0.f};

#ifndef NO_CMP
    {
        const LAS bf16_t* dummy = nullptr; (void)dummy;
        const int cmaxq = (pos - 31) >> 4;
        float mx = -3.0e38f, sum = 0.f;
#pragma unroll 1
        for (int blk = 0; blk < 4; ++blk) {
            __syncthreads();
            at_load_k(lds, KC + (size_t)((b * 4 + g) * 256 + blk * 64) * 128, 128);
            __syncthreads();
            f32x4 s4[4]; at_scores(lds, qf, s4, fr, fq);
            const int lim = cmaxq - 64 * blk - 4 * fq;
            float bm = -3.0e38f;
#pragma unroll
            for (int kt = 0; kt < 4; ++kt)
#pragma unroll
                for (int j = 0; j < 4; ++j) { const float s = (16 * kt + j <= lim) ? s4[kt][j] : -3.0e38f; s4[kt][j] = s; bm = fmaxf(bm, s); }
            bm = fmaxf(bm, __shfl_xor(bm, 16)); bm = fmaxf(bm, __shfl_xor(bm, 32));
            const float mnew = fmaxf(mx, bm), mns = (mnew < -1.0e37f) ? 0.f : mnew;
            float ps = 0.f;
#pragma unroll
            for (int kt = 0; kt < 4; ++kt)
#pragma unroll
                for (int j = 0; j < 4; ++j) ps += __expf(s4[kt][j] - mns);
            sum = sum * __expf(mx - mns) + ps; mx = mnew;
        }
        sum += __shfl_xor(sum, 16); sum += __shfl_xor(sum, 32);
        const float inv = sum > 0.f ? 1.0f / sum : 0.f;
        const float mxs = (mx < -1.0e37f) ? 0.f : mx;
        f32x4 oc[8];
#pragma unroll
        for (int dt = 0; dt < 8; ++dt) oc[dt] = (f32x4){0.f, 0.f, 0.f, 0.f};
        float eprev = 0.f;
#pragma unroll 1
        for (int blk = 0; blk < 4; ++blk) {
            __syncthreads();
            at_load_k(lds, KC + (size_t)((b * 4 + g) * 256 + blk * 64) * 128, 128);
            at_load_vt(lds, VC + (size_t)((b * 4 + g) * 128) * 256 + blk * 64, 256);
            __syncthreads();
            f32x4 s4[4]; at_scores(lds, qf, s4, fr, fq);
            const int lim = cmaxq - 64 * blk - 4 * fq;
#pragma unroll
            for (int kt = 0; kt < 4; ++kt) {
#pragma unroll
                for (int j = 0; j < 4; ++j) s4[kt][j] = (16 * kt + j <= lim) ? __expf(s4[kt][j] - mxs) * inv : 0.f;
                const float a = s4[kt][0] + s4[kt][1] + s4[kt][2] + s4[kt][3], e = 0.5f * s4[kt][3];
                const float src = (fq == 3) ? eprev : e;
                const float got = __shfl(src, (lane + 48) & 63);
                impW[(wave * 16 + fr) * 64 + 16 * blk + 4 * kt + fq] = a - e + got;
                eprev = e;
            }
            at_pv(lds, s4, oc, wave, fr, fq);
        }
        const float gate = GT[tok * 48 + 0 * 16 + head];
#pragma unroll
        for (int dt = 0; dt < 8; ++dt) outacc[dt] += oc[dt] * gate;
    }
#endif
    __syncthreads();
#ifndef NO_TOPK
    {
#pragma unroll 1
        for (int i = 0; i < 4; ++i) {
            const int q = 4 * wave + i;
            float v = 0.f;
#pragma unroll
            for (int r = 0; r < 4; ++r) v += impW[((2 * r + (q >> 4)) * 16 + (q & 15)) * 64 + lane];
            const int J = lane;
            if (J == 0 || J == cur || J == cur - 1) v = 1.0e9f; else if (J > cur) v = -1.0e9f;
            int rank = 0;
            for (int o = 0; o < 64; ++o) { const float vo = __shfl(v, o); rank += (vo > v || (vo == v && o < J)) ? 1 : 0; }
            const unsigned long long mask = __ballot((rank < 16) && (J <= cur));
            if (lane == 0) { selw[2 * q] = (unsigned)mask; selw[2 * q + 1] = (unsigned)(mask >> 32); }
        }
    }
#endif
    __syncthreads();
    unsigned long long un = 0ull;
#pragma unroll 1
    for (int q = 0; q < 32; ++q) un |= ((unsigned long long)selw[2 * q + 1] << 32) | selw[2 * q];
    const unsigned long long mysel = ((unsigned long long)selw[2 * (qoff + fr) + 1] << 32) | selw[2 * (qoff + fr)];
#ifndef NO_SEL
    {
        AttnState st; st.mrun = -3.0e38f; st.lrun = 0.f;
#pragma unroll
        for (int dt = 0; dt < 8; ++dt) st.o[dt] = (f32x4){0.f, 0.f, 0.f, 0.f};
#pragma unroll 1
        for (int jb = 0; jb <= cur; ++jb) {
            if (!((un >> jb) & 1ull)) continue;
            __syncthreads();
            at_load_k(lds, BIG + (size_t)(tokb + jb * 64) * 5120 + kv_col(1, 0, g), 5120);
            at_load_vt(lds, VTG + (size_t)(((b * 2 + 0) * 4 + g) * 128) * 4096 + jb * 64, 4096);
            __syncthreads();
            const bool selb = (mysel >> jb) & 1ull;
            unsigned valid[4];
#pragma unroll
            for (int kt = 0; kt < 4; ++kt) { unsigned m = 0; for (int j = 0; j < 4; ++j) { const int kp = jb * 64 + 16 * kt + 4 * fq + j; if (selb && kp <= pos) m |= 1u << j; } valid[kt] = m; }
            at_online(lds, qf, st, valid, wave, fr, fq);
        }
        const float gate = GT[tok * 48 + 1 * 16 + head];
        const float sc = st.lrun > 0.f ? gate / st.lrun : 0.f;
#pragma unroll
        for (int dt = 0; dt < 8; ++dt) outacc[dt] += st.o[dt] * sc;
    }
#endif
#ifndef NO_WIN
    {
        AttnState st; st.mrun = -3.0e38f; st.lrun = 0.f;
#pragma unroll
        for (int dt = 0; dt < 8; ++dt) st.o[dt] = (f32x4){0.f, 0.f, 0.f, 0.f};
        const int lo = t0 - 511, jlo = lo < 0 ? 0 : (lo >> 6);
#pragma unroll 1
        for (int jb = jlo; jb <= cur; ++jb) {
            __syncthreads();
            at_load_k(lds, BIG + (size_t)(tokb + jb * 64) * 5120 + kv_col(2, 0, g), 5120);
            at_load_vt(lds, VTG + (size_t)(((b * 2 + 1) * 4 + g) * 128) * 4096 + jb * 64, 4096);
            __syncthreads();
            unsigned valid[4];
#pragma unroll
            for (int kt = 0; kt < 4; ++kt) { unsigned m = 0; for (int j = 0; j < 4; ++j) { const int kp = jb * 64 + 16 * kt + 4 * fq + j; if (kp <= pos && pos - kp < 512) m |= 1u << j; } valid[kt] = m; }
            at_online(lds, qf, st, valid, wave, fr, fq);
        }
        const float gate = GT[tok * 48 + 2 * 16 + head];
        const float sc = st.lrun > 0.f ? gate / st.lrun : 0.f;
#pragma unroll
        for (int dt = 0; dt < 8; ++dt) outacc[dt] += st.o[dt] * sc;
    }
#endif
#pragma unroll
    for (int dt = 0; dt < 8; ++dt) {
        u32x2 o = {pack2(outacc[dt][0], outacc[dt][1]), pack2(outacc[dt][2], outacc[dt][3])};
        *(u32x2*)(Y + tok * 2048 + head * 128 + 16 * dt + 4 * fq) = o;
    }
    __syncthreads();
}
__device__ __forceinline__ void phase_attn(const Params& P, LAS unsigned char* lds) {
    for (int it = blockIdx.x; it < 2048; it += gridDim.x) attn_item(P, lds, it);
}

constexpr int N_PHASES = 25;
constexpr int LDS_BYTES = 131072;

template <class Epi>
__device__ __forceinline__ void run_gemm(LAS unsigned char* lds, const bf16_t* A, const bf16_t* Bt, int N, int K, const Epi& E) {
    pg8::Gemm g{A, Bt, MTOK, N, K};
    pg8::StaticOrder S; S.init(MTOK, N, (int)gridDim.x, (int)blockIdx.x);
    pg8::gemm_phase<Epi, pg8::StaticOrder, false>((PG8_LAS unsigned char*)lds, g, S, E, nullptr);
}

__global__ void __launch_bounds__(512, 2) mega(Params P) {
    extern __shared__ __attribute__((aligned(16))) unsigned char shm[];
    LAS unsigned char* lds = (LAS unsigned char*)shm;
    cg::grid_group grid = cg::this_grid();
    unsigned char* ws = P.ws;
    bf16_t* ABUF = (bf16_t*)(ws + OFF_ABUF); bf16_t* BIG = (bf16_t*)(ws + OFF_BIG);
    float* H = P.out;
    for (int ph = P.ph_lo; ph < P.ph_hi; ++ph) {
        int f = -1, sub = -1;
        if (ph >= 1 && ph <= 3) { f = 0; sub = ph - 1; }
        else if (ph >= 10 && ph <= 12) { f = 1; sub = ph - 10; }
        else if (ph >= 13 && ph <= 15) { f = 2; sub = ph - 13; }
        else if (ph >= 21 && ph <= 23) { f = 3; sub = ph - 21; }
        if (ph == 0) phase_prep(P, lds);
        else if (f >= 0) {
            if (sub == 0) phase_norm(f == 0 ? P.in[0] : H, P.in[1] + (size_t)f * DM, ABUF);
            else if (sub == 1) { EpiSwiGLU E{BIG}; run_gemm(lds, ABUF, (const bf16_t*)(ws + OFF_WGU + f * SZ_GU), 11264, 2048, E); }
            else { EpiResid E{f == 0 ? P.in[0] : H, H, 0.5f}; run_gemm(lds, BIG, (const bf16_t*)(ws + OFF_WDN + f * SZ_DN), 2048, 5632, E); }
        }
        else if (ph == 4) phase_norm(H, P.in[5], ABUF);
        else if (ph == 16) phase_norm(H, P.in[5] + DM, ABUF);
        else if (ph == 5) {
            phase_skinny<1, 0>(ABUF, (const bf16_t*)(ws + OFF_WABIN) + (size_t)6144 * 2048, (float*)(ws + OFF_GATES), P.in[7]);
            EpiProj0 E{BIG}; run_gemm(lds, ABUF, (const bf16_t*)(ws + OFF_WABIN), 6144, 2048, E);
        }
        else if (ph == 6) phase_conv_gmlp(P, lds);
        else if (ph == 7) phase_mlstm(P, lds);
        else if (ph == 8) phase_htnorm(P);
        else if (ph == 9) { EpiResid E{H, H, 1.0f}; run_gemm(lds, ABUF, (const bf16_t*)(ws + OFF_WABOUT), 2048, 2048, E); }
        else if (ph == 17) {
            phase_skinny<3, 1>(ABUF, (const bf16_t*)(ws + OFF_WNSAIN) + (size_t)5120 * 2048, (float*)(ws + OFF_GATES), nullptr);
            EpiProj1 E{BIG, (const float*)(ws + OFF_ROPE)}; run_gemm(lds, ABUF, (const bf16_t*)(ws + OFF_WNSAIN), 5120, 2048, E);
        }
        else if (ph == 18) phase_compress(P, lds);
        else if (ph == 19) phase_attn(P, lds);
        else if (ph == 20) { EpiResid E{H, H, 1.0f}; run_gemm(lds, ABUF, (const bf16_t*)(ws + OFF_WNSAOUT), 2048, 2048, E); }
        else if (ph == 24) phase_final_norm(H, P.in[19]);
        if (ph + 1 < P.ph_hi) grid.sync();
    }
}

extern "C" void kernel_launch(void* const* d_in, const int* in_sizes, int n_in, void* d_out, int out_size, void* d_ws, size_t ws_size, hipStream_t stream) {
    static int grid = 0;
    if (grid == 0) {
        if (n_in != 20 || out_size != MTOK * DM || ws_size < WS_END) { fprintf(stderr, "kernel_launch: unexpected shapes (n_in %d out %d ws %zu need %zu)\n", n_in, out_size, ws_size, (size_t)WS_END); grid = -1; return; }
        int dev = 0, cus = 0, per_cu = 0;
        hipGetDevice(&dev);
        hipDeviceGetAttribute(&cus, hipDeviceAttributeMultiprocessorCount, dev);
        if (hipFuncSetAttribute((const void*)mega, hipFuncAttributeMaxDynamicSharedMemorySize, LDS_BYTES) != hipSuccess) { fprintf(stderr, "kernel_launch: hipFuncSetAttribute failed\n"); grid = -1; return; }
        if (hipOccupancyMaxActiveBlocksPerMultiprocessor(&per_cu, (const void*)mega, 512, LDS_BYTES) != hipSuccess || per_cu < 1) { fprintf(stderr, "kernel_launch: occupancy query says %d\n", per_cu); per_cu = 1; }
        (void)hipGetLastError();
        grid = cus * per_cu;
        if (grid > 256) grid = 256;
    }
    if (grid < 0) return;
    Params p{};
    for (int i = 0; i < 20; ++i) p.in[i] = (const float*)d_in[i];
    p.out = (float*)d_out; p.ws = (unsigned char*)d_ws;
#ifndef MULTI_LAUNCH
    p.ph_lo = 0; p.ph_hi = N_PHASES;
    void* args[] = {&p};
    hipError_t e = hipLaunchCooperativeKernel((const void*)mega, dim3(grid), dim3(512), args, LDS_BYTES, stream);
    if (e != hipSuccess) fprintf(stderr, "cooperative launch failed: %s (grid %d)\n", hipGetErrorString(e), grid);
#else
    for (int ph = 0; ph < N_PHASES; ++ph) {
        p.ph_lo = ph; p.ph_hi = ph + 1;
        void* args[] = {&p};
        hipError_t e = hipLaunchCooperativeKernel((const void*)mega, dim3(grid), dim3(512), args, LDS_BYTES, stream);
        if (e != hipSuccess) { fprintf(stderr, "launch %d failed: %s\n", ph, hipGetErrorString(e)); break; }
    }
#endif
}
```

```cpp
#define SKIP_ALPHA 1
#include <hip/hip_runtime.h>
#include <hip/hip_cooperative_groups.h>
#include <cstdio>
namespace cg = cooperative_groups;
namespace pg8 {
#define PG8_LAS __attribute__((address_space(3)))
typedef unsigned short bf16_t;
typedef short bf16x8 __attribute__((ext_vector_type(8)));
typedef float f32x4 __attribute__((ext_vector_type(4)));
typedef unsigned u32x4 __attribute__((ext_vector_type(4)));
constexpr int BM = 256, BK = 64, HALF = 128, HTB = HALF * BK * 2  , STAGE_BYTES = 8 * HTB, NXCD = 8, WGM = 8;

__host__ __device__ __forceinline__ int lds_byte(int r, int c) { const int st = (r >> 4) * 2 + (c >> 5), rr = r & 15, cc = c & 31, ob = rr * 64 + cc * 2; return st * 1024 + (ob ^ (((ob >> 9) & 1) << 5)); }
__host__ __device__ __forceinline__ void stage_rc(int b, int& R, int& C) { const int st = b / 1024, sb = b % 1024, swz = sb ^ (((sb >> 9) & 1) << 5); R = (st >> 1) * 16 + swz / 64; C = (st & 1) * 32 + (swz % 64) / 2; }
__host__ __device__ __forceinline__ int perm32(int rho) { const int n = rho >> 4, i = rho & 15; return 8 * (i >> 2) + 4 * n + (i & 3); }

struct Unit { int pm, pn; };
struct Gemm { const bf16_t* A; const bf16_t* Bt; int M, N, K; };

struct StaticOrder {
    int nM, nN, nwg, G, c;
    __host__ __device__ void init(int M, int N, int G_, int c_) { nM = M / BM; nN = N / BM; nwg = nM * nN; G = G_; c = c_; }
    __host__ __device__ bool next(int i, Unit& u) const {
        const long L = (long)i * G + c; if (L >= nwg) return false;
        int wgid = (int)L; { const int q = nwg / NXCD, r = nwg % NXCD, xcd = wgid % NXCD, off = wgid / NXCD; wgid = (xcd < r ? xcd * (q + 1) : r * (q + 1) + (xcd - r) * q) + off; }
        const int nig = WGM * nN, gid = wgid / nig, fm = gid * WGM, gsz = (nM - fm) < WGM ? (nM - fm) : WGM;
        u.pm = fm + ((wgid % nig) % gsz); u.pn = (wgid % nig) / gsz; return true;
    }
    __device__ __forceinline__ void a_ready(const Unit&) const {}
    __device__ __forceinline__ void done(const Unit&) const {}
};
template <class Epi, class Sched, bool STAMP = false>
__device__ __forceinline__ void gemm_phase(PG8_LAS unsigned char* lds, const Gemm g, const Sched& S, const Epi& E, unsigned long long* stamps) {
    int tid_ = threadIdx.x; asm volatile("" : "+v"(tid_)); const int tid = tid_, wid = __builtin_amdgcn_readfirstlane(tid >> 6), lane = tid & 63, wr = wid >> 2, wc = wid & 3, fr = lane & 15, fq = lane >> 4;
    const int K = g.K, nt = K / BK;
#define PG8_STAMP() do {} while (0)
    PG8_STAMP();
    unsigned voffA[2], voffB[2];
#pragma unroll
    for (int i = 0; i < 2; ++i) { int R, C; stage_rc(tid * 16 + i * 8192, R, C); const int Rb = Epi::PERM ? ((R & ~31) + perm32(R & 31)) : R;
        voffA[i] = (unsigned)(R * K + C) * 2u; voffB[i] = (unsigned)(Rb * K + C) * 2u; }
    const size_t kstep = (size_t)(BK * 2);
    const size_t hstep = (size_t)HALF * K * 2;
    const size_t tstep = 2 * hstep;
    const unsigned ldsw = (unsigned)wid * 1024u;
    const int aoff = lds_byte(wr * 64 + fr, fq * 8), boff = lds_byte(wc * 32 + fr, fq * 8);
#define PG8_SA(b, h) (((b) * 2 + (h)) * HTB)
#define PG8_SB(b, h) ((4 + (b) * 2 + (h)) * HTB)
#define PG8_STAGE(bufoff, gbase, voff) do { _Pragma("unroll") for (int _i = 0; _i < 2; ++_i) \
        __builtin_amdgcn_global_load_lds((const unsigned*)((const char*)(gbase) + (voff)[_i]), (PG8_LAS unsigned*)(lds + (bufoff) + ldsw + _i * 8192), 16, 0, 0); } while (0)
#define PG8_LDA(dst, b, h) do { _Pragma("unroll") for (int m = 0; m < 4; ++m) _Pragma("unroll") for (int k = 0; k < 2; ++k) dst[m][k] = *(const PG8_LAS bf16x8*)(lds + PG8_SA(b, h) + aoff + m * 2048 + k * 1024); } while (0)
#define PG8_LDB(dst, b, h) do { _Pragma("unroll") for (int n = 0; n < 2; ++n) _Pragma("unroll") for (int k = 0; k < 2; ++k) dst[n][k] = *(const PG8_LAS bf16x8*)(lds + PG8_SB(b, h) + boff + n * 2048 + k * 1024); } while (0)
#define PG8_MMA(ai, bj, At, Bt) do { __builtin_amdgcn_s_setprio(1); _Pragma("unroll") for (int m = 0; m < 4; ++m) _Pragma("unroll") for (int n = 0; n < 2; ++n) _Pragma("unroll") for (int k = 0; k < 2; ++k) \
        acc[ai][bj][m][n] = __builtin_amdgcn_mfma_f32_16x16x32_bf16(Bt[n][k], At[m][k], acc[ai][bj][m][n], 0, 0, 0); __builtin_amdgcn_s_setprio(0); } while (0)
#define PG8_WAIT_V(n) asm volatile("s_waitcnt vmcnt(" #n ")" ::: "memory")
#define PG8_WAIT_L(n) asm volatile("s_waitcnt lgkmcnt(" #n ")" ::: "memory")
#define PG8_BAR __builtin_amdgcn_s_barrier()
#define PG8_SCHED __builtin_amdgcn_sched_barrier(0)
    Unit cur, nxt; int ui = 0;
    if (!S.next(0, cur)) return;
    f32x4 acc[2][2][4][2];
#pragma unroll
    for (int a = 0; a < 2; ++a)
#pragma unroll
        for (int b = 0; b < 2; ++b)
#pragma unroll
            for (int m = 0; m < 4; ++m)
#pragma unroll
                for (int n = 0; n < 2; ++n) acc[a][b][m][n] = (f32x4){0.f, 0.f, 0.f, 0.f};
    bf16x8 At[4][2], B0[2][2], B1[2][2];
    const char* cA = (const char*)g.A + (size_t)cur.pm * tstep; const char* cB = (const char*)g.Bt + (size_t)cur.pn * tstep;
    S.a_ready(cur);
    typename Epi::Pre pre = E.pre(cur, wr, fr);
    PG8_STAGE(PG8_SB(0, 0), cB, voffB); PG8_STAGE(PG8_SA(0, 0), cA, voffA); PG8_STAGE(PG8_SB(0, 1), cB + hstep, voffB); PG8_STAGE(PG8_SA(0, 1), cA + hstep, voffA);
    if (wr == 1) PG8_BAR;
    PG8_WAIT_V(4); PG8_BAR;
    PG8_STAGE(PG8_SB(1, 0), cB + kstep, voffB); PG8_STAGE(PG8_SA(1, 0), cA + kstep, voffA); PG8_STAGE(PG8_SB(1, 1), cB + hstep + kstep, voffB);
    PG8_WAIT_V(6); PG8_BAR;
    PG8_STAMP();
    for (;;) {
        const bool has_next = S.next(ui + 1, nxt);
        const char* nA = has_next ? (const char*)g.A + (size_t)nxt.pm * tstep : cA; const char* nB = has_next ? (const char*)g.Bt + (size_t)nxt.pn * tstep : cB;
        for (int t = 0; t < nt; t += 2) {
            const bool last = (t == nt - 2);
            const char* a1 = cA + (size_t)(t + 1) * kstep;
            const char* a2 = last ? nA : cA + (size_t)(t + 2) * kstep; const char* b2 = last ? nB : cB + (size_t)(t + 2) * kstep;
            const char* a3 = a2 + kstep; const char* b3 = b2 + kstep;
            if (last && has_next) S.a_ready(nxt);
            PG8_LDB(B0, 0, 0); PG8_SCHED; PG8_LDA(At, 0, 0); PG8_STAGE(PG8_SA(1, 1), a1 + hstep, voffA);
            PG8_WAIT_L(8); PG8_BAR; PG8_WAIT_L(0); PG8_MMA(0, 0, At, B0); PG8_BAR; PG8_SCHED;
            PG8_LDB(B1, 0, 1); PG8_STAGE(PG8_SB(0, 0), b2, voffB);
            PG8_BAR; PG8_WAIT_L(0); PG8_MMA(0, 1, At, B1); PG8_BAR;
            PG8_LDA(At, 0, 1); PG8_STAGE(PG8_SA(0, 0), a2, voffA);
            PG8_BAR; PG8_WAIT_L(0); PG8_MMA(1, 0, At, B0); PG8_BAR; PG8_SCHED;
            PG8_STAGE(PG8_SB(0, 1), b2 + hstep, voffB);
            PG8_WAIT_V(6); PG8_BAR; PG8_MMA(1, 1, At, B1); PG8_BAR;
            PG8_LDB(B0, 1, 0); PG8_SCHED; PG8_LDA(At, 1, 0); PG8_STAGE(PG8_SA(0, 1), a2 + hstep, voffA);
            PG8_WAIT_L(8); PG8_BAR; PG8_WAIT_L(0); PG8_MMA(0, 0, At, B0); PG8_BAR; PG8_SCHED;
            PG8_LDB(B1, 1, 1); PG8_STAGE(PG8_SB(1, 0), b3, voffB);
            PG8_BAR; PG8_WAIT_L(0); PG8_MMA(0, 1, At, B1); PG8_BAR;
            PG8_LDA(At, 1, 1); PG8_STAGE(PG8_SA(1, 0), a3, voffA);
            PG8_BAR; PG8_WAIT_L(0); PG8_MMA(1, 0, At, B0); PG8_BAR; PG8_SCHED;
            PG8_STAGE(PG8_SB(1, 1), b3 + hstep, voffB);
            PG8_WAIT_V(6); PG8_BAR; PG8_MMA(1, 1, At, B1); PG8_BAR;
        }
        PG8_STAMP();
        if constexpr (!Epi::AFTER_DRAIN) { E(acc, cur, wr, wc, fr, fq, pre); S.done(cur); }
        PG8_STAMP();
        if (!has_next) break;
#pragma unroll
        for (int a = 0; a < 2; ++a)
#pragma unroll
            for (int b = 0; b < 2; ++b)
#pragma unroll
                for (int m = 0; m < 4; ++m)
#pragma unroll
                    for (int n = 0; n < 2; ++n) acc[a][b][m][n] = (f32x4){0.f, 0.f, 0.f, 0.f};
        cur = nxt; cA = nA; cB = nB; ++ui;
        pre = E.pre(cur, wr, fr);
    }
    PG8_WAIT_V(0);
    if (wr == 0) PG8_BAR;
    PG8_BAR;
    if constexpr (Epi::AFTER_DRAIN) { E.fused(acc, cur, wr, wc, fr, fq, lds, wid, lane); S.done(cur); }
    PG8_STAMP();
#undef PG8_STAMP
#undef PG8_SA
#undef PG8_SB
#undef PG8_STAGE
#undef PG8_LDA
#undef PG8_LDB
#undef PG8_MMA
#undef PG8_WAIT_V
#undef PG8_WAIT_L
#undef PG8_BAR
#undef PG8_SCHED
}
}
using pg8::bf16_t; using pg8::bf16x8; using pg8::f32x4; using pg8::u32x4; using pg8::Unit;
#define LAS __attribute__((address_space(3)))
typedef unsigned u32x2 __attribute__((ext_vector_type(2)));

constexpr int MTOK = 16384, DM = 2048, DFF = 5632, SEQL = 4096;
constexpr float EPSN = 1e-6f;

struct Params { const float* in[20]; float* out; unsigned char* ws; int ph_lo, ph_hi; };

constexpr size_t SZ_GU = (size_t)11264 * 2048 * 2, SZ_DN = (size_t)2048 * 5632 * 2;
constexpr size_t OFF_WGU = 0;
constexpr size_t OFF_WDN = OFF_WGU + 4 * SZ_GU;
constexpr size_t OFF_WABIN = OFF_WDN + 4 * SZ_DN;
constexpr size_t OFF_WABOUT = OFF_WABIN + (size_t)6208 * 2048 * 2;
constexpr size_t OFF_WNSAIN = OFF_WABOUT + (size_t)2048 * 2048 * 2;
constexpr size_t OFF_WNSAOUT = OFF_WNSAIN + (size_t)5184 * 2048 * 2;
constexpr size_t OFF_WC1 = OFF_WNSAOUT + (size_t)2048 * 2048 * 2;
constexpr size_t OFF_WC2 = OFF_WC1 + (size_t)2 * 128 * 4096 * 2;
constexpr size_t OFF_ABUF = OFF_WC2 + (size_t)2 * 128 * 128 * 2;
constexpr size_t OFF_BIG = OFF_ABUF + (size_t)MTOK * 2048 * 2;
constexpr size_t OFF_AUX1 = OFF_BIG + (size_t)MTOK * 6144 * 2 + 262144;
constexpr size_t OFF_AUX2 = OFF_AUX1 + (size_t)MTOK * 2048 * 2;
constexpr size_t OFF_KT = OFF_AUX2 + (size_t)MTOK * 1024 * 4;
constexpr size_t OFF_GATES = OFF_KT + (size_t)MTOK * 1024 * 2;
constexpr size_t OFF_ROPE = OFF_GATES + (size_t)MTOK * 48 * 4;
constexpr size_t OFF_KCMP = OFF_ROPE + (size_t)4096 * 32 * 4;
constexpr size_t OFF_VCMPT = OFF_KCMP + (size_t)16 * 256 * 128 * 2;
constexpr size_t OFF_SS = OFF_VCMPT + (size_t)16 * 128 * 256 * 2;
constexpr size_t OFF_BAR = OFF_SS + (size_t)6 * MTOK * 4;
constexpr size_t OFF_XB = OFF_BAR + 256;
constexpr size_t WS_END = OFF_XB + 1024 + 17 * 256;

__device__ __forceinline__ int otid() { int t = threadIdx.x; asm volatile("" : "+v"(t)); return t; }
__device__ __forceinline__ unsigned f2bf(float f) { unsigned u = __float_as_uint(f); u += 0x7FFFu + ((u >> 16) & 1u); return u >> 16; }
typedef float f32x2v __attribute__((ext_vector_type(2)));
typedef __bf16 bf16x2v __attribute__((ext_vector_type(2)));
__device__ __forceinline__ unsigned pack2(float a, float b) { f32x2v v = {a, b}; bf16x2v r = __builtin_convertvector(v, bf16x2v); return __builtin_bit_cast(unsigned, r); }
__device__ __forceinline__ float bflo(unsigned u) { return __uint_as_float(u << 16); }
__device__ __forceinline__ float bfhi(unsigned u) { return __uint_as_float(u & 0xFFFF0000u); }
__device__ __forceinline__ float bfs(short s) { return __uint_as_float(((unsigned)(unsigned short)s) << 16); }
__device__ __forceinline__ f32x4 mfma16(bf16x8 x, bf16x8 y, f32x4 c) { return __builtin_amdgcn_mfma_f32_16x16x32_bf16(x, y, c, 0, 0, 0); }
__device__ __forceinline__ bf16x8 ld8(const bf16_t* p) { return *(const bf16x8*)p; }
__device__ __forceinline__ bf16x8 lds8(const LAS bf16_t* p) { return *(const LAS bf16x8*)p; }
typedef short s16x4 __attribute__((ext_vector_type(4)));
__device__ __forceinline__ s16x4 lds_tr4(const LAS bf16_t* p) { return __builtin_amdgcn_ds_read_tr16_b64_v4i16((LAS s16x4*)p); }
__device__ __forceinline__ bf16x8 mk8(float a, float b, float c, float d, float e, float f, float g, float h) {
    u32x4 u = {pack2(a, b), pack2(c, d), pack2(e, f), pack2(g, h)}; return __builtin_bit_cast(bf16x8, u); }
__device__ __forceinline__ float xmax4(float x) {
    auto r = __builtin_amdgcn_permlane32_swap(__float_as_uint(x), __float_as_uint(x), false, false);
    x = fmaxf(__uint_as_float(r[0]), __uint_as_float(r[1]));
    auto r2 = __builtin_amdgcn_permlane16_swap(__float_as_uint(x), __float_as_uint(x), false, false);
    return fmaxf(__uint_as_float(r2[0]), __uint_as_float(r2[1]));
}
__device__ __forceinline__ float xsum4(float x) {
    auto r = __builtin_amdgcn_permlane32_swap(__float_as_uint(x), __float_as_uint(x), false, false);
    x = __uint_as_float(r[0]) + __uint_as_float(r[1]);
    auto r2 = __builtin_amdgcn_permlane16_swap(__float_as_uint(x), __float_as_uint(x), false, false);
    return __uint_as_float(r2[0]) + __uint_as_float(r2[1]);
}
__device__ __forceinline__ float wave_sum(float v) { for (int o = 32; o; o >>= 1) v += __shfl_xor(v, o); return v; }
__device__ __forceinline__ float sigm(float x) { return __builtin_amdgcn_rcpf(1.f + __expf(-x)); }
__device__ __forceinline__ float silu(float x) { return x * __builtin_amdgcn_rcpf(1.f + __expf(-x)); }
__device__ __forceinline__ float gelu_t(float x) { return x * __builtin_amdgcn_rcpf(1.f + __expf(-1.5957691216f * (x + 0.044715f * x * x * x))); }

struct EpiSwiGLU {
    static constexpr bool PERM = true, AFTER_DRAIN = false;
    bf16_t* O; const float* SS; const LAS float* lrs; int pm0;
    struct Pre { };
    __device__ __forceinline__ Pre pre(const Unit&, int, int) const { return Pre{}; }
    __device__ __forceinline__ float rstd_of(const Unit& u, int lrow) const {
        if (u.pm == pm0) return lrs[lrow];
        return rsqrtf(SS[u.pm * 256 + lrow] * (1.0f / 2048.0f) + EPSN);
    }
    __device__ __forceinline__ void operator()(const f32x4 (&acc)[2][2][4][2], const Unit& u, int wr, int wc, int fr, int fq, const Pre& pre) const {
        const int row0 = u.pm * 256 + wr * 64 + fr, col0 = u.pn * 128 + wc * 32 + 8 * fq;
#pragma unroll
        for (int ai = 0; ai < 2; ++ai)
#pragma unroll
            for (int m = 0; m < 4; ++m) {
                const float rs = rstd_of(u, wr * 64 + ai * 128 + m * 16 + fr);
                float h[8];
#pragma unroll
                for (int n = 0; n < 2; ++n)
#pragma unroll
                    for (int j = 0; j < 4; ++j) h[4 * n + j] = silu(acc[ai][0][m][n][j] * rs) * (acc[ai][1][m][n][j] * rs);
                u32x4 o = {pack2(h[0], h[1]), pack2(h[2], h[3]), pack2(h[4], h[5]), pack2(h[6], h[7])};
                *(u32x4*)(O + (size_t)(row0 + ai * 128 + m * 16) * DFF + col0) = o;
            }
    }
};
template <bool COPY> struct EpiResid {
    static constexpr bool PERM = false, AFTER_DRAIN = false;
    const float* R; float* O; bf16_t* Ob; float* SS; float scale;
    struct Pre { };
    __device__ __forceinline__ Pre pre(const Unit&, int, int) const { return Pre{}; }
    __device__ __forceinline__ void operator()(const f32x4 (&acc)[2][2][4][2], const Unit& u, int wr, int wc, int fr, int fq, const Pre& pre) const {
        const int row0 = u.pm * 256 + wr * 64 + fr, col0 = u.pn * 256 + wc * 32 + 4 * fq;
#pragma unroll
        for (int ai = 0; ai < 2; ++ai) {
            f32x4 rv[4][2][2];
#pragma unroll
            for (int m = 0; m < 4; ++m)
#pragma unroll
                for (int bj = 0; bj < 2; ++bj)
#pragma unroll
                    for (int n = 0; n < 2; ++n) rv[m][bj][n] = *(const f32x4*)(R + (size_t)(row0 + ai * 128 + m * 16) * DM + col0 + bj * 128 + n * 16);
#pragma unroll
            for (int m = 0; m < 4; ++m) {
                const size_t ro = (size_t)(row0 + ai * 128 + m * 16) * DM + col0;
                float ss = 0.f;
#pragma unroll
                for (int bj = 0; bj < 2; ++bj)
#pragma unroll
                    for (int n = 0; n < 2; ++n) {
                        const f32x4 hv = rv[m][bj][n] + acc[ai][bj][m][n] * scale;
                        *(f32x4*)(O + ro + bj * 128 + n * 16) = hv;
                        if (COPY) {
                            u32x2 o = {pack2(hv[0], hv[1]), pack2(hv[2], hv[3])};
                            *(u32x2*)(Ob + ro + bj * 128 + n * 16) = o;
                            ss += hv[0] * hv[0] + hv[1] * hv[1] + hv[2] * hv[2] + hv[3] * hv[3];
                        }
                    }
                if (COPY) { ss = xsum4(ss); if (fq == 0) (void)__hip_atomic_fetch_add(SS + row0 + ai * 128 + m * 16, ss, __ATOMIC_RELAXED, __HIP_MEMORY_SCOPE_AGENT); }
            }
        }
    }
};
struct EpiProj0 {
    static constexpr bool PERM = true, AFTER_DRAIN = false;
    bf16_t* O; const float* SS; const LAS float* lrs; int pm0;
    struct Pre { };
    __device__ __forceinline__ Pre pre(const Unit&, int, int) const { return Pre{}; }
    __device__ __forceinline__ float rstd_of(const Unit& u, int lrow) const {
        if (u.pm == pm0) return lrs[lrow];
        return rsqrtf(SS[u.pm * 256 + lrow] * (1.0f / 2048.0f) + EPSN);
    }
    __device__ __forceinline__ void operator()(const f32x4 (&acc)[2][2][4][2], const Unit& u, int wr, int wc, int fr, int fq, const Pre& pre) const {
        const int row0 = u.pm * 256 + wr * 64 + fr, col0 = u.pn * 256 + wc * 32 + 8 * fq;
        const bool g = u.pn < 8;
#pragma unroll
        for (int ai = 0; ai < 2; ++ai)
#pragma unroll
            for (int m = 0; m < 4; ++m) {
                const float rs = rstd_of(u, wr * 64 + ai * 128 + m * 16 + fr);
#pragma unroll
                for (int bj = 0; bj < 2; ++bj) {
                    float h[8];
#pragma unroll
                    for (int n = 0; n < 2; ++n)
#pragma unroll
                        for (int j = 0; j < 4; ++j) { const float v = acc[ai][bj][m][n][j] * rs; h[4 * n + j] = g ? gelu_t(v) : v; }
                    u32x4 o = {pack2(h[0], h[1]), pack2(h[2], h[3]), pack2(h[4], h[5]), pack2(h[6], h[7])};
                    *(u32x4*)(O + (size_t)(row0 + ai * 128 + m * 16) * 6144 + col0 + bj * 128) = o;
                }
            }
    }
};
struct EpiProj1 {
    static constexpr bool PERM = false, AFTER_DRAIN = false;
    bf16_t* O; const float* rope; const float* SS; const LAS float* lrs; int pm0;
    struct Pre { };
    __device__ __forceinline__ Pre pre(const Unit&, int, int) const { return Pre{}; }
    __device__ __forceinline__ float rstd_of(const Unit& u, int lrow) const {
        if (u.pm == pm0) return lrs[lrow];
        return rsqrtf(SS[u.pm * 256 + lrow] * (1.0f / 2048.0f) + EPSN);
    }
    __device__ __forceinline__ void operator()(const f32x4 (&acc)[2][2][4][2], const Unit& u, int wr, int wc, int fr, int fq, const Pre& pre) const {
        const int row0 = u.pm * 256 + wr * 64 + fr, col0 = u.pn * 256 + wc * 32 + 4 * fq;
#pragma unroll
        for (int ai = 0; ai < 2; ++ai) {
            f32x4 rcos[4], rsin[4];
            if (wc == 0) {
#pragma unroll
                for (int m = 0; m < 4; ++m) { const float* rp = rope + (size_t)((row0 + ai * 128 + m * 16) & 4095) * 32 + 4 * fq; rcos[m] = *(const f32x4*)rp; rsin[m] = *(const f32x4*)(rp + 16); }
            }
#pragma unroll
            for (int bj = 0; bj < 2; ++bj) {
                const int head = u.pn * 2 + bj;
                const bool isq = head < 16;
                const bool dorope = (wc == 0) && (isq || ((((head - 16) >> 2) & 1) == 0));
                const float sc = isq ? 0.08838834764831845f * 1.4426950408889634f : 1.f;
#pragma unroll
                for (int m = 0; m < 4; ++m) {
                    const int row = row0 + ai * 128 + m * 16;
                    const float rs = rstd_of(u, wr * 64 + ai * 128 + m * 16 + fr) * sc;
                    f32x4 v0 = acc[ai][bj][m][0] * rs, v1 = acc[ai][bj][m][1] * rs;
                    if (dorope) {
                        const f32x4 c = rcos[m], s = rsin[m];
                        const f32x4 a = v0 * c - v1 * s, b = v0 * s + v1 * c; v0 = a; v1 = b;
                    }
                    bf16_t* op = O + (size_t)row * 5120 + col0 + bj * 128;
                    u32x2 o0 = {pack2(v0[0], v0[1]), pack2(v0[2], v0[3])}, o1 = {pack2(v1[0], v1[1]), pack2(v1[2], v1[3])};
                    *(u32x2*)op = o0; *(u32x2*)(op + 16) = o1;
                }
            }
        }
    }
};

struct Job { const float* src; bf16_t* dst; const float* gain; int K, ldn, nvalid, ntn, remap, off; };
__device__ __forceinline__ void make_job(const Params& P, int j, Job& J) {
    unsigned char* ws = P.ws;
    J.gain = nullptr;
    if (j < 12) {
        const int fi = j / 3, kind = j - 3 * fi;
        if (kind < 2) { J.src = P.in[2 + kind] + (size_t)fi * 2048 * 5632; J.dst = (bf16_t*)(ws + OFF_WGU + fi * SZ_GU); J.K = 2048; J.ldn = 5632; J.nvalid = 5632; J.ntn = 88; J.remap = 1; J.off = kind * 128; J.gain = P.in[1] + (size_t)fi * 2048; }
        else { J.src = P.in[4] + (size_t)fi * 5632 * 2048; J.dst = (bf16_t*)(ws + OFF_WDN + fi * SZ_DN); J.K = 5632; J.ldn = 2048; J.nvalid = 2048; J.ntn = 32; J.remap = 0; J.off = 0; }
    } else if (j == 12) { J.src = P.in[6]; J.dst = (bf16_t*)(ws + OFF_WABIN); J.K = 2048; J.ldn = 6152; J.nvalid = 6152; J.ntn = 97; J.remap = 0; J.off = 0; J.gain = P.in[5]; }
    else if (j == 13) { J.src = P.in[13]; J.dst = (bf16_t*)(ws + OFF_WABOUT); J.K = 2048; J.ldn = 2048; J.nvalid = 2048; J.ntn = 32; J.remap = 0; J.off = 0; }
    else if (j == 14) { J.src = P.in[14]; J.dst = (bf16_t*)(ws + OFF_WNSAIN); J.K = 2048; J.ldn = 5168; J.nvalid = 5168; J.ntn = 81; J.remap = 0; J.off = 0; J.gain = P.in[5] + 2048; }
    else if (j == 15) { J.src = P.in[18]; J.dst = (bf16_t*)(ws + OFF_WNSAOUT); J.K = 2048; J.ldn = 2048; J.nvalid = 2048; J.ntn = 32; J.remap = 0; J.off = 0; }
    else if (j < 18) { const int kv = j - 16; J.src = P.in[16] + (size_t)kv * 4096 * 128; J.dst = (bf16_t*)(ws + OFF_WC1) + (size_t)kv * 128 * 4096; J.K = 4096; J.ldn = 128; J.nvalid = 128; J.ntn = 2; J.remap = 0; J.off = 0; }
    else { const int kv = j - 18; J.src = P.in[17] + (size_t)kv * 128 * 128; J.dst = (bf16_t*)(ws + OFF_WC2) + (size_t)kv * 128 * 128; J.K = 128; J.ldn = 128; J.nvalid = 128; J.ntn = 2; J.remap = 0; J.off = 0; }
}
constexpr int NT_CONVERT = 12 * 1408 + 16 * 97 + 16 * 32 + 16 * 81 + 16 * 32 + 2 * 64 + 2 * 2;
__device__ __forceinline__ void phase_prep(const Params& P, LAS unsigned char* lds) {
    LAS float* tile = (LAS float*)lds;
    const int tid = otid();
    if (tid == 0) ((unsigned*)(P.ws + OFF_XB))[blockIdx.x] = (unsigned)__builtin_amdgcn_s_getreg((3 << 11) | 20) & 0xFu;
    if (blockIdx.x == 0 && tid < 17) __hip_atomic_store((unsigned*)(P.ws + OFF_XB + 1024 + 256 * tid), 0u, __ATOMIC_RELAXED, __HIP_MEMORY_SCOPE_AGENT);
    {
        const int idx = blockIdx.x * 512 + tid;
        if (idx < 4096 * 16) {
            const int pos = idx >> 4, i = idx & 15;
            const float inv = 1.0f / powf(500000.0f, (float)i * (1.0f / 16.0f));
            const float ang = (float)pos * inv;
            float s, c; sincosf(ang, &s, &c);
            float* rp = (float*)(P.ws + OFF_ROPE) + (size_t)pos * 32;
            rp[i] = c; rp[16 + i] = s;
        }
    }
    {
        float* SS = (float*)(P.ws + OFF_SS); bf16_t* XB = (bf16_t*)(P.ws + OFF_ABUF);
        for (int i = blockIdx.x * 512 + tid; i < 5 * MTOK; i += gridDim.x * 512) SS[MTOK + i] = 0.f;
        const int wave = tid >> 6, lane = tid & 63;
        for (int row = blockIdx.x * 8 + wave; row < MTOK; row += gridDim.x * 8) {
            const float4* s = (const float4*)(P.in[0] + (size_t)row * DM);
            float ss = 0.f;
#pragma unroll
            for (int i = 0; i < 8; ++i) {
                const float4 v = s[lane + 64 * i];
                ss += v.x * v.x + v.y * v.y + v.z * v.z + v.w * v.w;
                u32x2 o = {pack2(v.x, v.y), pack2(v.z, v.w)};
                *(u32x2*)(XB + (size_t)row * DM + 4 * (lane + 64 * i)) = o;
            }
            ss = wave_sum(ss);
            if (lane == 0) SS[row] = ss;
        }
    }
    {
        Job J, Jn; float4 v[4]; int k0 = 0, n0 = 0, k0n = 0, n0n = 0;
#define PREP_FIND(T, JJ, K0, N0) do { int lt_ = (T), j_ = 0; for (;; ++j_) { make_job(P, j_, JJ); const int n_ = (JJ.K >> 7) * JJ.ntn; if (lt_ < n_) break; lt_ -= n_; } \
            const int nkt_ = JJ.K >> 7; K0 = (lt_ % nkt_) * 128; N0 = (lt_ / nkt_) * 64; } while (0)
#define PREP_LOAD(JJ, K0, N0) do { _Pragma("unroll") for (int i = 0; i < 4; ++i) { const int idx = tid + 512 * i, k = idx >> 4, n = (N0) + 4 * (idx & 15); \
            float4 x = make_float4(0.f, 0.f, 0.f, 0.f); if (n < JJ.nvalid) x = *(const float4*)(JJ.src + (size_t)((K0) + k) * JJ.ldn + n); \
            if (JJ.gain) { const float gk = JJ.gain[(K0) + k]; x.x *= gk; x.y *= gk; x.z *= gk; x.w *= gk; } v[i] = x; } } while (0)
        int t = blockIdx.x;
        if (t < NT_CONVERT) { PREP_FIND(t, Jn, k0n, n0n); PREP_LOAD(Jn, k0n, n0n); }
        for (; t < NT_CONVERT; t += gridDim.x) {
            J = Jn; k0 = k0n; n0 = n0n;
#pragma unroll
            for (int i = 0; i < 4; ++i) { const int idx = tid + 512 * i, k = idx >> 4, c4 = idx & 15; LAS float* tp = tile + k * 65 + 4 * c4; tp[0] = v[i].x; tp[1] = v[i].y; tp[2] = v[i].z; tp[3] = v[i].w; }
            __syncthreads();
            if (t + (int)gridDim.x < NT_CONVERT) { PREP_FIND(t + (int)gridDim.x, Jn, k0n, n0n); PREP_LOAD(Jn, k0n, n0n); }
#pragma unroll
            for (int i = 0; i < 2; ++i) {
                const int idx = tid + 512 * i, n = idx >> 4, kg = idx & 15;
                float f[8];
#pragma unroll
                for (int jj = 0; jj < 8; ++jj) f[jj] = tile[(8 * kg + jj) * 65 + n];
                u32x4 o = {pack2(f[0], f[1]), pack2(f[2], f[3]), pack2(f[4], f[5]), pack2(f[6], f[7])};
                const int nn = n0 + n, row = J.remap ? ((nn >> 7) * 256 + J.off + (nn & 127)) : nn;
                *(u32x4*)(J.dst + (size_t)row * J.K + k0 + 8 * kg) = o;
            }
            __syncthreads();
        }
#undef PREP_FIND
#undef PREP_LOAD
    }
}

__device__ __forceinline__ void phase_norm(const float* src, const float* g, bf16_t* dst) {
    const int wave = otid() >> 6, lane = otid() & 63;
    for (int row = blockIdx.x * 8 + wave; row < MTOK; row += gridDim.x * 8) {
        const float4* s = (const float4*)(src + (size_t)row * DM);
        float4 v[8]; float ss = 0.f;
#pragma unroll
        for (int i = 0; i < 8; ++i) { v[i] = s[lane + 64 * i]; ss += v[i].x * v[i].x + v[i].y * v[i].y + v[i].z * v[i].z + v[i].w * v[i].w; }
        ss = wave_sum(ss);
        const float r = rsqrtf(ss * (1.0f / 2048.0f) + EPSN);
#pragma unroll
        for (int i = 0; i < 8; ++i) {
            const float4 gg = ((const float4*)g)[lane + 64 * i];
            u32x2 o = {pack2(v[i].x * r * gg.x, v[i].y * r * gg.y), pack2(v[i].z * r * gg.z, v[i].w * r * gg.w)};
            *(u32x2*)(dst + (size_t)row * DM + 4 * (lane + 64 * i)) = o;
        }
    }
}
__device__ __forceinline__ void phase_final_norm(float* io, const float* g) {
    const int wave = otid() >> 6, lane = otid() & 63;
    for (int row = blockIdx.x * 8 + wave; row < MTOK; row += gridDim.x * 8) {
        float4* s = (float4*)(io + (size_t)row * DM);
        float4 v[8]; float ss = 0.f;
#pragma unroll
        for (int i = 0; i < 8; ++i) { v[i] = s[lane + 64 * i]; ss += v[i].x * v[i].x + v[i].y * v[i].y + v[i].z * v[i].z + v[i].w * v[i].w; }
        ss = wave_sum(ss);
        const float r = rsqrtf(ss * (1.0f / 2048.0f) + EPSN);
#pragma unroll
        for (int i = 0; i < 8; ++i) {
            const float4 gg = ((const float4*)g)[lane + 64 * i];
            s[lane + 64 * i] = make_float4(v[i].x * r * gg.x, v[i].y * r * gg.y, v[i].z * r * gg.z, v[i].w * r * gg.w);
        }
    }
}

template <int NT, int MODE>
__device__ __forceinline__ void phase_skinny(const bf16_t* A, const bf16_t* Bt, float* G, const float* bias, const float* SS) {
    const int wave = otid() >> 6, lane = otid() & 63, fr = lane & 15, fq = lane >> 4;
    for (int rt = blockIdx.x * 8 + wave; rt < MTOK / 16; rt += gridDim.x * 8) {
        f32x4 acc[NT];
#pragma unroll
        for (int n = 0; n < NT; ++n) acc[n] = (f32x4){0.f, 0.f, 0.f, 0.f};
        const bf16_t* ap = A + (size_t)(rt * 16 + fr) * DM + 8 * fq;
        const bf16_t* bp = Bt + (size_t)fr * DM + 8 * fq;
#pragma unroll 8
        for (int ks = 0; ks < 64; ++ks) {
            const bf16x8 a = ld8(ap + 32 * ks);
#pragma unroll
            for (int n = 0; n < NT; ++n) { const bf16x8 b = ld8(bp + (size_t)n * 16 * DM + 32 * ks); acc[n] = mfma16(b, a, acc[n]); }
        }
        const int token = rt * 16 + fr;
        const float rs = rsqrtf(SS[token] * (1.0f / 2048.0f) + EPSN);
        if (MODE == 0) {
            if (fq < 2) { const f32x4 b = *(const f32x4*)(bias + 4 * fq); *(f32x4*)(G + (size_t)token * 8 + 4 * fq) = acc[0] * rs + b; }
        } else {
#pragma unroll
            for (int n = 0; n < NT; ++n) { f32x4 o; for (int j = 0; j < 4; ++j) o[j] = sigm(acc[n][j] * rs); *(f32x4*)(G + (size_t)token * 48 + 16 * n + 4 * fq) = o; }
        }
    }
}


__device__ __forceinline__ void conv_wave_item(const Params& P, int item, int lane) {
    const bf16_t* BIG = (const bf16_t*)(P.ws + OFF_BIG); bf16_t* QK = (bf16_t*)(P.ws + OFF_AUX1); bf16_t* KT = (bf16_t*)(P.ws + OFF_KT);
    const float* cw = P.in[11];
    const int tgp = item >> 5, cgp = item & 31, tg = lane & 7, cg = lane >> 3;
    const int tok0 = tgp * 64 + 8 * tg, c0 = cgp * 64 + 8 * cg, pos0 = tok0 & 4095;
    float w[4][8];
#pragma unroll
    for (int jj = 0; jj < 4; ++jj) { const float4 a = *(const float4*)(cw + jj * 2048 + c0), b = *(const float4*)(cw + jj * 2048 + c0 + 4);
        w[jj][0] = a.x; w[jj][1] = a.y; w[jj][2] = a.z; w[jj][3] = a.w; w[jj][4] = b.x; w[jj][5] = b.y; w[jj][6] = b.z; w[jj][7] = b.w; }
    bf16x8 xr[11];
#pragma unroll
    for (int r = 0; r < 11; ++r) {
        const bool ok = (r >= 3) || (pos0 != 0);
        const int t = ok ? (tok0 - 3 + r) : tok0;
        const bf16x8 v = ld8(BIG + (size_t)t * 6144 + 2048 + c0);
        xr[r] = ok ? v : (bf16x8){0, 0, 0, 0, 0, 0, 0, 0};
    }
    const float ksc = (c0 >= 1024) ? 0.0625f : 1.0f;
    float o[8][8];
#pragma unroll
    for (int i = 0; i < 8; ++i)
#pragma unroll
        for (int j = 0; j < 8; ++j) {
            float a = 0.f;
#pragma unroll
            for (int jj = 0; jj < 4; ++jj) a += w[jj][j] * bfs(xr[i + jj][j]);
            o[i][j] = silu(a) * ksc;
        }
#pragma unroll
    for (int i = 0; i < 8; ++i) {
        u32x4 v = {pack2(o[i][0], o[i][1]), pack2(o[i][2], o[i][3]), pack2(o[i][4], o[i][5]), pack2(o[i][6], o[i][7])};
        *(u32x4*)(QK + (size_t)(tok0 + i) * 2048 + c0) = v;
    }
    if (c0 >= 1024) {
        const int b = tok0 >> 12;
#pragma unroll
        for (int j = 0; j < 8; ++j) {
            u32x4 v = {pack2(o[0][j], o[1][j]), pack2(o[2][j], o[3][j]), pack2(o[4][j], o[5][j]), pack2(o[6][j], o[7][j])};
            *(u32x4*)(KT + (size_t)(b * 1024 + (c0 - 1024) + j) * 4096 + pos0) = v;
        }
    }
}

__device__ __forceinline__ void gmlp_item(const Params& P, LAS unsigned char* lds, int item2) {
    const int item = item2 >> 1, g0 = (item2 & 1) * 4;
    const int tid = otid(), wave = tid >> 6, lane = tid & 63, fr = lane & 15, fq = lane >> 4;
    LAS bf16_t* VT = (LAS bf16_t*)lds;
    LAS float* rstd = (LAS float*)(lds + 34816);
    const bf16_t* BIG = (const bf16_t*)(P.ws + OFF_BIG); bf16_t* ABUF = (bf16_t*)(P.ws + OFF_ABUF);
    const float* gn = P.in[8]; const float* wsp = P.in[9]; const float* bsp = P.in[10];
    const int T0 = item * 128;
    for (int r = 0; r < 16; ++r) {
        const int row = wave * 16 + r;
        const bf16_t* p = BIG + (size_t)(T0 + row) * 6144 + 1024 + 16 * lane;
        const bf16x8 a = ld8(p), b = ld8(p + 8);
        float ss = 0.f;
#pragma unroll
        for (int j = 0; j < 8; ++j) { const float x = bfs(a[j]), y = bfs(b[j]); ss += x * x + y * y; }
        ss = wave_sum(ss);
        if (lane == 0) rstd[row] = rsqrtf(ss * (1.0f / 1024.0f) + EPSN);
    }
    __syncthreads();
    for (int g = g0; g < g0 + 4; ++g) {
        {
            const int s = tid & 127, eg0 = tid >> 7; const float rs = rstd[s];
#pragma unroll
            for (int it = 0; it < 4; ++it) {
                const int eg = eg0 + 4 * it;
                const bf16x8 v = ld8(BIG + (size_t)(T0 + s) * 6144 + 1024 + g * 128 + 8 * eg);
                const float4 g0 = *(const float4*)(gn + g * 128 + 8 * eg), g1 = *(const float4*)(gn + g * 128 + 8 * eg + 4);
                const float gg[8] = {g0.x, g0.y, g0.z, g0.w, g1.x, g1.y, g1.z, g1.w};
#pragma unroll
                for (int jj = 0; jj < 8; ++jj) VT[(8 * eg + jj) * 136 + s] = (bf16_t)f2bf(bfs(v[jj]) * rs * gg[jj]);
            }
        }
        __syncthreads();
        f32x4 acc[8];
#pragma unroll
        for (int e = 0; e < 8; ++e) acc[e] = (f32x4){0.f, 0.f, 0.f, 0.f};
        const int t = wave * 16 + fr;
        for (int ks = 0; ks < 4; ++ks) {
            if (32 * ks <= wave * 16 + 15) {
                const float* wp = wsp + ((size_t)(g * 128 + t)) * 128 + 32 * ks + 8 * fq;
                const float4 w0 = *(const float4*)wp, w1 = *(const float4*)(wp + 4);
                const int s0 = 32 * ks + 8 * fq;
                const bf16x8 Y = mk8(s0 + 0 <= t ? w0.x : 0.f, s0 + 1 <= t ? w0.y : 0.f, s0 + 2 <= t ? w0.z : 0.f, s0 + 3 <= t ? w0.w : 0.f,
                                     s0 + 4 <= t ? w1.x : 0.f, s0 + 5 <= t ? w1.y : 0.f, s0 + 6 <= t ? w1.z : 0.f, s0 + 7 <= t ? w1.w : 0.f);
#pragma unroll
                for (int e = 0; e < 8; ++e) { const bf16x8 X = lds8(VT + (16 * e + fr) * 136 + 32 * ks + 8 * fq); acc[e] = mfma16(X, Y, acc[e]); }
            }
        }
        const float bsv = bsp[g * 128 + t]; const size_t tok = (size_t)(T0 + t);
        u32x2 uall[8];
#pragma unroll
        for (int e = 0; e < 8; ++e) uall[e] = *(const u32x2*)(BIG + tok * 6144 + g * 128 + 16 * e + 4 * fq);
#pragma unroll
        for (int e = 0; e < 8; ++e) {
            const int e0 = 16 * e + 4 * fq;
            const u32x2 uu = uall[e];
            u32x2 o = {pack2(bflo(uu.x) * (acc[e][0] + bsv), bfhi(uu.x) * (acc[e][1] + bsv)), pack2(bflo(uu.y) * (acc[e][2] + bsv), bfhi(uu.y) * (acc[e][3] + bsv))};
            *(u32x2*)(ABUF + tok * 2048 + g * 128 + e0) = o;
        }
        __syncthreads();
    }
}

__device__ __forceinline__ void phase_conv_gmlp(const Params& P, LAS unsigned char* lds) {
    for (int it = blockIdx.x; it < 256; it += gridDim.x) gmlp_item(P, lds, it);
    const int wave = otid() >> 6, lane = otid() & 63;
    for (int it = blockIdx.x * 8 + wave; it < 8192; it += gridDim.x * 8) conv_wave_item(P, it, lane);
}

constexpr int ML_KS = 0, ML_PS = 67584, ML_VT = 102400, ML_VTW = 106752, ML_CB = 111104, ML_N = 119552, ML_A = 120576, ML_MT = 121088, ML_B = 121600, ML_WS = 122112;
constexpr int ML_CB2 = 122624, ML_N2 = 131072, ML_SC2 = 132096 - ML_A;
__device__ __forceinline__ void mlstm_scalars(LAS float* sa, LAS float* sMt, LAS float* sb, float f0, float f1, float i0, float i1, float m, int lane) {
    const float l0 = (f0 >= 0.f) ? -log1pf(__expf(-f0)) : (f0 - log1pf(__expf(f0)));
    const float l1 = (f1 >= 0.f) ? -log1pf(__expf(-f1)) : (f1 - log1pf(__expf(f1)));
    float v = l0 + l1;
#pragma unroll
    for (int o = 1; o < 64; o <<= 1) { const float y = __shfl_up(v, o); if (lane >= o) v += y; }
    const float excl = v - (l0 + l1);
    const float b0 = excl + l0, b1 = excl + l0 + l1;
    const float a0 = i0 - b0, a1 = i1 - b1;
    float q = fmaxf(a0, a1);
#pragma unroll
    for (int o = 1; o < 64; o <<= 1) { const float y = __shfl_up(q, o); if (lane >= o) q = fmaxf(q, y); }
    float qe = __shfl_up(q, 1); if (lane == 0) qe = -3.0e38f;
    const float pm0 = fmaxf(qe, a0), pm1 = fmaxf(pm0, a1);
    sa[2 * lane] = a0; sa[2 * lane + 1] = a1; sb[2 * lane] = b0; sb[2 * lane + 1] = b1;
    sMt[2 * lane] = fmaxf(pm0, m); sMt[2 * lane + 1] = fmaxf(pm1, m);
}
__device__ __forceinline__ void mlstm_item(const Params& P, LAS unsigned char* lds, int item) {
    const int tid = otid(), wave = tid >> 6, lane = tid & 63, fr = lane & 15, fq = lane >> 4;
    LAS bf16_t* Ks = (LAS bf16_t*)(lds + ML_KS);
    LAS bf16_t* Ps = (LAS bf16_t*)(lds + ML_PS);
    LAS bf16_t* VT = (LAS bf16_t*)(lds + ML_VT);
    LAS bf16_t* VTW = (LAS bf16_t*)(lds + ML_VTW);
    const bf16_t* BIG = (const bf16_t*)(P.ws + OFF_BIG); const bf16_t* QK = (const bf16_t*)(P.ws + OFF_AUX1);
    const float* G0 = (const float*)(P.ws + OFF_GATES); float* HT = (float*)(P.ws + OFF_AUX2);
    const int bh_ = ((item & 7) << 1) + ((item >> 7) & 1), es = (item >> 3) & 15, h = bh_ & 3, b = bh_ >> 2;
    { LAS bf16_t* Cb0 = (LAS bf16_t*)(lds + ML_CB); LAS float* n0 = (LAS float*)(lds + ML_N);
      for (int i = tid; i < 16 * 264; i += 512) Cb0[i] = 0;
      if (tid < 256) n0[tid] = 0.f; }
    f32x4 Cacc[2] = {(f32x4){0.f, 0.f, 0.f, 0.f}, (f32x4){0.f, 0.f, 0.f, 0.f}}, Nacc[2] = {(f32x4){0.f, 0.f, 0.f, 0.f}, (f32x4){0.f, 0.f, 0.f, 0.f}};
    float m = 0.f;
    bf16x8 gk[8], gq[8], gv = (bf16x8){0, 0, 0, 0, 0, 0, 0, 0};
    float pf0 = 0.f, pf1 = 0.f, pi0 = 0.f, pi1 = 0.f;
#define ML_FETCH(TB) do { const int tb_ = (TB); \
        _Pragma("unroll") for (int i = 0; i < 8; ++i) { const int idx = tid + 512 * i; gk[i] = ld8(QK + (size_t)(tb_ + (idx >> 5)) * 2048 + 1024 + h * 256 + 8 * (idx & 31)); } \
        _Pragma("unroll") for (int ks = 0; ks < 8; ++ks) gq[ks] = ld8(QK + (size_t)(tb_ + 16 * wave + fr) * 2048 + h * 256 + 32 * ks + 8 * fq); \
        if (tid < 256) gv = ld8(BIG + (size_t)(tb_ + (tid & 127)) * 6144 + 4096 + h * 256 + es * 16 + 8 * (tid >> 7)); \
        if (wave == 0) { pf0 = G0[(size_t)(tb_ + 2 * lane) * 8 + 4 + h]; pf1 = G0[(size_t)(tb_ + 2 * lane + 1) * 8 + 4 + h]; pi0 = G0[(size_t)(tb_ + 2 * lane) * 8 + h]; pi1 = G0[(size_t)(tb_ + 2 * lane + 1) * 8 + h]; } } while (0)
    ML_FETCH(b * 4096);
    if (wave == 0) mlstm_scalars((LAS float*)(lds + ML_A), (LAS float*)(lds + ML_MT), (LAS float*)(lds + ML_B), pf0, pf1, pi0, pi1, m, lane);
    __syncthreads();
    for (int c = 0; c < 32; ++c) {
        const int T0 = b * 4096 + c * 128, par = c & 1;
        LAS float* sa = (LAS float*)(lds + ML_A + par * ML_SC2); LAS float* sMt = (LAS float*)(lds + ML_MT + par * ML_SC2);
        LAS float* sb = (LAS float*)(lds + ML_B + par * ML_SC2); LAS float* sws = (LAS float*)(lds + ML_WS + par * ML_SC2);
        LAS bf16_t* Cb = (LAS bf16_t*)(lds + (par ? ML_CB2 : ML_CB)); LAS bf16_t* CbN = (LAS bf16_t*)(lds + (par ? ML_CB : ML_CB2));
        LAS float* nvec = (LAS float*)(lds + (par ? ML_N2 : ML_N)); LAS float* nvecN = (LAS float*)(lds + (par ? ML_N : ML_N2));
        const float MtL = sMt[127];
        if (tid < 128) sws[tid] = __expf(sa[tid] - MtL);
#pragma unroll
        for (int i = 0; i < 8; ++i) {
            const int idx = tid + 512 * i, s = idx >> 5, dp = idx & 31;
            *(LAS bf16x8*)(Ks + s * 264 + 8 * dp) = gk[i];
        }
        if (tid < 256) {
            const int s = tid & 127, hf = tid >> 7;
            const bf16x8 v = gv;
            const float w = __expf(sa[s] - MtL);
            const int sp = (s & ~31) + 8 * ((s >> 2) & 3) + 4 * ((s >> 4) & 1) + (s & 3);
#pragma unroll
            for (int jj = 0; jj < 8; ++jj) { VT[(8 * hf + jj) * 136 + sp] = (bf16_t)v[jj]; VTW[(8 * hf + jj) * 136 + s] = (bf16_t)f2bf(bfs(v[jj]) * w); }
        }
        bf16x8 qf[8];
#pragma unroll
        for (int ks = 0; ks < 8; ++ks) qf[ks] = gq[ks];
        if (c < 31) ML_FETCH(T0 + 128);
        __syncthreads();
        const int t = 16 * wave + fr;
        const float Mt_t = sMt[t];
        float rsum = 0.f;
        f32x4 a1 = (f32x4){0.f, 0.f, 0.f, 0.f};
        for (int kk = 0; kk <= (wave >> 1); ++kk) {
            f32x4 acc0 = (f32x4){0.f, 0.f, 0.f, 0.f}, acc1 = (f32x4){0.f, 0.f, 0.f, 0.f};
#pragma unroll
            for (int ks = 0; ks < 8; ++ks) {
                const bf16x8 X0 = lds8(Ks + (32 * kk + fr) * 264 + 32 * ks + 8 * fq), X1 = lds8(Ks + (32 * kk + 16 + fr) * 264 + 32 * ks + 8 * fq);
                acc0 = mfma16(X0, qf[ks], acc0); acc1 = mfma16(X1, qf[ks], acc1);
            }
            float pv[2][4];
#pragma unroll
            for (int hh = 0; hh < 2; ++hh) {
                const f32x4 acc = hh ? acc1 : acc0;
                const int s0 = 32 * kk + 16 * hh + 4 * fq;
                const f32x4 av = *(const LAS f32x4*)(sa + s0);
#pragma unroll
                for (int j = 0; j < 4; ++j) { const float d = (s0 + j <= t) ? __expf(av[j] - Mt_t) : 0.f; pv[hh][j] = acc[j] * d; rsum += pv[hh][j]; }
            }
            const bf16x8 Y = mk8(pv[0][0], pv[0][1], pv[0][2], pv[0][3], pv[1][0], pv[1][1], pv[1][2], pv[1][3]);
            a1 = mfma16(lds8(VT + fr * 136 + 32 * kk + 8 * fq), Y, a1);
        }
        rsum = xsum4(rsum);
        {
            f32x4 a2 = (f32x4){0.f, 0.f, 0.f, 0.f};
            float qn = 0.f;
#pragma unroll
            for (int ks = 0; ks < 8; ++ks) {
                const bf16x8 X = lds8(Cb + fr * 264 + 32 * ks + 8 * fq);
                a2 = mfma16(X, qf[ks], a2);
                const f32x4 n0 = *(const LAS f32x4*)(nvec + 32 * ks + 8 * fq), n1 = *(const LAS f32x4*)(nvec + 32 * ks + 8 * fq + 4);
#pragma unroll
                for (int jj = 0; jj < 4; ++jj) qn += bfs(qf[ks][jj]) * n0[jj] + bfs(qf[ks][4 + jj]) * n1[jj];
            }
            qn = xsum4(qn);
            const float wi = __expf(m - Mt_t);
            const float den = rsum + wi * qn;
            const float dn = fmaxf(fabsf(den), __expf(-(sb[t] + Mt_t)));
            const float inv = 1.0f / dn;
            f32x4 o; for (int j = 0; j < 4; ++j) o[j] = (a1[j] + wi * a2[j]) * inv;
            *(f32x4*)(HT + (size_t)(T0 + t) * 1024 + h * 256 + es * 16 + 4 * fq) = o;
        }
        {
            const float wprev = __expf(m - MtL);
            Cacc[0] *= wprev; Cacc[1] *= wprev; Nacc[0] *= wprev; Nacc[1] *= wprev;
#pragma unroll
            for (int kk = 0; kk < 4; ++kk) {
                const bf16x8 X = lds8(VTW + fr * 136 + 32 * kk + 8 * fq);
                const f32x4 w0 = *(const LAS f32x4*)(sws + 32 * kk + 8 * fq), w1 = *(const LAS f32x4*)(sws + 32 * kk + 8 * fq + 4);
                const bf16x8 XWf = mk8(w0[0], w0[1], w0[2], w0[3], w1[0], w1[1], w1[2], w1[3]);
                const bf16x8 XW = (fr == 0) ? XWf : (bf16x8){0, 0, 0, 0, 0, 0, 0, 0};
#pragma unroll
                for (int dt = 0; dt < 2; ++dt) {
                    const int dcol = 16 * (2 * wave + dt) + fr;
                    const LAS bf16_t* yp = Ks + (32 * kk + 8 * fq + (fr >> 2)) * 264 + 16 * (2 * wave + dt) + 4 * (fr & 3);
                    const s16x4 ylo = lds_tr4(yp), yhi = lds_tr4(yp + 4 * 264);
                    const bf16x8 Y = {ylo[0], ylo[1], ylo[2], ylo[3], yhi[0], yhi[1], yhi[2], yhi[3]};
                    Cacc[dt] = mfma16(X, Y, Cacc[dt]);
                    Nacc[dt] = mfma16(XW, Y, Nacc[dt]);
                }
            }
#pragma unroll
            for (int dt = 0; dt < 2; ++dt) {
                const int dcol = 16 * (2 * wave + dt) + fr;
#pragma unroll
                for (int j = 0; j < 4; ++j) CbN[(4 * fq + j) * 264 + dcol] = (bf16_t)f2bf(Cacc[dt][j]);
                if (fq == 0) nvecN[dcol] = Nacc[dt][0];
            }
            m = sb[127] + MtL;
        }
        if (wave == 0 && c < 31)
            mlstm_scalars((LAS float*)(lds + ML_A + (par ^ 1) * ML_SC2), (LAS float*)(lds + ML_MT + (par ^ 1) * ML_SC2), (LAS float*)(lds + ML_B + (par ^ 1) * ML_SC2), pf0, pf1, pi0, pi1, m, lane);
        __syncthreads();
    }
#undef ML_FETCH
}
__device__ __forceinline__ void phase_mlstm(const Params& P, LAS unsigned char* lds) {
    for (int it = blockIdx.x; it < 256; it += gridDim.x) { mlstm_item(P, lds, it); __syncthreads(); }
}

__device__ __forceinline__ void phase_htnorm(const Params& P) {
    const int wave = otid() >> 6, lane = otid() & 63;
    const float* HT = (const float*)(P.ws + OFF_AUX2); const bf16_t* BIG = (const bf16_t*)(P.ws + OFF_BIG); bf16_t* ABUF = (bf16_t*)(P.ws + OFF_ABUF);
    const float* mn = P.in[12];
    for (int row = blockIdx.x * 8 + wave; row < MTOK; row += gridDim.x * 8) {
        float4 vv[4], gg[4]; u32x2 ov[4];
#pragma unroll
        for (int h = 0; h < 4; ++h) { gg[h] = *(const float4*)(mn + h * 256 + 4 * lane); vv[h] = *(const float4*)(HT + (size_t)row * 1024 + h * 256 + 4 * lane); ov[h] = *(const u32x2*)(BIG + (size_t)row * 6144 + 5120 + h * 256 + 4 * lane); }
#pragma unroll
        for (int h = 0; h < 4; ++h) {
            const float4 v = vv[h];
            float ss = v.x * v.x + v.y * v.y + v.z * v.z + v.w * v.w;
            ss = wave_sum(ss);
            const float r = rsqrtf(ss * (1.0f / 256.0f) + EPSN);
            const float4 g = gg[h];
            const u32x2 oo = ov[h];
            u32x2 o = {pack2(sigm(bflo(oo.x)) * v.x * r * g.x, sigm(bfhi(oo.x)) * v.y * r * g.y), pack2(sigm(bflo(oo.y)) * v.z * r * g.z, sigm(bfhi(oo.y)) * v.w * r * g.w)};
            *(u32x2*)(ABUF + (size_t)row * 2048 + 1024 + h * 256 + 4 * lane) = o;
        }
    }
}


__device__ __forceinline__ int kv_col(int br, int kv, int g) { return 2048 + ((br * 2 + kv) * 4 + g) * 128; }

__device__ __forceinline__ void vt_wave_item(const Params& P, int item, int lane) {
    const bf16_t* BIG = (const bf16_t*)(P.ws + OFF_BIG); bf16_t* VTG = (bf16_t*)(P.ws + OFF_KT);
    const int tgp = item >> 4, cgp = item & 15;
    const int brm = cgp >> 3, g = (cgp >> 1) & 3, half = cgp & 1;
    const int tg = lane & 7, cg = lane >> 3;
    const int tok0 = tgp * 64 + 8 * tg, b = tok0 >> 12, pos0 = tok0 & 4095;
    const int col = kv_col(brm + 1, 1, g) + half * 64 + 8 * cg;
    bf16x8 x[8];
#pragma unroll
    for (int i = 0; i < 8; ++i) x[i] = ld8(BIG + (size_t)(tok0 + i) * 5120 + col);
    const size_t rb = (size_t)(((b * 2 + brm) * 4 + g) * 128 + half * 64 + 8 * cg);
#pragma unroll
    for (int j = 0; j < 8; ++j) {
        bf16x8 v; for (int i = 0; i < 8; ++i) v[i] = x[i][j];
        *(bf16x8*)(VTG + (rb + j) * 4096 + pos0) = v;
    }
}

__device__ __forceinline__ void cmp_item(const Params& P, LAS unsigned char* lds, int item) {
    const int tid = otid(), wave = tid >> 6, lane = tid & 63, fr = lane & 15, fq = lane >> 4;
    LAS float* pos = (LAS float*)lds;
    LAS bf16_t* H = (LAS bf16_t*)(lds + 16384);
    const bf16_t* BIG = (const bf16_t*)(P.ws + OFF_BIG);
    const int rt = item & 15, g = (item >> 4) & 3, b = (item >> 6) & 3, kv = item >> 8;
    const bf16_t* W1 = (const bf16_t*)(P.ws + OFF_WC1) + (size_t)kv * 128 * 4096;
    const bf16_t* W2 = (const bf16_t*)(P.ws + OFF_WC2) + (size_t)kv * 128 * 128;
    const float* pe = P.in[15] + (size_t)kv * 4096;
    for (int i = tid; i < 1024; i += 512) *(LAS f32x4*)(pos + 4 * i) = *(const f32x4*)(pe + 4 * i);
    __syncthreads();
    int cr = rt * 16 + fr; if (cr > 254) cr = 254;
    const bf16_t* ap = BIG + (size_t)(b * 4096 + 16 * cr) * 5120 + kv_col(0, kv, g) + 8 * fq;
    const bf16_t* wp = W1 + (size_t)(16 * wave + fr) * 4096 + 8 * fq;
    f32x4 acc = (f32x4){0.f, 0.f, 0.f, 0.f};
#pragma unroll 8
    for (int ks = 0; ks < 128; ++ks) {
        const int l = ks >> 2, d0 = (ks & 3) * 32;
        const bf16x8 xv = ld8(ap + (size_t)l * 5120 + d0);
        const f32x4 p0 = *(const LAS f32x4*)(pos + l * 128 + d0 + 8 * fq), p1 = *(const LAS f32x4*)(pos + l * 128 + d0 + 8 * fq + 4);
        const bf16x8 Y = mk8(bfs(xv[0]) + p0[0], bfs(xv[1]) + p0[1], bfs(xv[2]) + p0[2], bfs(xv[3]) + p0[3], bfs(xv[4]) + p1[0], bfs(xv[5]) + p1[1], bfs(xv[6]) + p1[2], bfs(xv[7]) + p1[3]);
        const bf16x8 X = ld8(wp + 32 * ks);
        acc = mfma16(X, Y, acc);
    }
    { u32x2 o = {pack2(gelu_t(acc[0]), gelu_t(acc[1])), pack2(gelu_t(acc[2]), gelu_t(acc[3]))}; *(LAS u32x2*)(H + fr * 136 + 16 * wave + 4 * fq) = o; }
    __syncthreads();
    f32x4 a2 = (f32x4){0.f, 0.f, 0.f, 0.f};
    if (kv == 0) {
#pragma unroll
        for (int ks = 0; ks < 4; ++ks) { const bf16x8 X = ld8(W2 + (size_t)(16 * wave + fr) * 128 + 32 * ks + 8 * fq), Y = lds8(H + fr * 136 + 32 * ks + 8 * fq); a2 = mfma16(X, Y, a2); }
        bf16_t* KC = (bf16_t*)(P.ws + OFF_KCMP);
        u32x2 o = {pack2(a2[0], a2[1]), pack2(a2[2], a2[3])};
        *(u32x2*)(KC + (size_t)((b * 4 + g) * 256 + rt * 16 + fr) * 128 + 16 * wave + 4 * fq) = o;
    } else {
#pragma unroll
        for (int ks = 0; ks < 4; ++ks) { const bf16x8 Y = ld8(W2 + (size_t)(16 * wave + fr) * 128 + 32 * ks + 8 * fq), X = lds8(H + fr * 136 + 32 * ks + 8 * fq); a2 = mfma16(X, Y, a2); }
        bf16_t* VC = (bf16_t*)(P.ws + OFF_VCMPT);
        u32x2 o = {pack2(a2[0], a2[1]), pack2(a2[2], a2[3])};
        *(u32x2*)(VC + (size_t)((b * 4 + g) * 128 + 16 * wave + fr) * 256 + rt * 16 + 4 * fq) = o;
    }
    __syncthreads();
}
__device__ __forceinline__ void phase_compress(const Params& P, LAS unsigned char* lds) {
    for (int it = blockIdx.x; it < 512; it += gridDim.x) cmp_item(P, lds, it);
    const int wave = otid() >> 6, lane = otid() & 63;
    for (int it = blockIdx.x * 8 + wave; it < 4096; it += gridDim.x * 8) vt_wave_item(P, it, lane);
}

constexpr int AT_KB = 0, AT_VT = 17408, AT_PS = 35840, AT_IMP = 72704, AT_SEL = 138240;
struct KVRegs { bf16x8 k[2], v[2]; };
__device__ __forceinline__ void at_fetch(KVRegs& R, const bf16_t* ksrc, size_t kpitch, const bf16_t* vsrc, size_t vpitch, int tid, bool wantv) {
#pragma unroll
    for (int i = 0; i < 2; ++i) {
        const int p = tid + 512 * i;
        R.k[i] = ld8(ksrc + (size_t)(p >> 4) * kpitch + 8 * (p & 15));
        if (wantv) R.v[i] = ld8(vsrc + (size_t)(p >> 3) * vpitch + 8 * (p & 7));
    }
}
__device__ __forceinline__ void at_stage(LAS unsigned char* lds, const KVRegs& R, int tid, bool wantv, int bofs = 0) {
    LAS bf16_t* Kb = (LAS bf16_t*)(lds + bofs + AT_KB); LAS bf16_t* Vb = (LAS bf16_t*)(lds + bofs + AT_VT);
#pragma unroll
    for (int i = 0; i < 2; ++i) {
        const int p = tid + 512 * i;
        *(LAS bf16x8*)(Kb + (p >> 4) * 136 + 8 * (p & 15)) = R.k[i];
        if (wantv) {
            const int c8 = p & 7, cc = c8 & 3, base = (p >> 3) * 72 + 32 * (c8 >> 2) + 16 * (cc & 1) + 4 * (cc >> 1);
            const u32x4 vv = __builtin_bit_cast(u32x4, R.v[i]);
            *(LAS u32x2*)(Vb + base) = (u32x2){vv[0], vv[1]};
            *(LAS u32x2*)(Vb + base + 8) = (u32x2){vv[2], vv[3]};
        }
    }
}
__device__ __forceinline__ void at_scores2(LAS unsigned char* lds, const bf16x8 (&qf)[2][4], f32x4 (&sc)[2][4], int fr, int fq, int bofs = 0) {
    const LAS bf16_t* Kb = (const LAS bf16_t*)(lds + bofs + AT_KB);
    __builtin_amdgcn_s_setprio(1);
#pragma unroll
    for (int kt = 0; kt < 4; ++kt) {
        f32x4 a0 = (f32x4){0.f, 0.f, 0.f, 0.f}, a1 = (f32x4){0.f, 0.f, 0.f, 0.f};
#pragma unroll
        for (int ks = 0; ks < 4; ++ks) { const bf16x8 X = lds8(Kb + (16 * kt + fr) * 136 + 32 * ks + 8 * fq); a0 = mfma16(X, qf[0][ks], a0); a1 = mfma16(X, qf[1][ks], a1); }
        sc[0][kt] = a0; sc[1][kt] = a1;
    }
    __builtin_amdgcn_s_setprio(0);
}
__device__ __forceinline__ void at_pv2(LAS unsigned char* lds, const f32x4 (&p)[2][4], f32x4 (&o)[2][8], int wave, int fr, int fq, int bofs = 0) {
    const LAS bf16_t* Vb = (const LAS bf16_t*)(lds + bofs + AT_VT);
#pragma unroll
    for (int kk = 0; kk < 2; ++kk) {
        const bf16x8 Y0 = mk8(p[0][2 * kk][0], p[0][2 * kk][1], p[0][2 * kk][2], p[0][2 * kk][3], p[0][2 * kk + 1][0], p[0][2 * kk + 1][1], p[0][2 * kk + 1][2], p[0][2 * kk + 1][3]);
        const bf16x8 Y1 = mk8(p[1][2 * kk][0], p[1][2 * kk][1], p[1][2 * kk][2], p[1][2 * kk][3], p[1][2 * kk + 1][0], p[1][2 * kk + 1][1], p[1][2 * kk + 1][2], p[1][2 * kk + 1][3]);
        __builtin_amdgcn_s_setprio(1);
#pragma unroll
        for (int dt = 0; dt < 8; ++dt) { const bf16x8 X = lds8(Vb + (16 * dt + fr) * 72 + 32 * kk + 8 * fq); o[0][dt] = mfma16(X, Y0, o[0][dt]); o[1][dt] = mfma16(X, Y1, o[1][dt]); }
        __builtin_amdgcn_s_setprio(0);
    }
}
__device__ __forceinline__ void at_online2(LAS unsigned char* lds, const bf16x8 (&qf)[2][4], float (&mrun)[2], float (&lrun)[2], f32x4 (&o)[2][8], const int (&lo)[2], const int (&hi)[2], const bool (&rowok)[2], bool fullvis, int wave, int fr, int fq, int bofs) {
    f32x4 sc[2][4];
    at_scores2(lds, qf, sc, fr, fq, bofs);
    float bm[2];
#pragma unroll
    for (int rt = 0; rt < 2; ++rt) {
        if (!fullvis) {
            const bool mok = hi[rt] >= lo[rt];
            const int moff = mok ? -lo[rt] : -100000; const unsigned mspan = mok ? (unsigned)(hi[rt] - lo[rt]) : 0u;
#pragma unroll
            for (int kt = 0; kt < 4; ++kt)
#pragma unroll
                for (int j = 0; j < 4; ++j) sc[rt][kt][j] = ((unsigned)(16 * kt + j + moff) <= mspan) ? sc[rt][kt][j] : -3.0e38f;
        }
        float b = -3.0e38f;
#pragma unroll
        for (int kt = 0; kt < 4; ++kt)
#pragma unroll
            for (int j = 0; j < 4; ++j) b = fmaxf(b, sc[rt][kt][j]);
        bm[rt] = b;
    }
    if (__any((bm[0] > mrun[0] + 6.0f) || (bm[1] > mrun[1] + 6.0f))) {
#pragma unroll
        for (int rt = 0; rt < 2; ++rt) {
            const float mnew = fmaxf(mrun[rt], xmax4(bm[rt])), mns = (mnew < -1.0e37f) ? 0.f : mnew;
            const float alpha = __builtin_amdgcn_exp2f(mrun[rt] - mns);
            lrun[rt] *= alpha; mrun[rt] = mnew;
#pragma unroll
            for (int dt = 0; dt < 8; ++dt) o[rt][dt] *= alpha;
        }
    }
#pragma unroll
    for (int rt = 0; rt < 2; ++rt) {
        const float mns = (mrun[rt] < -1.0e37f) ? 0.f : mrun[rt];
        const float mex = (fullvis && !rowok[rt]) ? 3.0e38f : mns;
        float ps = 0.f;
#pragma unroll
        for (int kt = 0; kt < 4; ++kt)
#pragma unroll
            for (int j = 0; j < 4; ++j) { const float e = __builtin_amdgcn_exp2f(sc[rt][kt][j] - mex); sc[rt][kt][j] = e; ps += e; }
        lrun[rt] += ps;
    }
    at_pv2(lds, sc, o, wave, fr, fq, bofs);
}

template <bool FIRST>
__device__ __forceinline__ void y_accum(bf16_t* yp0, bf16_t* yp1, const f32x4 (&o)[2][8], float s0, float s1) {
    u32x2 p[2][8];
    if (!FIRST) {
#pragma unroll
        for (int dt = 0; dt < 8; ++dt) { p[0][dt] = *(const u32x2*)(yp0 + 16 * dt); p[1][dt] = *(const u32x2*)(yp1 + 16 * dt); }
    }
#pragma unroll
    for (int rt = 0; rt < 2; ++rt) {
        bf16_t* yp = rt ? yp1 : yp0; const float scale = rt ? s1 : s0;
#pragma unroll
        for (int dt = 0; dt < 8; ++dt) {
            float a0 = o[rt][dt][0] * scale, a1 = o[rt][dt][1] * scale, a2 = o[rt][dt][2] * scale, a3 = o[rt][dt][3] * scale;
            if (!FIRST) { a0 += bflo(p[rt][dt].x); a1 += bfhi(p[rt][dt].x); a2 += bflo(p[rt][dt].y); a3 += bfhi(p[rt][dt].y); }
            u32x2 v = {pack2(a0, a1), pack2(a2, a3)};
            *(u32x2*)(yp + 16 * dt) = v;
        }
    }
}

__device__ __forceinline__ void attn_item(const Params& P, LAS unsigned char* lds, int item) {
    const int tid = otid(), wave = tid >> 6, lane = tid & 63, fr = lane & 15, fq = lane >> 4;
    const bf16_t* BIG = (const bf16_t*)(P.ws + OFF_BIG); const bf16_t* VTG = (const bf16_t*)(P.ws + OFF_KT);
    const bf16_t* KC = (const bf16_t*)(P.ws + OFF_KCMP); const bf16_t* VC = (const bf16_t*)(P.ws + OFF_VCMPT);
    const float* GT = (const float*)(P.ws + OFF_GATES); bf16_t* Y = (bf16_t*)(P.ws + OFF_ABUF);
    LAS float* impW = (LAS float*)(lds + AT_IMP);
    LAS unsigned* selw = (LAS unsigned*)(lds + AT_SEL);
    const int kk_ = item >> 8, blk_ = item & 255, j_ = blk_ >> 3;
    const int qt = (kk_ & 1) ? 63 - j_ : j_, pair_ = ((blk_ & 7) << 1) + (kk_ >> 1), g = pair_ & 3, b = pair_ >> 2;
    const int t0 = qt * 64, tokb = b * 4096;
    const int head = g * 4 + (wave >> 1), qoff = 32 * (wave & 1);
    const int cur = qt;
    int pos[2]; pos[0] = t0 + qoff + fr; pos[1] = pos[0] + 16;
    bf16x8 qf[2][4];
#pragma unroll
    for (int rt = 0; rt < 2; ++rt)
#pragma unroll
        for (int ks = 0; ks < 4; ++ks) qf[rt][ks] = ld8(BIG + (size_t)(tokb + pos[rt]) * 5120 + head * 128 + 32 * ks + 8 * fq);
    KVRegs R;
    const bf16_t* kc0 = KC + (size_t)((b * 4 + g) * 256) * 128;
    const bf16_t* vc0 = VC + (size_t)((b * 4 + g) * 128) * 256;
    {
        int cmaxq[2]; cmaxq[0] = (pos[0] - 31) >> 4; cmaxq[1] = (pos[1] - 31) >> 4;
        float mx[2] = {-3.0e38f, -3.0e38f}, sum[2] = {0.f, 0.f};
        const int nblk = min(4, ((4 * qt + 2) >> 6) + 1);
        at_fetch(R, kc0, 128, vc0, 256, tid, false);
#pragma unroll 1
        for (int blk = 0; blk < nblk; ++blk) {
            __syncthreads();
            at_stage(lds, R, tid, false);
            __syncthreads();
            if (blk + 1 < nblk) at_fetch(R, kc0 + (size_t)(blk + 1) * 64 * 128, 128, vc0, 256, tid, false);
            else at_fetch(R, kc0, 128, vc0, 256, tid, true);
            f32x4 s4[2][4]; at_scores2(lds, qf, s4, fr, fq);
#pragma unroll
            for (int rt = 0; rt < 2; ++rt) {
                const int lim = cmaxq[rt] - 64 * blk - 4 * fq;
                float bm = -3.0e38f;
#pragma unroll
                for (int kt = 0; kt < 4; ++kt)
#pragma unroll
                    for (int j = 0; j < 4; ++j) { const float s = (16 * kt + j <= lim) ? s4[rt][kt][j] : -3.0e38f; s4[rt][kt][j] = s; bm = fmaxf(bm, s); }
                bm = xmax4(bm);
                const float mnew = fmaxf(mx[rt], bm), mns = (mnew < -1.0e37f) ? 0.f : mnew;
                float ps = 0.f;
#pragma unroll
                for (int kt = 0; kt < 4; ++kt)
#pragma unroll
                    for (int j = 0; j < 4; ++j) ps += __builtin_amdgcn_exp2f(s4[rt][kt][j] - mns);
                sum[rt] = sum[rt] * __builtin_amdgcn_exp2f(mx[rt] - mns) + ps; mx[rt] = mnew;
            }
        }
        float inv[2], mxs[2];
#pragma unroll
        for (int rt = 0; rt < 2; ++rt) {
            const float s = xsum4(sum[rt]);
            inv[rt] = s > 0.f ? 1.0f / s : 0.f; mxs[rt] = (mx[rt] < -1.0e37f) ? 0.f : mx[rt];
        }
        f32x4 oc[2][8];
#pragma unroll
        for (int rt = 0; rt < 2; ++rt)
#pragma unroll
            for (int dt = 0; dt < 8; ++dt) oc[rt][dt] = (f32x4){0.f, 0.f, 0.f, 0.f};
        float eprev[2] = {0.f, 0.f};
        if (nblk < 4) {
            for (int r = 0; r < 32; ++r) { const int J = 16 * nblk + lane; if (J < 64) impW[(wave * 32 + r) * 64 + J] = 0.f; }
        }
#pragma unroll 1
        for (int blk = 0; blk < nblk; ++blk) {
            __syncthreads();
            at_stage(lds, R, tid, true);
            __syncthreads();
            if (blk + 1 < nblk) at_fetch(R, kc0 + (size_t)(blk + 1) * 64 * 128, 128, vc0 + (blk + 1) * 64, 256, tid, true);
            f32x4 s4[2][4]; at_scores2(lds, qf, s4, fr, fq);
#pragma unroll
            for (int rt = 0; rt < 2; ++rt) {
                const int lim = cmaxq[rt] - 64 * blk - 4 * fq;
#pragma unroll
                for (int kt = 0; kt < 4; ++kt) {
#pragma unroll
                    for (int j = 0; j < 4; ++j) s4[rt][kt][j] = (16 * kt + j <= lim) ? __builtin_amdgcn_exp2f(s4[rt][kt][j] - mxs[rt]) * inv[rt] : 0.f;
                    const float a = s4[rt][kt][0] + s4[rt][kt][1] + s4[rt][kt][2] + s4[rt][kt][3], e = 0.5f * s4[rt][kt][3];
                    const float src = (fq == 3) ? eprev[rt] : e;
                    const float got = __shfl(src, (lane + 48) & 63);
                    impW[(wave * 32 + 16 * rt + fr) * 64 + 16 * blk + 4 * kt + fq] = a - e + got;
                    eprev[rt] = e;
                }
            }
            at_pv2(lds, s4, oc, wave, fr, fq);
        }
        y_accum<true>(Y + (size_t)(tokb + pos[0]) * 2048 + head * 128 + 4 * fq, Y + (size_t)(tokb + pos[1]) * 2048 + head * 128 + 4 * fq, oc,
                      GT[(size_t)(tokb + pos[0]) * 48 + 0 * 16 + head], GT[(size_t)(tokb + pos[1]) * 48 + 0 * 16 + head]);
    }
    __syncthreads();
    {
#pragma unroll 1
        for (int i = 0; i < 8; ++i) {
            const int q = 8 * wave + i;
            float v = 0.f;
#pragma unroll
            for (int r = 0; r < 4; ++r) v += impW[((2 * r + (q >> 5)) * 32 + (q & 31)) * 64 + lane];
            const int J = lane;
            if (J == 0 || J == cur || J == cur - 1) v = 1.0e9f; else if (J > cur) v = -1.0e9f;
            int rank = 0;
            for (int o = 0; o < 64; ++o) { const float vo = __shfl(v, o); rank += (vo > v || (vo == v && o < J)) ? 1 : 0; }
            const unsigned long long mask = __ballot((rank < 16) && (J <= cur));
            if (lane == 0) { selw[2 * q] = (unsigned)mask; selw[2 * q + 1] = (unsigned)(mask >> 32); }
        }
    }
    __syncthreads();
    unsigned long long un = 0ull;
#pragma unroll 1
    for (int q = 0; q < 64; ++q) un |= ((unsigned long long)selw[2 * q + 1] << 32) | selw[2 * q];
    {
        unsigned long long mysel[2];
#pragma unroll
        for (int rt = 0; rt < 2; ++rt) mysel[rt] = ((unsigned long long)selw[2 * (qoff + 16 * rt + fr) + 1] << 32) | selw[2 * (qoff + 16 * rt + fr)];
        float mrun[2] = {-3.0e38f, -3.0e38f}, lrun[2] = {0.f, 0.f};
        f32x4 o[2][8];
#pragma unroll
        for (int rt = 0; rt < 2; ++rt)
#pragma unroll
            for (int dt = 0; dt < 8; ++dt) o[rt][dt] = (f32x4){0.f, 0.f, 0.f, 0.f};
        const bf16_t* kb = BIG + (size_t)tokb * 5120 + kv_col(1, 0, g);
        const bf16_t* vb = VTG + (size_t)(((b * 2 + 0) * 4 + g) * 128) * 4096;
        unsigned long long rem = un;
        int jb = __builtin_ctzll(rem); rem &= rem - 1;
        at_fetch(R, kb + (size_t)jb * 64 * 5120, 5120, vb + jb * 64, 4096, tid, true);
        __syncthreads();
        at_stage(lds, R, tid, true, 0);
        int jn = rem ? (int)__builtin_ctzll(rem) : -1;
        if (jn >= 0) at_fetch(R, kb + (size_t)jn * 64 * 5120, 5120, vb + jn * 64, 4096, tid, true);
        __syncthreads();
        int cb = 0;
#pragma unroll 1
        for (;;) {
            int jn2 = -1;
            if (jn >= 0) {
                at_stage(lds, R, tid, true, cb ? 0 : AT_IMP);
                rem &= rem - 1; jn2 = rem ? (int)__builtin_ctzll(rem) : -1;
                if (jn2 >= 0) at_fetch(R, kb + (size_t)jn2 * 64 * 5120, 5120, vb + jn2 * 64, 4096, tid, true);
            }
            int lo[2], hi[2]; bool rowok[2];
#pragma unroll
            for (int rt = 0; rt < 2; ++rt) { rowok[rt] = (mysel[rt] >> jb) & 1ull; lo[rt] = rowok[rt] ? 0 : 1000; hi[rt] = pos[rt] - 64 * jb - 4 * fq; }
            at_online2(lds, qf, mrun, lrun, o, lo, hi, rowok, jb < cur, wave, fr, fq, cb ? AT_IMP : 0);
            __syncthreads();
            if (jn < 0) break;
            jb = jn; jn = jn2; cb ^= 1;
        }
        {
            const float g0 = GT[(size_t)(tokb + pos[0]) * 48 + 1 * 16 + head], g1 = GT[(size_t)(tokb + pos[1]) * 48 + 1 * 16 + head];
            const float l0 = xsum4(lrun[0]), l1 = xsum4(lrun[1]);
            y_accum<false>(Y + (size_t)(tokb + pos[0]) * 2048 + head * 128 + 4 * fq, Y + (size_t)(tokb + pos[1]) * 2048 + head * 128 + 4 * fq, o,
                           l0 > 0.f ? g0 / l0 : 0.f, l1 > 0.f ? g1 / l1 : 0.f);
        }
    }
    {
        float mrun[2] = {-3.0e38f, -3.0e38f}, lrun[2] = {0.f, 0.f};
        f32x4 o[2][8];
#pragma unroll
        for (int rt = 0; rt < 2; ++rt)
#pragma unroll
            for (int dt = 0; dt < 8; ++dt) o[rt][dt] = (f32x4){0.f, 0.f, 0.f, 0.f};
        const bf16_t* kb = BIG + (size_t)tokb * 5120 + kv_col(2, 0, g);
        const bf16_t* vb = VTG + (size_t)(((b * 2 + 1) * 4 + g) * 128) * 4096;
        const int lo0 = t0 - 511, jlo = lo0 < 0 ? 0 : (lo0 >> 6);
        at_fetch(R, kb + (size_t)jlo * 64 * 5120, 5120, vb + jlo * 64, 4096, tid, true);
        at_stage(lds, R, tid, true, 0);
        if (jlo < cur) at_fetch(R, kb + (size_t)(jlo + 1) * 64 * 5120, 5120, vb + (jlo + 1) * 64, 4096, tid, true);
        __syncthreads();
        int cb = 0;
#pragma unroll 1
        for (int jb = jlo; jb <= cur; ++jb) {
            if (jb < cur) {
                at_stage(lds, R, tid, true, cb ? 0 : AT_IMP);
                if (jb + 1 < cur) at_fetch(R, kb + (size_t)(jb + 2) * 64 * 5120, 5120, vb + (jb + 2) * 64, 4096, tid, true);
            }
            int lo[2], hi[2]; bool rowok[2] = {true, true};
#pragma unroll
            for (int rt = 0; rt < 2; ++rt) { hi[rt] = pos[rt] - 64 * jb - 4 * fq; lo[rt] = hi[rt] - 511; }
            at_online2(lds, qf, mrun, lrun, o, lo, hi, rowok, (jb < cur) && (jb >= cur - 7), wave, fr, fq, cb ? AT_IMP : 0);
            __syncthreads();
            cb ^= 1;
        }
        {
            const float g0 = GT[(size_t)(tokb + pos[0]) * 48 + 2 * 16 + head], g1 = GT[(size_t)(tokb + pos[1]) * 48 + 2 * 16 + head];
            const float l0 = xsum4(lrun[0]), l1 = xsum4(lrun[1]);
            y_accum<false>(Y + (size_t)(tokb + pos[0]) * 2048 + head * 128 + 4 * fq, Y + (size_t)(tokb + pos[1]) * 2048 + head * 128 + 4 * fq, o,
                           l0 > 0.f ? g0 / l0 : 0.f, l1 > 0.f ? g1 / l1 : 0.f);
        }
    }
    __syncthreads();
}
__device__ __forceinline__ void phase_attn(const Params& P, LAS unsigned char* lds) {
    for (int it = blockIdx.x; it < 1024; it += gridDim.x) attn_item(P, lds, it);
}


#ifndef FBAR_SLEEP
#define FBAR_SLEEP 127
#endif
#ifndef FBAR_SLEEP2
#define FBAR_SLEEP2 0
#endif
constexpr int N_PHASES = 25;
constexpr int LDS_BYTES = 139264;

template <class Epi>
__device__ __forceinline__ void run_gemm(LAS unsigned char* lds, const bf16_t* A, const bf16_t* Bt, int N, int K, const Epi& E) {
    pg8::Gemm g{A, Bt, MTOK, N, K};
    pg8::StaticOrder S; S.init(MTOK, N, (int)gridDim.x, (int)blockIdx.x);
    pg8::gemm_phase<Epi, pg8::StaticOrder, false>((PG8_LAS unsigned char*)lds, g, S, E, nullptr);
}

__device__ __forceinline__ unsigned xbar_setup(unsigned char* ws) {
    const unsigned* slot = (const unsigned*)(ws + OFF_XB);
    const int lane = threadIdx.x & 63;
    const unsigned mine = __hip_atomic_load(slot + blockIdx.x, __ATOMIC_RELAXED, __HIP_MEMORY_SCOPE_AGENT) & 0xFu;
    unsigned nx = 0, seen = 0;
    for (unsigned i = lane; i < gridDim.x; i += 64) { const unsigned x = __hip_atomic_load(slot + i, __ATOMIC_RELAXED, __HIP_MEMORY_SCOPE_AGENT) & 0xFu; nx += (x == mine) ? 1u : 0u; seen |= 1u << x; }
#pragma unroll
    for (int o = 32; o; o >>= 1) { nx += __shfl_xor(nx, o); seen |= __shfl_xor(seen, o); }
    return mine | (nx << 4) | ((unsigned)__builtin_popcount(seen) << 16);
}
__device__ __forceinline__ void xbar_sync(unsigned char* ws, LAS unsigned char* lds, unsigned k) {
    __syncthreads();
    if (threadIdx.x == 0) {
        const unsigned info = *(const LAS unsigned*)(lds + 139008);
        unsigned* sub = (unsigned*)(ws + OFF_XB + 1024 + 256 * (info & 0xFu)); unsigned* top = (unsigned*)(ws + OFF_XB + 1024 + 256 * 16);
        const unsigned nx = (info >> 4) & 0xFFFu, nxcc = info >> 16;
        const unsigned old = __hip_atomic_fetch_add(sub, 1u, __ATOMIC_RELAXED, __HIP_MEMORY_SCOPE_AGENT);
        if (old + 1u == nx * k) {
            __builtin_amdgcn_fence(__ATOMIC_RELEASE, "agent");
            asm volatile("s_waitcnt vmcnt(0)" ::: "memory");
            __hip_atomic_fetch_add(top, 1u, __ATOMIC_RELAXED, __HIP_MEMORY_SCOPE_AGENT);
        }
        const unsigned want = nxcc * k;
        unsigned spins = 0;
        while (__hip_atomic_load(top, __ATOMIC_RELAXED, __HIP_MEMORY_SCOPE_AGENT) < want && ++spins < (1u << 21)) __builtin_amdgcn_s_sleep(FBAR_SLEEP);
        __builtin_amdgcn_fence(__ATOMIC_ACQUIRE, "agent");
        asm volatile("s_waitcnt vmcnt(0)" ::: "memory");
    }
    __syncthreads();
}

__device__ __forceinline__ int stage_rstd(LAS unsigned char* lds, const float* SS, int N) {
    pg8::StaticOrder S; S.init(MTOK, N, (int)gridDim.x, (int)blockIdx.x);
    Unit u0; if (!S.next(0, u0)) u0.pm = 0;
    LAS float* l = (LAS float*)(lds + 131072);
    const int tid = otid();
    if (tid < 256) l[tid] = rsqrtf(SS[u0.pm * 256 + tid] * (1.0f / 2048.0f) + EPSN);
    __syncthreads();
    return u0.pm;
}

__global__ void __launch_bounds__(512, 2) mega(Params P) {
    extern __shared__ __attribute__((aligned(16))) unsigned char shm[];
    LAS unsigned char* lds = (LAS unsigned char*)shm;
    cg::grid_group grid = cg::this_grid();
    unsigned char* ws = P.ws;
    bf16_t* ABUF = (bf16_t*)(ws + OFF_ABUF); bf16_t* BIG = (bf16_t*)(ws + OFF_BIG);
    float* H = P.out;
    unsigned xk = 0;
    for (int ph = P.ph_lo; ph < P.ph_hi; ++ph) {
        int f = -1, sub = -1;
        if (ph >= 1 && ph <= 3) { f = 0; sub = ph - 1; }
        else if (ph >= 10 && ph <= 12) { f = 1; sub = ph - 10; }
        else if (ph >= 13 && ph <= 15) { f = 2; sub = ph - 13; }
        else if (ph >= 21 && ph <= 23) { f = 3; sub = ph - 21; }
        int reps = 1;
#ifdef PROBE_REPS
        if (ph == 0) reps += REP_PREP;
        if (ph == 7) reps += REP_ML;
        if (ph == 18 || ph == 19) reps += REP_AT;
        if (sub == 1 || ph == 5 || ph == 17) reps += REP_GEMM;
        if (ph == 6 || ph == 8) reps += REP_L0X;
#ifdef REP_DOWN3
        if (ph == 23) reps += REP_DOWN3;
#endif
#endif
        if (sub == 0 || ph == 4 || ph == 16) continue;
        float* SSQ = (float*)(ws + OFF_SS); bf16_t* AUX1B = (bf16_t*)(ws + OFF_AUX1);
        for (int rep = 0; rep < reps; ++rep) {
        if (rep) grid.sync();
        if (ph == 0) phase_prep(P, lds);
        else if (f >= 0) {
            if (sub == 1) {
                const int si = (f == 0) ? 0 : (f == 1) ? 2 : (f == 2) ? 3 : 5;
                const int pm0 = stage_rstd(lds, SSQ + (size_t)si * MTOK, 11264);
                EpiSwiGLU E{BIG, SSQ + (size_t)si * MTOK, (const LAS float*)(lds + 131072), pm0};
                run_gemm(lds, (f == 1 || f == 3) ? AUX1B : ABUF, (const bf16_t*)(ws + OFF_WGU + f * SZ_GU), 11264, 2048, E);
            } else {
                const int so = (f == 0) ? 1 : (f == 1) ? 3 : 4;
                if (f == 3) { EpiResid<false> E{H, H, nullptr, nullptr, 0.5f / (float)reps}; run_gemm(lds, BIG, (const bf16_t*)(ws + OFF_WDN + f * SZ_DN), 2048, 5632, E); }
                else { EpiResid<true> E{f == 0 ? P.in[0] : H, H, ABUF, SSQ + (size_t)so * MTOK, 0.5f}; run_gemm(lds, BIG, (const bf16_t*)(ws + OFF_WDN + f * SZ_DN), 2048, 5632, E); }
            }
        }
        else if (ph == 5) {
            phase_skinny<1, 0>(ABUF, (const bf16_t*)(ws + OFF_WABIN) + (size_t)6144 * 2048, (float*)(ws + OFF_GATES), P.in[7], SSQ + (size_t)1 * MTOK);
            const int pm0 = stage_rstd(lds, SSQ + (size_t)1 * MTOK, 6144);
            EpiProj0 E{BIG, SSQ + (size_t)1 * MTOK, (const LAS float*)(lds + 131072), pm0}; run_gemm(lds, ABUF, (const bf16_t*)(ws + OFF_WABIN), 6144, 2048, E);
        }
        else if (ph == 6) phase_conv_gmlp(P, lds);
        else if (ph == 7) phase_mlstm(P, lds);
        else if (ph == 8) phase_htnorm(P);
        else if (ph == 9) { EpiResid<true> E{H, H, AUX1B, SSQ + (size_t)2 * MTOK, 1.0f}; run_gemm(lds, ABUF, (const bf16_t*)(ws + OFF_WABOUT), 2048, 2048, E); }
        else if (ph == 17) {
            phase_skinny<3, 1>(ABUF, (const bf16_t*)(ws + OFF_WNSAIN) + (size_t)5120 * 2048, (float*)(ws + OFF_GATES), nullptr, SSQ + (size_t)4 * MTOK);
            const int pm0 = stage_rstd(lds, SSQ + (size_t)4 * MTOK, 5120);
            EpiProj1 E{BIG, (const float*)(ws + OFF_ROPE), SSQ + (size_t)4 * MTOK, (const LAS float*)(lds + 131072), pm0}; run_gemm(lds, ABUF, (const bf16_t*)(ws + OFF_WNSAIN), 5120, 2048, E);
        }
        else if (ph == 18) phase_compress(P, lds);
        else if (ph == 19) phase_attn(P, lds);
        else if (ph == 20) { EpiResid<true> E{H, H, AUX1B, SSQ + (size_t)5 * MTOK, 1.0f}; run_gemm(lds, ABUF, (const bf16_t*)(ws + OFF_WNSAOUT), 2048, 2048, E); }
        else if (ph == 24) phase_final_norm(H, P.in[19]);
        }
#ifdef FBAR_SLEEP
        if (ph + 1 < P.ph_hi) { if (ph == 0) { grid.sync(); if (threadIdx.x < 64) { const unsigned xi = xbar_setup(ws); if (threadIdx.x == 0) *(LAS unsigned*)(lds + 139008) = xi; } } else { ++xk; xbar_sync(ws, lds, xk); } }
#else
        if (ph + 1 < P.ph_hi) grid.sync();
#endif
#ifdef PROBE_SYNCS
        if (ph == 5) { for (int i = 0; i < PROBE_SYNCS; ++i) grid.sync(); }
#endif
    }
}

extern "C" void kernel_launch(void* const* d_in, const int* in_sizes, int n_in, void* d_out, int out_size, void* d_ws, size_t ws_size, hipStream_t stream) {
    static int grid = 0;
    if (grid == 0) {
        if (n_in != 20 || out_size != MTOK * DM || ws_size < WS_END) { fprintf(stderr, "kernel_launch: unexpected shapes (n_in %d out %d ws %zu need %zu)\n", n_in, out_size, ws_size, (size_t)WS_END); grid = -1; return; }
        int dev = 0, cus = 0, per_cu = 0;
        hipGetDevice(&dev);
        hipDeviceGetAttribute(&cus, hipDeviceAttributeMultiprocessorCount, dev);
        if (hipFuncSetAttribute((const void*)mega, hipFuncAttributeMaxDynamicSharedMemorySize, LDS_BYTES) != hipSuccess) { fprintf(stderr, "kernel_launch: hipFuncSetAttribute failed\n"); grid = -1; return; }
        if (hipOccupancyMaxActiveBlocksPerMultiprocessor(&per_cu, (const void*)mega, 512, LDS_BYTES) != hipSuccess || per_cu < 1) { fprintf(stderr, "kernel_launch: occupancy query says %d\n", per_cu); per_cu = 1; }
        (void)hipGetLastError();
        grid = cus * per_cu;
        if (grid > 256) grid = 256;
    }
    if (grid < 0) return;
    Params p{};
    for (int i = 0; i < 20; ++i) p.in[i] = (const float*)d_in[i];
    p.out = (float*)d_out; p.ws = (unsigned char*)d_ws;
#ifndef MULTI_LAUNCH
    p.ph_lo = 0; p.ph_hi = N_PHASES;
    void* args[] = {&p};
    hipError_t e = hipLaunchCooperativeKernel((const void*)mega, dim3(grid), dim3(512), args, LDS_BYTES, stream);
    if (e != hipSuccess) fprintf(stderr, "cooperative launch failed: %s (grid %d)\n", hipGetErrorString(e), grid);
#else
    for (int ph = 0; ph < N_PHASES; ++ph) {
        p.ph_lo = ph; p.ph_hi = ph + 1;
        void* args[] = {&p};
        hipError_t e = hipLaunchCooperativeKernel((const void*)mega, dim3(grid), dim3(512), args, LDS_BYTES, stream);
        if (e != hipSuccess) { fprintf(stderr, "launch %d failed: %s\n", ph, hipGetErrorString(e)); break; }
    }
#endif
}
```

```cpp
#define SKIP_ALPHA 1
#include <hip/hip_runtime.h>
#include <hip/hip_cooperative_groups.h>
#include <cstdio>
namespace cg = cooperative_groups;
namespace pg8 {
#define PG8_LAS __attribute__((address_space(3)))
typedef unsigned short bf16_t;
typedef short bf16x8 __attribute__((ext_vector_type(8)));
typedef float f32x4 __attribute__((ext_vector_type(4)));
typedef unsigned u32x4 __attribute__((ext_vector_type(4)));
constexpr int BM = 256, BK = 64, HALF = 128, HTB = HALF * BK * 2  , STAGE_BYTES = 8 * HTB, NXCD = 8, WGM = 8;

__host__ __device__ __forceinline__ int lds_byte(int r, int c) { const int st = (r >> 4) * 2 + (c >> 5), rr = r & 15, cc = c & 31, ob = rr * 64 + cc * 2; return st * 1024 + (ob ^ (((ob >> 9) & 1) << 5)); }
__host__ __device__ __forceinline__ void stage_rc(int b, int& R, int& C) { const int st = b / 1024, sb = b % 1024, swz = sb ^ (((sb >> 9) & 1) << 5); R = (st >> 1) * 16 + swz / 64; C = (st & 1) * 32 + (swz % 64) / 2; }
__host__ __device__ __forceinline__ int perm32(int rho) { const int n = rho >> 4, i = rho & 15; return 8 * (i >> 2) + 4 * n + (i & 3); }

struct Unit { int pm, pn; };
struct Gemm { const bf16_t* A; const bf16_t* Bt; int M, N, K; };

struct StaticOrder {
    int nM, nN, nwg, G, c;
    __host__ __device__ void init(int M, int N, int G_, int c_) { nM = M / BM; nN = N / BM; nwg = nM * nN; G = G_; c = c_; }
    __host__ __device__ bool next(int i, Unit& u) const {
        const long L = (long)i * G + c; if (L >= nwg) return false;
        int wgid = (int)L; { const int q = nwg / NXCD, r = nwg % NXCD, xcd = wgid % NXCD, off = wgid / NXCD; wgid = (xcd < r ? xcd * (q + 1) : r * (q + 1) + (xcd - r) * q) + off; }
        const int nig = WGM * nN, gid = wgid / nig, fm = gid * WGM, gsz = (nM - fm) < WGM ? (nM - fm) : WGM;
        u.pm = fm + ((wgid % nig) % gsz); u.pn = (wgid % nig) / gsz; return true;
    }
    __device__ __forceinline__ void a_ready(const Unit&) const {}
    __device__ __forceinline__ void done(const Unit&) const {}
};
template <class Epi, class Sched, bool STAMP = false>
__device__ __forceinline__ void gemm_phase(PG8_LAS unsigned char* lds, const Gemm g, const Sched& S, const Epi& E, unsigned long long* stamps) {
    int tid_ = threadIdx.x; asm volatile("" : "+v"(tid_)); const int tid = tid_, wid = __builtin_amdgcn_readfirstlane(tid >> 6), lane = tid & 63, wr = wid >> 2, wc = wid & 3, fr = lane & 15, fq = lane >> 4;
    const int K = g.K, nt = K / BK;
#define PG8_STAMP() do {} while (0)
    PG8_STAMP();
    unsigned voffA[2], voffB[2];
#pragma unroll
    for (int i = 0; i < 2; ++i) { int R, C; stage_rc(tid * 16 + i * 8192, R, C); const int Rb = Epi::PERM ? ((R & ~31) + perm32(R & 31)) : R;
        voffA[i] = (unsigned)(R * K + C) * 2u; voffB[i] = (unsigned)(Rb * K + C) * 2u; }
    const size_t kstep = (size_t)(BK * 2);
    const size_t hstep = (size_t)HALF * K * 2;
    const size_t tstep = 2 * hstep;
    const unsigned ldsw = (unsigned)wid * 1024u;
    const int aoff = lds_byte(wr * 64 + fr, fq * 8), boff = lds_byte(wc * 32 + fr, fq * 8);
#define PG8_SA(b, h) (((b) * 2 + (h)) * HTB)
#define PG8_SB(b, h) ((4 + (b) * 2 + (h)) * HTB)
#define PG8_STAGE(bufoff, gbase, voff) do { _Pragma("unroll") for (int _i = 0; _i < 2; ++_i) \
        __builtin_amdgcn_global_load_lds((const unsigned*)((const char*)(gbase) + (voff)[_i]), (PG8_LAS unsigned*)(lds + (bufoff) + ldsw + _i * 8192), 16, 0, 0); } while (0)
#define PG8_LDA(dst, b, h) do { _Pragma("unroll") for (int m = 0; m < 4; ++m) _Pragma("unroll") for (int k = 0; k < 2; ++k) dst[m][k] = *(const PG8_LAS bf16x8*)(lds + PG8_SA(b, h) + aoff + m * 2048 + k * 1024); } while (0)
#define PG8_LDB(dst, b, h) do { _Pragma("unroll") for (int n = 0; n < 2; ++n) _Pragma("unroll") for (int k = 0; k < 2; ++k) dst[n][k] = *(const PG8_LAS bf16x8*)(lds + PG8_SB(b, h) + boff + n * 2048 + k * 1024); } while (0)
#define PG8_MMA(ai, bj, At, Bt) do { __builtin_amdgcn_s_setprio(1); _Pragma("unroll") for (int m = 0; m < 4; ++m) _Pragma("unroll") for (int n = 0; n < 2; ++n) _Pragma("unroll") for (int k = 0; k < 2; ++k) \
        acc[ai][bj][m][n] = __builtin_amdgcn_mfma_f32_16x16x32_bf16(Bt[n][k], At[m][k], acc[ai][bj][m][n], 0, 0, 0); __builtin_amdgcn_s_setprio(0); } while (0)
#define PG8_WAIT_V(n) asm volatile("s_waitcnt vmcnt(" #n ")" ::: "memory")
#define PG8_WAIT_L(n) asm volatile("s_waitcnt lgkmcnt(" #n ")" ::: "memory")
#define PG8_BAR __builtin_amdgcn_s_barrier()
#define PG8_SCHED __builtin_amdgcn_sched_barrier(0)
    Unit cur, nxt; int ui = 0;
    if (!S.next(0, cur)) return;
    f32x4 acc[2][2][4][2];
#pragma unroll
    for (int a = 0; a < 2; ++a)
#pragma unroll
        for (int b = 0; b < 2; ++b)
#pragma unroll
            for (int m = 0; m < 4; ++m)
#pragma unroll
                for (int n = 0; n < 2; ++n) acc[a][b][m][n] = (f32x4){0.f, 0.f, 0.f, 0.f};
    bf16x8 At[4][2], B0[2][2], B1[2][2];
    const char* cA = (const char*)g.A + (size_t)cur.pm * tstep; const char* cB = (const char*)g.Bt + (size_t)cur.pn * tstep;
    S.a_ready(cur);
    typename Epi::Pre pre = E.pre(cur, wr, fr);
    PG8_STAGE(PG8_SB(0, 0), cB, voffB); PG8_STAGE(PG8_SA(0, 0), cA, voffA); PG8_STAGE(PG8_SB(0, 1), cB + hstep, voffB); PG8_STAGE(PG8_SA(0, 1), cA + hstep, voffA);
    if (wr == 1) PG8_BAR;
    PG8_WAIT_V(4); PG8_BAR;
    PG8_STAGE(PG8_SB(1, 0), cB + kstep, voffB); PG8_STAGE(PG8_SA(1, 0), cA + kstep, voffA); PG8_STAGE(PG8_SB(1, 1), cB + hstep + kstep, voffB);
    PG8_WAIT_V(6); PG8_BAR;
    PG8_STAMP();
    for (;;) {
        const bool has_next = S.next(ui + 1, nxt);
        const char* nA = has_next ? (const char*)g.A + (size_t)nxt.pm * tstep : cA; const char* nB = has_next ? (const char*)g.Bt + (size_t)nxt.pn * tstep : cB;
        for (int t = 0; t < nt; t += 2) {
            const bool last = (t == nt - 2);
            const char* a1 = cA + (size_t)(t + 1) * kstep;
            const char* a2 = last ? nA : cA + (size_t)(t + 2) * kstep; const char* b2 = last ? nB : cB + (size_t)(t + 2) * kstep;
            const char* a3 = a2 + kstep; const char* b3 = b2 + kstep;
            if (last && has_next) S.a_ready(nxt);
            PG8_LDB(B0, 0, 0); PG8_SCHED; PG8_LDA(At, 0, 0); PG8_STAGE(PG8_SA(1, 1), a1 + hstep, voffA);
            PG8_WAIT_L(8); PG8_BAR; PG8_WAIT_L(0); PG8_MMA(0, 0, At, B0); PG8_BAR; PG8_SCHED;
            PG8_LDB(B1, 0, 1); PG8_STAGE(PG8_SB(0, 0), b2, voffB);
            PG8_BAR; PG8_WAIT_L(0); PG8_MMA(0, 1, At, B1); PG8_BAR;
            PG8_LDA(At, 0, 1); PG8_STAGE(PG8_SA(0, 0), a2, voffA);
            PG8_BAR; PG8_WAIT_L(0); PG8_MMA(1, 0, At, B0); PG8_BAR; PG8_SCHED;
            PG8_STAGE(PG8_SB(0, 1), b2 + hstep, voffB);
            PG8_WAIT_V(6); PG8_BAR; PG8_MMA(1, 1, At, B1); PG8_BAR;
            PG8_LDB(B0, 1, 0); PG8_SCHED; PG8_LDA(At, 1, 0); PG8_STAGE(PG8_SA(0, 1), a2 + hstep, voffA);
            PG8_WAIT_L(8); PG8_BAR; PG8_WAIT_L(0); PG8_MMA(0, 0, At, B0); PG8_BAR; PG8_SCHED;
            PG8_LDB(B1, 1, 1); PG8_STAGE(PG8_SB(1, 0), b3, voffB);
            PG8_BAR; PG8_WAIT_L(0); PG8_MMA(0, 1, At, B1); PG8_BAR;
            PG8_LDA(At, 1, 1); PG8_STAGE(PG8_SA(1, 0), a3, voffA);
            PG8_BAR; PG8_WAIT_L(0); PG8_MMA(1, 0, At, B0); PG8_BAR; PG8_SCHED;
            PG8_STAGE(PG8_SB(1, 1), b3 + hstep, voffB);
            PG8_WAIT_V(6); PG8_BAR; PG8_MMA(1, 1, At, B1); PG8_BAR;
        }
        PG8_STAMP();
        if constexpr (!Epi::AFTER_DRAIN) { E(acc, cur, wr, wc, fr, fq, pre); S.done(cur); }
        PG8_STAMP();
        if (!has_next) break;
#pragma unroll
        for (int a = 0; a < 2; ++a)
#pragma unroll
            for (int b = 0; b < 2; ++b)
#pragma unroll
                for (int m = 0; m < 4; ++m)
#pragma unroll
                    for (int n = 0; n < 2; ++n) acc[a][b][m][n] = (f32x4){0.f, 0.f, 0.f, 0.f};
        cur = nxt; cA = nA; cB = nB; ++ui;
        pre = E.pre(cur, wr, fr);
    }
    PG8_WAIT_V(0);
    if (wr == 0) PG8_BAR;
    PG8_BAR;
    if constexpr (Epi::AFTER_DRAIN) { E.fused(acc, cur, wr, wc, fr, fq, lds, wid, lane); S.done(cur); }
    PG8_STAMP();
#undef PG8_STAMP
#undef PG8_SA
#undef PG8_SB
#undef PG8_STAGE
#undef PG8_LDA
#undef PG8_LDB
#undef PG8_MMA
#undef PG8_WAIT_V
#undef PG8_WAIT_L
#undef PG8_BAR
#undef PG8_SCHED
}
}
using pg8::bf16_t; using pg8::bf16x8; using pg8::f32x4; using pg8::u32x4; using pg8::Unit;
#define LAS __attribute__((address_space(3)))
typedef unsigned u32x2 __attribute__((ext_vector_type(2)));

constexpr int MTOK = 16384, DM = 2048, DFF = 5632, SEQL = 4096;
constexpr float EPSN = 1e-6f;

struct Params { const float* in[20]; float* out; unsigned char* ws; int ph_lo, ph_hi; };

constexpr size_t SZ_GU = (size_t)11264 * 2048 * 2, SZ_DN = (size_t)2048 * 5632 * 2;
constexpr size_t OFF_WGU = 0;
constexpr size_t OFF_WDN = OFF_WGU + 4 * SZ_GU;
constexpr size_t OFF_WABIN = OFF_WDN + 4 * SZ_DN;
constexpr size_t OFF_WABOUT = OFF_WABIN + (size_t)6208 * 2048 * 2;
constexpr size_t OFF_WNSAIN = OFF_WABOUT + (size_t)2048 * 2048 * 2;
constexpr size_t OFF_WNSAOUT = OFF_WNSAIN + (size_t)5184 * 2048 * 2;
constexpr size_t OFF_WC1 = OFF_WNSAOUT + (size_t)2048 * 2048 * 2;
constexpr size_t OFF_WC2 = OFF_WC1 + (size_t)2 * 128 * 4096 * 2;
constexpr size_t OFF_ABUF = OFF_WC2 + (size_t)2 * 128 * 128 * 2;
constexpr size_t OFF_BIG = OFF_ABUF + (size_t)MTOK * 2048 * 2;
constexpr size_t OFF_AUX1 = OFF_BIG + (size_t)MTOK * 6144 * 2 + 262144;
constexpr size_t OFF_AUX2 = OFF_AUX1 + (size_t)MTOK * 2048 * 2;
constexpr size_t OFF_KT = OFF_AUX2 + (size_t)MTOK * 1024 * 4;
constexpr size_t OFF_GATES = OFF_KT + (size_t)MTOK * 1024 * 2;
constexpr size_t OFF_ROPE = OFF_GATES + (size_t)MTOK * 48 * 4;
constexpr size_t OFF_KCMP = OFF_ROPE + (size_t)4096 * 32 * 4;
constexpr size_t OFF_VCMPT = OFF_KCMP + (size_t)16 * 256 * 128 * 2;
constexpr size_t OFF_SS = OFF_VCMPT + (size_t)16 * 128 * 256 * 2;
constexpr size_t OFF_BAR = OFF_SS + (size_t)6 * MTOK * 4;
constexpr size_t OFF_XB = OFF_BAR + 256;
constexpr size_t WS_END = OFF_XB + 1024 + 17 * 256;

__device__ __forceinline__ int otid() { int t = threadIdx.x; asm volatile("" : "+v"(t)); return t; }
__device__ __forceinline__ unsigned f2bf(float f) { unsigned u = __float_as_uint(f); u += 0x7FFFu + ((u >> 16) & 1u); return u >> 16; }
typedef float f32x2v __attribute__((ext_vector_type(2)));
typedef __bf16 bf16x2v __attribute__((ext_vector_type(2)));
__device__ __forceinline__ unsigned pack2(float a, float b) { f32x2v v = {a, b}; bf16x2v r = __builtin_convertvector(v, bf16x2v); return __builtin_bit_cast(unsigned, r); }
__device__ __forceinline__ float bflo(unsigned u) { return __uint_as_float(u << 16); }
__device__ __forceinline__ float bfhi(unsigned u) { return __uint_as_float(u & 0xFFFF0000u); }
__device__ __forceinline__ float bfs(short s) { return __uint_as_float(((unsigned)(unsigned short)s) << 16); }
__device__ __forceinline__ f32x4 mfma16(bf16x8 x, bf16x8 y, f32x4 c) { return __builtin_amdgcn_mfma_f32_16x16x32_bf16(x, y, c, 0, 0, 0); }
__device__ __forceinline__ bf16x8 ld8(const bf16_t* p) { return *(const bf16x8*)p; }
__device__ __forceinline__ bf16x8 lds8(const LAS bf16_t* p) { return *(const LAS bf16x8*)p; }
typedef short s16x4 __attribute__((ext_vector_type(4)));
__device__ __forceinline__ s16x4 lds_tr4(const LAS bf16_t* p) { return __builtin_amdgcn_ds_read_tr16_b64_v4i16((LAS s16x4*)p); }
__device__ __forceinline__ bf16x8 mk8(float a, float b, float c, float d, float e, float f, float g, float h) {
    u32x4 u = {pack2(a, b), pack2(c, d), pack2(e, f), pack2(g, h)}; return __builtin_bit_cast(bf16x8, u); }
__device__ __forceinline__ float xmax4(float x) {
    auto r = __builtin_amdgcn_permlane32_swap(__float_as_uint(x), __float_as_uint(x), false, false);
    x = fmaxf(__uint_as_float(r[0]), __uint_as_float(r[1]));
    auto r2 = __builtin_amdgcn_permlane16_swap(__float_as_uint(x), __float_as_uint(x), false, false);
    return fmaxf(__uint_as_float(r2[0]), __uint_as_float(r2[1]));
}
__device__ __forceinline__ float xsum4(float x) {
    auto r = __builtin_amdgcn_permlane32_swap(__float_as_uint(x), __float_as_uint(x), false, false);
    x = __uint_as_float(r[0]) + __uint_as_float(r[1]);
    auto r2 = __builtin_amdgcn_permlane16_swap(__float_as_uint(x), __float_as_uint(x), false, false);
    return __uint_as_float(r2[0]) + __uint_as_float(r2[1]);
}
__device__ __forceinline__ float wave_sum(float v) { for (int o = 32; o; o >>= 1) v += __shfl_xor(v, o); return v; }
__device__ __forceinline__ float sigm(float x) { return __builtin_amdgcn_rcpf(1.f + __expf(-x)); }
__device__ __forceinline__ float silu(float x) { return x * __builtin_amdgcn_rcpf(1.f + __expf(-x)); }
__device__ __forceinline__ float gelu_t(float x) { return x * __builtin_amdgcn_rcpf(1.f + __expf(-1.5957691216f * (x + 0.044715f * x * x * x))); }

struct EpiSwiGLU {
    static constexpr bool PERM = true, AFTER_DRAIN = false;
    bf16_t* O; const float* SS; const LAS float* lrs; int pm0;
    struct Pre { };
    __device__ __forceinline__ Pre pre(const Unit&, int, int) const { return Pre{}; }
    __device__ __forceinline__ float rstd_of(const Unit& u, int lrow) const {
        if (u.pm == pm0) return lrs[lrow];
        return rsqrtf(SS[u.pm * 256 + lrow] * (1.0f / 2048.0f) + EPSN);
    }
    __device__ __forceinline__ void operator()(const f32x4 (&acc)[2][2][4][2], const Unit& u, int wr, int wc, int fr, int fq, const Pre& pre) const {
        const int row0 = u.pm * 256 + wr * 64 + fr, col0 = u.pn * 128 + wc * 32 + 8 * fq;
#pragma unroll
        for (int ai = 0; ai < 2; ++ai)
#pragma unroll
            for (int m = 0; m < 4; ++m) {
                const float rs = rstd_of(u, wr * 64 + ai * 128 + m * 16 + fr);
                float h[8];
#pragma unroll
                for (int n = 0; n < 2; ++n)
#pragma unroll
                    for (int j = 0; j < 4; ++j) h[4 * n + j] = silu(acc[ai][0][m][n][j] * rs) * (acc[ai][1][m][n][j] * rs);
                u32x4 o = {pack2(h[0], h[1]), pack2(h[2], h[3]), pack2(h[4], h[5]), pack2(h[6], h[7])};
                *(u32x4*)(O + (size_t)(row0 + ai * 128 + m * 16) * DFF + col0) = o;
            }
    }
};
template <bool COPY> struct EpiResid {
    static constexpr bool PERM = false, AFTER_DRAIN = false;
    const float* R; float* O; bf16_t* Ob; float* SS; float scale;
    struct Pre { };
    __device__ __forceinline__ Pre pre(const Unit&, int, int) const { return Pre{}; }
    __device__ __forceinline__ void operator()(const f32x4 (&acc)[2][2][4][2], const Unit& u, int wr, int wc, int fr, int fq, const Pre& pre) const {
        const int row0 = u.pm * 256 + wr * 64 + fr, col0 = u.pn * 256 + wc * 32 + 4 * fq;
#pragma unroll
        for (int ai = 0; ai < 2; ++ai) {
            f32x4 rv[4][2][2];
#pragma unroll
            for (int m = 0; m < 4; ++m)
#pragma unroll
                for (int bj = 0; bj < 2; ++bj)
#pragma unroll
                    for (int n = 0; n < 2; ++n) rv[m][bj][n] = *(const f32x4*)(R + (size_t)(row0 + ai * 128 + m * 16) * DM + col0 + bj * 128 + n * 16);
#pragma unroll
            for (int m = 0; m < 4; ++m) {
                const size_t ro = (size_t)(row0 + ai * 128 + m * 16) * DM + col0;
                float ss = 0.f;
#pragma unroll
                for (int bj = 0; bj < 2; ++bj)
#pragma unroll
                    for (int n = 0; n < 2; ++n) {
                        const f32x4 hv = rv[m][bj][n] + acc[ai][bj][m][n] * scale;
                        *(f32x4*)(O + ro + bj * 128 + n * 16) = hv;
                        if (COPY) {
                            u32x2 o = {pack2(hv[0], hv[1]), pack2(hv[2], hv[3])};
                            *(u32x2*)(Ob + ro + bj * 128 + n * 16) = o;
                            ss += hv[0] * hv[0] + hv[1] * hv[1] + hv[2] * hv[2] + hv[3] * hv[3];
                        }
                    }
                if (COPY) { ss = xsum4(ss); if (fq == 0) (void)__hip_atomic_fetch_add(SS + row0 + ai * 128 + m * 16, ss, __ATOMIC_RELAXED, __HIP_MEMORY_SCOPE_AGENT); }
            }
        }
    }
};
struct EpiProj0 {
    static constexpr bool PERM = true, AFTER_DRAIN = false;
    bf16_t* O; const float* SS; const LAS float* lrs; int pm0;
    struct Pre { };
    __device__ __forceinline__ Pre pre(const Unit&, int, int) const { return Pre{}; }
    __device__ __forceinline__ float rstd_of(const Unit& u, int lrow) const {
        if (u.pm == pm0) return lrs[lrow];
        return rsqrtf(SS[u.pm * 256 + lrow] * (1.0f / 2048.0f) + EPSN);
    }
    __device__ __forceinline__ void operator()(const f32x4 (&acc)[2][2][4][2], const Unit& u, int wr, int wc, int fr, int fq, const Pre& pre) const {
        const int row0 = u.pm * 256 + wr * 64 + fr, col0 = u.pn * 256 + wc * 32 + 8 * fq;
        const bool g = u.pn < 8;
#pragma unroll
        for (int ai = 0; ai < 2; ++ai)
#pragma unroll
            for (int m = 0; m < 4; ++m) {
                const float rs = rstd_of(u, wr * 64 + ai * 128 + m * 16 + fr);
#pragma unroll
                for (int bj = 0; bj < 2; ++bj) {
                    float h[8];
#pragma unroll
                    for (int n = 0; n < 2; ++n)
#pragma unroll
                        for (int j = 0; j < 4; ++j) { const float v = acc[ai][bj][m][n][j] * rs; h[4 * n + j] = g ? gelu_t(v) : v; }
                    u32x4 o = {pack2(h[0], h[1]), pack2(h[2], h[3]), pack2(h[4], h[5]), pack2(h[6], h[7])};
                    *(u32x4*)(O + (size_t)(row0 + ai * 128 + m * 16) * 6144 + col0 + bj * 128) = o;
                }
            }
    }
};
struct EpiProj1 {
    static constexpr bool PERM = false, AFTER_DRAIN = false;
    bf16_t* O; const float* rope; const float* SS; const LAS float* lrs; int pm0;
    struct Pre { };
    __device__ __forceinline__ Pre pre(const Unit&, int, int) const { return Pre{}; }
    __device__ __forceinline__ float rstd_of(const Unit& u, int lrow) const {
        if (u.pm == pm0) return lrs[lrow];
        return rsqrtf(SS[u.pm * 256 + lrow] * (1.0f / 2048.0f) + EPSN);
    }
    __device__ __forceinline__ void operator()(const f32x4 (&acc)[2][2][4][2], const Unit& u, int wr, int wc, int fr, int fq, const Pre& pre) const {
        const int row0 = u.pm * 256 + wr * 64 + fr, col0 = u.pn * 256 + wc * 32 + 4 * fq;
#pragma unroll
        for (int ai = 0; ai < 2; ++ai) {
            f32x4 rcos[4], rsin[4];
            if (wc == 0) {
#pragma unroll
                for (int m = 0; m < 4; ++m) { const float* rp = rope + (size_t)((row0 + ai * 128 + m * 16) & 4095) * 32 + 4 * fq; rcos[m] = *(const f32x4*)rp; rsin[m] = *(const f32x4*)(rp + 16); }
            }
#pragma unroll
            for (int bj = 0; bj < 2; ++bj) {
                const int head = u.pn * 2 + bj;
                const bool isq = head < 16;
                const bool dorope = (wc == 0) && (isq || ((((head - 16) >> 2) & 1) == 0));
                const float sc = isq ? 0.08838834764831845f * 1.4426950408889634f : 1.f;
#pragma unroll
                for (int m = 0; m < 4; ++m) {
                    const int row = row0 + ai * 128 + m * 16;
                    const float rs = rstd_of(u, wr * 64 + ai * 128 + m * 16 + fr) * sc;
                    f32x4 v0 = acc[ai][bj][m][0] * rs, v1 = acc[ai][bj][m][1] * rs;
                    if (dorope) {
                        const f32x4 c = rcos[m], s = rsin[m];
                        const f32x4 a = v0 * c - v1 * s, b = v0 * s + v1 * c; v0 = a; v1 = b;
                    }
                    bf16_t* op = O + (size_t)row * 5120 + col0 + bj * 128;
                    u32x2 o0 = {pack2(v0[0], v0[1]), pack2(v0[2], v0[3])}, o1 = {pack2(v1[0], v1[1]), pack2(v1[2], v1[3])};
                    *(u32x2*)op = o0; *(u32x2*)(op + 16) = o1;
                }
            }
        }
    }
};

struct Job { const float* src; bf16_t* dst; const float* gain; int K, ldn, nvalid, ntn, remap, off; };
__device__ __forceinline__ void make_job(const Params& P, int j, Job& J) {
    unsigned char* ws = P.ws;
    J.gain = nullptr;
    if (j < 12) {
        const int fi = j / 3, kind = j - 3 * fi;
        if (kind < 2) { J.src = P.in[2 + kind] + (size_t)fi * 2048 * 5632; J.dst = (bf16_t*)(ws + OFF_WGU + fi * SZ_GU); J.K = 2048; J.ldn = 5632; J.nvalid = 5632; J.ntn = 88; J.remap = 1; J.off = kind * 128; J.gain = P.in[1] + (size_t)fi * 2048; }
        else { J.src = P.in[4] + (size_t)fi * 5632 * 2048; J.dst = (bf16_t*)(ws + OFF_WDN + fi * SZ_DN); J.K = 5632; J.ldn = 2048; J.nvalid = 2048; J.ntn = 32; J.remap = 0; J.off = 0; }
    } else if (j == 12) { J.src = P.in[6]; J.dst = (bf16_t*)(ws + OFF_WABIN); J.K = 2048; J.ldn = 6152; J.nvalid = 6152; J.ntn = 97; J.remap = 0; J.off = 0; J.gain = P.in[5]; }
    else if (j == 13) { J.src = P.in[13]; J.dst = (bf16_t*)(ws + OFF_WABOUT); J.K = 2048; J.ldn = 2048; J.nvalid = 2048; J.ntn = 32; J.remap = 0; J.off = 0; }
    else if (j == 14) { J.src = P.in[14]; J.dst = (bf16_t*)(ws + OFF_WNSAIN); J.K = 2048; J.ldn = 5168; J.nvalid = 5168; J.ntn = 81; J.remap = 0; J.off = 0; J.gain = P.in[5] + 2048; }
    else if (j == 15) { J.src = P.in[18]; J.dst = (bf16_t*)(ws + OFF_WNSAOUT); J.K = 2048; J.ldn = 2048; J.nvalid = 2048; J.ntn = 32; J.remap = 0; J.off = 0; }
    else if (j < 18) { const int kv = j - 16; J.src = P.in[16] + (size_t)kv * 4096 * 128; J.dst = (bf16_t*)(ws + OFF_WC1) + (size_t)kv * 128 * 4096; J.K = 4096; J.ldn = 128; J.nvalid = 128; J.ntn = 2; J.remap = 0; J.off = 0; }
    else { const int kv = j - 18; J.src = P.in[17] + (size_t)kv * 128 * 128; J.dst = (bf16_t*)(ws + OFF_WC2) + (size_t)kv * 128 * 128; J.K = 128; J.ldn = 128; J.nvalid = 128; J.ntn = 2; J.remap = 0; J.off = 0; }
}
constexpr int NT_CONVERT = 12 * 1408 + 16 * 97 + 16 * 32 + 16 * 81 + 16 * 32 + 2 * 64 + 2 * 2;
__device__ __forceinline__ void phase_prep(const Params& P, LAS unsigned char* lds) {
    LAS float* tile = (LAS float*)lds;
    const int tid = otid();
    if (tid == 0) ((unsigned*)(P.ws + OFF_XB))[blockIdx.x] = (unsigned)__builtin_amdgcn_s_getreg((3 << 11) | 20) & 0xFu;
    if (blockIdx.x == 0 && tid < 17) __hip_atomic_store((unsigned*)(P.ws + OFF_XB + 1024 + 256 * tid), 0u, __ATOMIC_RELAXED, __HIP_MEMORY_SCOPE_AGENT);
    {
        const int idx = blockIdx.x * 512 + tid;
        if (idx < 4096 * 16) {
            const int pos = idx >> 4, i = idx & 15;
            const float inv = 1.0f / powf(500000.0f, (float)i * (1.0f / 16.0f));
            const float ang = (float)pos * inv;
            float s, c; sincosf(ang, &s, &c);
            float* rp = (float*)(P.ws + OFF_ROPE) + (size_t)pos * 32;
            rp[i] = c; rp[16 + i] = s;
        }
    }
    {
        float* SS = (float*)(P.ws + OFF_SS); bf16_t* XB = (bf16_t*)(P.ws + OFF_ABUF);
        for (int i = blockIdx.x * 512 + tid; i < 5 * MTOK; i += gridDim.x * 512) SS[MTOK + i] = 0.f;
        const int wave = tid >> 6, lane = tid & 63;
        for (int row = blockIdx.x * 8 + wave; row < MTOK; row += gridDim.x * 8) {
            const float4* s = (const float4*)(P.in[0] + (size_t)row * DM);
            float ss = 0.f;
#pragma unroll
            for (int i = 0; i < 8; ++i) {
                const float4 v = s[lane + 64 * i];
                ss += v.x * v.x + v.y * v.y + v.z * v.z + v.w * v.w;
                u32x2 o = {pack2(v.x, v.y), pack2(v.z, v.w)};
                *(u32x2*)(XB + (size_t)row * DM + 4 * (lane + 64 * i)) = o;
            }
            ss = wave_sum(ss);
            if (lane == 0) SS[row] = ss;
        }
    }
    {
        Job J, Jn; float4 v[4]; int k0 = 0, n0 = 0, k0n = 0, n0n = 0;
#define PREP_FIND(T, JJ, K0, N0) do { int lt_ = (T), j_ = 0; for (;; ++j_) { make_job(P, j_, JJ); const int n_ = (JJ.K >> 7) * JJ.ntn; if (lt_ < n_) break; lt_ -= n_; } \
            const int nkt_ = JJ.K >> 7; K0 = (lt_ % nkt_) * 128; N0 = (lt_ / nkt_) * 64; } while (0)
#define PREP_LOAD(JJ, K0, N0) do { _Pragma("unroll") for (int i = 0; i < 4; ++i) { const int idx = tid + 512 * i, k = idx >> 4, n = (N0) + 4 * (idx & 15); \
            float4 x = make_float4(0.f, 0.f, 0.f, 0.f); if (n < JJ.nvalid) x = *(const float4*)(JJ.src + (size_t)((K0) + k) * JJ.ldn + n); \
            if (JJ.gain) { const float gk = JJ.gain[(K0) + k]; x.x *= gk; x.y *= gk; x.z *= gk; x.w *= gk; } v[i] = x; } } while (0)
        int t = blockIdx.x;
        if (t < NT_CONVERT) { PREP_FIND(t, Jn, k0n, n0n); PREP_LOAD(Jn, k0n, n0n); }
        for (; t < NT_CONVERT; t += gridDim.x) {
            J = Jn; k0 = k0n; n0 = n0n;
#pragma unroll
            for (int i = 0; i < 4; ++i) { const int idx = tid + 512 * i, k = idx >> 4, c4 = idx & 15; LAS float* tp = tile + k * 65 + 4 * c4; tp[0] = v[i].x; tp[1] = v[i].y; tp[2] = v[i].z; tp[3] = v[i].w; }
            __syncthreads();
            if (t + (int)gridDim.x < NT_CONVERT) { PREP_FIND(t + (int)gridDim.x, Jn, k0n, n0n); PREP_LOAD(Jn, k0n, n0n); }
#pragma unroll
            for (int i = 0; i < 2; ++i) {
                const int idx = tid + 512 * i, n = idx >> 4, kg = idx & 15;
                float f[8];
#pragma unroll
                for (int jj = 0; jj < 8; ++jj) f[jj] = tile[(8 * kg + jj) * 65 + n];
                u32x4 o = {pack2(f[0], f[1]), pack2(f[2], f[3]), pack2(f[4], f[5]), pack2(f[6], f[7])};
                const int nn = n0 + n, row = J.remap ? ((nn >> 7) * 256 + J.off + (nn & 127)) : nn;
                *(u32x4*)(J.dst + (size_t)row * J.K + k0 + 8 * kg) = o;
            }
            __syncthreads();
        }
#undef PREP_FIND
#undef PREP_LOAD
    }
}

__device__ __forceinline__ void phase_norm(const float* src, const float* g, bf16_t* dst) {
    const int wave = otid() >> 6, lane = otid() & 63;
    for (int row = blockIdx.x * 8 + wave; row < MTOK; row += gridDim.x * 8) {
        const float4* s = (const float4*)(src + (size_t)row * DM);
        float4 v[8]; float ss = 0.f;
#pragma unroll
        for (int i = 0; i < 8; ++i) { v[i] = s[lane + 64 * i]; ss += v[i].x * v[i].x + v[i].y * v[i].y + v[i].z * v[i].z + v[i].w * v[i].w; }
        ss = wave_sum(ss);
        const float r = rsqrtf(ss * (1.0f / 2048.0f) + EPSN);
#pragma unroll
        for (int i = 0; i < 8; ++i) {
            const float4 gg = ((const float4*)g)[lane + 64 * i];
            u32x2 o = {pack2(v[i].x * r * gg.x, v[i].y * r * gg.y), pack2(v[i].z * r * gg.z, v[i].w * r * gg.w)};
            *(u32x2*)(dst + (size_t)row * DM + 4 * (lane + 64 * i)) = o;
        }
    }
}
__device__ __forceinline__ void phase_final_norm(float* io, const float* g) {
    const int wave = otid() >> 6, lane = otid() & 63;
    for (int row = blockIdx.x * 8 + wave; row < MTOK; row += gridDim.x * 8) {
        float4* s = (float4*)(io + (size_t)row * DM);
        float4 v[8]; float ss = 0.f;
#pragma unroll
        for (int i = 0; i < 8; ++i) { v[i] = s[lane + 64 * i]; ss += v[i].x * v[i].x + v[i].y * v[i].y + v[i].z * v[i].z + v[i].w * v[i].w; }
        ss = wave_sum(ss);
        const float r = rsqrtf(ss * (1.0f / 2048.0f) + EPSN);
#pragma unroll
        for (int i = 0; i < 8; ++i) {
            const float4 gg = ((const float4*)g)[lane + 64 * i];
            s[lane + 64 * i] = make_float4(v[i].x * r * gg.x, v[i].y * r * gg.y, v[i].z * r * gg.z, v[i].w * r * gg.w);
        }
    }
}

template <int NT, int MODE>
__device__ __forceinline__ void phase_skinny(LAS unsigned char* lds, const bf16_t* A, const bf16_t* Bt, float* G, const float* bias, const float* SS) {
    const int wave = otid() >> 6, lane = otid() & 63, fr = lane & 15, fq = lane >> 4, half = wave >> 2, w4 = wave & 3;
    LAS f32x4* xch = (LAS f32x4*)lds;
    for (int rt0 = blockIdx.x * 4; rt0 < MTOK / 16; rt0 += gridDim.x * 4) {
        const int rt = rt0 + w4;
        f32x4 acc[NT];
#pragma unroll
        for (int n = 0; n < NT; ++n) acc[n] = (f32x4){0.f, 0.f, 0.f, 0.f};
        const bf16_t* ap = A + (size_t)(rt * 16 + fr) * DM + 8 * fq + 1024 * half;
        const bf16_t* bp = Bt + (size_t)fr * DM + 8 * fq + 1024 * half;
#pragma unroll 8
        for (int ks = 0; ks < 32; ++ks) {
            const bf16x8 a = ld8(ap + 32 * ks);
#pragma unroll
            for (int n = 0; n < NT; ++n) { const bf16x8 b = ld8(bp + (size_t)n * 16 * DM + 32 * ks); acc[n] = mfma16(b, a, acc[n]); }
        }
        if (half) {
#pragma unroll
            for (int n = 0; n < NT; ++n) xch[(w4 * NT + n) * 64 + lane] = acc[n];
        }
        __syncthreads();
        if (!half) {
#pragma unroll
            for (int n = 0; n < NT; ++n) acc[n] += xch[(w4 * NT + n) * 64 + lane];
            const int token = rt * 16 + fr;
            const float rs = rsqrtf(SS[token] * (1.0f / 2048.0f) + EPSN);
            if (MODE == 0) {
                if (fq < 2) { const f32x4 b = *(const f32x4*)(bias + 4 * fq); *(f32x4*)(G + (size_t)token * 8 + 4 * fq) = acc[0] * rs + b; }
            } else {
#pragma unroll
                for (int n = 0; n < NT; ++n) { f32x4 o; for (int j = 0; j < 4; ++j) o[j] = sigm(acc[n][j] * rs); *(f32x4*)(G + (size_t)token * 48 + 16 * n + 4 * fq) = o; }
            }
        }
        __syncthreads();
    }
}

__device__ __forceinline__ void conv_wave_item(const Params& P, int item, int lane) {
    const bf16_t* BIG = (const bf16_t*)(P.ws + OFF_BIG); bf16_t* QK = (bf16_t*)(P.ws + OFF_AUX1); bf16_t* KT = (bf16_t*)(P.ws + OFF_KT);
    const float* cw = P.in[11];
    const int tgp = item >> 5, cgp = item & 31, tg = lane & 7, cg = lane >> 3;
    const int tok0 = tgp * 64 + 8 * tg, c0 = cgp * 64 + 8 * cg, pos0 = tok0 & 4095;
    float w[4][8];
#pragma unroll
    for (int jj = 0; jj < 4; ++jj) { const float4 a = *(const float4*)(cw + jj * 2048 + c0), b = *(const float4*)(cw + jj * 2048 + c0 + 4);
        w[jj][0] = a.x; w[jj][1] = a.y; w[jj][2] = a.z; w[jj][3] = a.w; w[jj][4] = b.x; w[jj][5] = b.y; w[jj][6] = b.z; w[jj][7] = b.w; }
    bf16x8 xr[11];
#pragma unroll
    for (int r = 0; r < 11; ++r) {
        const bool ok = (r >= 3) || (pos0 != 0);
        const int t = ok ? (tok0 - 3 + r) : tok0;
        const bf16x8 v = ld8(BIG + (size_t)t * 6144 + 2048 + c0);
        xr[r] = ok ? v : (bf16x8){0, 0, 0, 0, 0, 0, 0, 0};
    }
    const float ksc = (c0 >= 1024) ? 0.0625f : 1.0f;
    float o[8][8];
#pragma unroll
    for (int i = 0; i < 8; ++i)
#pragma unroll
        for (int j = 0; j < 8; ++j) {
            float a = 0.f;
#pragma unroll
            for (int jj = 0; jj < 4; ++jj) a += w[jj][j] * bfs(xr[i + jj][j]);
            o[i][j] = silu(a) * ksc;
        }
#pragma unroll
    for (int i = 0; i < 8; ++i) {
        u32x4 v = {pack2(o[i][0], o[i][1]), pack2(o[i][2], o[i][3]), pack2(o[i][4], o[i][5]), pack2(o[i][6], o[i][7])};
        *(u32x4*)(QK + (size_t)(tok0 + i) * 2048 + c0) = v;
    }
    if (c0 >= 1024) {
        const int b = tok0 >> 12;
#pragma unroll
        for (int j = 0; j < 8; ++j) {
            u32x4 v = {pack2(o[0][j], o[1][j]), pack2(o[2][j], o[3][j]), pack2(o[4][j], o[5][j]), pack2(o[6][j], o[7][j])};
            *(u32x4*)(KT + (size_t)(b * 1024 + (c0 - 1024) + j) * 4096 + pos0) = v;
        }
    }
}

__device__ __forceinline__ void gmlp_item(const Params& P, LAS unsigned char* lds, int item2) {
    const int item = item2 >> 1, g0 = (item2 & 1) * 4;
    const int tid = otid(), wave = tid >> 6, lane = tid & 63, fr = lane & 15, fq = lane >> 4;
    LAS bf16_t* VT = (LAS bf16_t*)lds;
    LAS float* rstd = (LAS float*)(lds + 34816);
    const bf16_t* BIG = (const bf16_t*)(P.ws + OFF_BIG); bf16_t* ABUF = (bf16_t*)(P.ws + OFF_ABUF);
    const float* gn = P.in[8]; const float* wsp = P.in[9]; const float* bsp = P.in[10];
    const int T0 = item * 128;
    for (int r = 0; r < 16; ++r) {
        const int row = wave * 16 + r;
        const bf16_t* p = BIG + (size_t)(T0 + row) * 6144 + 1024 + 16 * lane;
        const bf16x8 a = ld8(p), b = ld8(p + 8);
        float ss = 0.f;
#pragma unroll
        for (int j = 0; j < 8; ++j) { const float x = bfs(a[j]), y = bfs(b[j]); ss += x * x + y * y; }
        ss = wave_sum(ss);
        if (lane == 0) rstd[row] = rsqrtf(ss * (1.0f / 1024.0f) + EPSN);
    }
    __syncthreads();
    for (int g = g0; g < g0 + 4; ++g) {
        {
            const int s = tid & 127, eg0 = tid >> 7; const float rs = rstd[s];
#pragma unroll
            for (int it = 0; it < 4; ++it) {
                const int eg = eg0 + 4 * it;
                const bf16x8 v = ld8(BIG + (size_t)(T0 + s) * 6144 + 1024 + g * 128 + 8 * eg);
                const float4 g0 = *(const float4*)(gn + g * 128 + 8 * eg), g1 = *(const float4*)(gn + g * 128 + 8 * eg + 4);
                const float gg[8] = {g0.x, g0.y, g0.z, g0.w, g1.x, g1.y, g1.z, g1.w};
#pragma unroll
                for (int jj = 0; jj < 8; ++jj) VT[(8 * eg + jj) * 136 + s] = (bf16_t)f2bf(bfs(v[jj]) * rs * gg[jj]);
            }
        }
        __syncthreads();
        f32x4 acc[8];
#pragma unroll
        for (int e = 0; e < 8; ++e) acc[e] = (f32x4){0.f, 0.f, 0.f, 0.f};
        const int t = wave * 16 + fr;
        for (int ks = 0; ks < 4; ++ks) {
            if (32 * ks <= wave * 16 + 15) {
                const float* wp = wsp + ((size_t)(g * 128 + t)) * 128 + 32 * ks + 8 * fq;
                const float4 w0 = *(const float4*)wp, w1 = *(const float4*)(wp + 4);
                const int s0 = 32 * ks + 8 * fq;
                const bf16x8 Y = mk8(s0 + 0 <= t ? w0.x : 0.f, s0 + 1 <= t ? w0.y : 0.f, s0 + 2 <= t ? w0.z : 0.f, s0 + 3 <= t ? w0.w : 0.f,
                                     s0 + 4 <= t ? w1.x : 0.f, s0 + 5 <= t ? w1.y : 0.f, s0 + 6 <= t ? w1.z : 0.f, s0 + 7 <= t ? w1.w : 0.f);
#pragma unroll
                for (int e = 0; e < 8; ++e) { const bf16x8 X = lds8(VT + (16 * e + fr) * 136 + 32 * ks + 8 * fq); acc[e] = mfma16(X, Y, acc[e]); }
            }
        }
        const float bsv = bsp[g * 128 + t]; const size_t tok = (size_t)(T0 + t);
        u32x2 uall[8];
#pragma unroll
        for (int e = 0; e < 8; ++e) uall[e] = *(const u32x2*)(BIG + tok * 6144 + g * 128 + 16 * e + 4 * fq);
#pragma unroll
        for (int e = 0; e < 8; ++e) {
            const int e0 = 16 * e + 4 * fq;
            const u32x2 uu = uall[e];
            u32x2 o = {pack2(bflo(uu.x) * (acc[e][0] + bsv), bfhi(uu.x) * (acc[e][1] + bsv)), pack2(bflo(uu.y) * (acc[e][2] + bsv), bfhi(uu.y) * (acc[e][3] + bsv))};
            *(u32x2*)(ABUF + tok * 2048 + g * 128 + e0) = o;
        }
        __syncthreads();
    }
}

__device__ __forceinline__ void phase_conv_gmlp(const Params& P, LAS unsigned char* lds) {
    for (int it = blockIdx.x; it < 256; it += gridDim.x) gmlp_item(P, lds, it);
    const int wave = otid() >> 6, lane = otid() & 63;
    for (int it = blockIdx.x * 8 + wave; it < 8192; it += gridDim.x * 8) conv_wave_item(P, it, lane);
}

constexpr int ML_KS = 0, ML_PS = 67584, ML_VT = 102400, ML_VTW = 106752, ML_CB = 111104, ML_N = 119552, ML_A = 120576, ML_MT = 121088, ML_B = 121600, ML_WS = 122112;
constexpr int ML_CB2 = 122624, ML_N2 = 131072, ML_SC2 = 132096 - ML_A;
__device__ __forceinline__ void mlstm_scalars(LAS float* sa, LAS float* sMt, LAS float* sb, float f0, float f1, float i0, float i1, float m, int lane) {
    const float l0 = (f0 >= 0.f) ? -log1pf(__expf(-f0)) : (f0 - log1pf(__expf(f0)));
    const float l1 = (f1 >= 0.f) ? -log1pf(__expf(-f1)) : (f1 - log1pf(__expf(f1)));
    float v = l0 + l1;
#pragma unroll
    for (int o = 1; o < 64; o <<= 1) { const float y = __shfl_up(v, o); if (lane >= o) v += y; }
    const float excl = v - (l0 + l1);
    const float b0 = excl + l0, b1 = excl + l0 + l1;
    const float a0 = i0 - b0, a1 = i1 - b1;
    float q = fmaxf(a0, a1);
#pragma unroll
    for (int o = 1; o < 64; o <<= 1) { const float y = __shfl_up(q, o); if (lane >= o) q = fmaxf(q, y); }
    float qe = __shfl_up(q, 1); if (lane == 0) qe = -3.0e38f;
    const float pm0 = fmaxf(qe, a0), pm1 = fmaxf(pm0, a1);
    sa[2 * lane] = a0; sa[2 * lane + 1] = a1; sb[2 * lane] = b0; sb[2 * lane + 1] = b1;
    sMt[2 * lane] = fmaxf(pm0, m); sMt[2 * lane + 1] = fmaxf(pm1, m);
}
__device__ __forceinline__ void mlstm_item(const Params& P, LAS unsigned char* lds, int item) {
    const int tid = otid(), wave = tid >> 6, lane = tid & 63, fr = lane & 15, fq = lane >> 4;
    LAS bf16_t* Ks = (LAS bf16_t*)(lds + ML_KS);
    LAS bf16_t* Ps = (LAS bf16_t*)(lds + ML_PS);
    LAS bf16_t* VT = (LAS bf16_t*)(lds + ML_VT);
    LAS bf16_t* VTW = (LAS bf16_t*)(lds + ML_VTW);
    const bf16_t* BIG = (const bf16_t*)(P.ws + OFF_BIG); const bf16_t* QK = (const bf16_t*)(P.ws + OFF_AUX1);
    const float* G0 = (const float*)(P.ws + OFF_GATES); float* HT = (float*)(P.ws + OFF_AUX2);
    const int bh_ = ((item & 7) << 1) + ((item >> 7) & 1), es = (item >> 3) & 15, h = bh_ & 3, b = bh_ >> 2;
    { LAS bf16_t* Cb0 = (LAS bf16_t*)(lds + ML_CB); LAS float* n0 = (LAS float*)(lds + ML_N);
      for (int i = tid; i < 16 * 264; i += 512) Cb0[i] = 0;
      if (tid < 256) n0[tid] = 0.f; }
    f32x4 Cacc[2] = {(f32x4){0.f, 0.f, 0.f, 0.f}, (f32x4){0.f, 0.f, 0.f, 0.f}}, Nacc[2] = {(f32x4){0.f, 0.f, 0.f, 0.f}, (f32x4){0.f, 0.f, 0.f, 0.f}};
    float m = 0.f;
    bf16x8 gk[8], gq[8], gv = (bf16x8){0, 0, 0, 0, 0, 0, 0, 0};
    float pf0 = 0.f, pf1 = 0.f, pi0 = 0.f, pi1 = 0.f;
#define ML_FETCH(TB) do { const int tb_ = (TB); \
        _Pragma("unroll") for (int i = 0; i < 8; ++i) { const int idx = tid + 512 * i; gk[i] = ld8(QK + (size_t)(tb_ + (idx >> 5)) * 2048 + 1024 + h * 256 + 8 * (idx & 31)); } \
        _Pragma("unroll") for (int ks = 0; ks < 8; ++ks) gq[ks] = ld8(QK + (size_t)(tb_ + 16 * wave + fr) * 2048 + h * 256 + 32 * ks + 8 * fq); \
        if (tid < 256) gv = ld8(BIG + (size_t)(tb_ + (tid & 127)) * 6144 + 4096 + h * 256 + es * 16 + 8 * (tid >> 7)); \
        if (wave == 0) { pf0 = G0[(size_t)(tb_ + 2 * lane) * 8 + 4 + h]; pf1 = G0[(size_t)(tb_ + 2 * lane + 1) * 8 + 4 + h]; pi0 = G0[(size_t)(tb_ + 2 * lane) * 8 + h]; pi1 = G0[(size_t)(tb_ + 2 * lane + 1) * 8 + h]; } } while (0)
    ML_FETCH(b * 4096);
    if (wave == 0) mlstm_scalars((LAS float*)(lds + ML_A), (LAS float*)(lds + ML_MT), (LAS float*)(lds + ML_B), pf0, pf1, pi0, pi1, m, lane);
    __syncthreads();
    for (int c = 0; c < 32; ++c) {
        const int T0 = b * 4096 + c * 128, par = c & 1;
        LAS float* sa = (LAS float*)(lds + ML_A + par * ML_SC2); LAS float* sMt = (LAS float*)(lds + ML_MT + par * ML_SC2);
        LAS float* sb = (LAS float*)(lds + ML_B + par * ML_SC2); LAS float* sws = (LAS float*)(lds + ML_WS + par * ML_SC2);
        LAS bf16_t* Cb = (LAS bf16_t*)(lds + (par ? ML_CB2 : ML_CB)); LAS bf16_t* CbN = (LAS bf16_t*)(lds + (par ? ML_CB : ML_CB2));
        LAS float* nvec = (LAS float*)(lds + (par ? ML_N2 : ML_N)); LAS float* nvecN = (LAS float*)(lds + (par ? ML_N : ML_N2));
        const float MtL = sMt[127];
        if (tid < 128) sws[tid] = __expf(sa[tid] - MtL);
#pragma unroll
        for (int i = 0; i < 8; ++i) {
            const int idx = tid + 512 * i, s = idx >> 5, dp = idx & 31;
            *(LAS bf16x8*)(Ks + s * 264 + 8 * dp) = gk[i];
        }
        if (tid < 256) {
            const int s = tid & 127, hf = tid >> 7;
            const bf16x8 v = gv;
            const float w = __expf(sa[s] - MtL);
            const int sp = (s & ~31) + 8 * ((s >> 2) & 3) + 4 * ((s >> 4) & 1) + (s & 3);
#pragma unroll
            for (int jj = 0; jj < 8; ++jj) { VT[(8 * hf + jj) * 136 + sp] = (bf16_t)v[jj]; VTW[(8 * hf + jj) * 136 + s] = (bf16_t)f2bf(bfs(v[jj]) * w); }
        }
        bf16x8 qf[8];
#pragma unroll
        for (int ks = 0; ks < 8; ++ks) qf[ks] = gq[ks];
        if (c < 31) ML_FETCH(T0 + 128);
        __syncthreads();
        const int t = 16 * wave + fr;
        const float Mt_t = sMt[t];
        float rsum = 0.f;
        f32x4 a1 = (f32x4){0.f, 0.f, 0.f, 0.f};
        for (int kk = 0; kk <= (wave >> 1); ++kk) {
            f32x4 acc0 = (f32x4){0.f, 0.f, 0.f, 0.f}, acc1 = (f32x4){0.f, 0.f, 0.f, 0.f};
#pragma unroll
            for (int ks = 0; ks < 8; ++ks) {
                const bf16x8 X0 = lds8(Ks + (32 * kk + fr) * 264 + 32 * ks + 8 * fq), X1 = lds8(Ks + (32 * kk + 16 + fr) * 264 + 32 * ks + 8 * fq);
                acc0 = mfma16(X0, qf[ks], acc0); acc1 = mfma16(X1, qf[ks], acc1);
            }
            float pv[2][4];
#pragma unroll
            for (int hh = 0; hh < 2; ++hh) {
                const f32x4 acc = hh ? acc1 : acc0;
                const int s0 = 32 * kk + 16 * hh + 4 * fq;
                const f32x4 av = *(const LAS f32x4*)(sa + s0);
#pragma unroll
                for (int j = 0; j < 4; ++j) { const float d = (s0 + j <= t) ? __expf(av[j] - Mt_t) : 0.f; pv[hh][j] = acc[j] * d; rsum += pv[hh][j]; }
            }
            const bf16x8 Y = mk8(pv[0][0], pv[0][1], pv[0][2], pv[0][3], pv[1][0], pv[1][1], pv[1][2], pv[1][3]);
            a1 = mfma16(lds8(VT + fr * 136 + 32 * kk + 8 * fq), Y, a1);
        }
        rsum = xsum4(rsum);
        {
            f32x4 a2 = (f32x4){0.f, 0.f, 0.f, 0.f};
            float qn = 0.f;
#pragma unroll
            for (int ks = 0; ks < 8; ++ks) {
                const bf16x8 X = lds8(Cb + fr * 264 + 32 * ks + 8 * fq);
                a2 = mfma16(X, qf[ks], a2);
                const f32x4 n0 = *(const LAS f32x4*)(nvec + 32 * ks + 8 * fq), n1 = *(const LAS f32x4*)(nvec + 32 * ks + 8 * fq + 4);
#pragma unroll
                for (int jj = 0; jj < 4; ++jj) qn += bfs(qf[ks][jj]) * n0[jj] + bfs(qf[ks][4 + jj]) * n1[jj];
            }
            qn = xsum4(qn);
            const float wi = __expf(m - Mt_t);
            const float den = rsum + wi * qn;
            const float dn = fmaxf(fabsf(den), __expf(-(sb[t] + Mt_t)));
            const float inv = 1.0f / dn;
            f32x4 o; for (int j = 0; j < 4; ++j) o[j] = (a1[j] + wi * a2[j]) * inv;
            *(f32x4*)(HT + (size_t)(T0 + t) * 1024 + h * 256 + es * 16 + 4 * fq) = o;
        }
        {
            const float wprev = __expf(m - MtL);
            Cacc[0] *= wprev; Cacc[1] *= wprev; Nacc[0] *= wprev; Nacc[1] *= wprev;
#pragma unroll
            for (int kk = 0; kk < 4; ++kk) {
                const bf16x8 X = lds8(VTW + fr * 136 + 32 * kk + 8 * fq);
                const f32x4 w0 = *(const LAS f32x4*)(sws + 32 * kk + 8 * fq), w1 = *(const LAS f32x4*)(sws + 32 * kk + 8 * fq + 4);
                const bf16x8 XWf = mk8(w0[0], w0[1], w0[2], w0[3], w1[0], w1[1], w1[2], w1[3]);
                const bf16x8 XW = (fr == 0) ? XWf : (bf16x8){0, 0, 0, 0, 0, 0, 0, 0};
#pragma unroll
                for (int dt = 0; dt < 2; ++dt) {
                    const int dcol = 16 * (2 * wave + dt) + fr;
                    const LAS bf16_t* yp = Ks + (32 * kk + 8 * fq + (fr >> 2)) * 264 + 16 * (2 * wave + dt) + 4 * (fr & 3);
                    const s16x4 ylo = lds_tr4(yp), yhi = lds_tr4(yp + 4 * 264);
                    const bf16x8 Y = {ylo[0], ylo[1], ylo[2], ylo[3], yhi[0], yhi[1], yhi[2], yhi[3]};
                    Cacc[dt] = mfma16(X, Y, Cacc[dt]);
                    Nacc[dt] = mfma16(XW, Y, Nacc[dt]);
                }
            }
#pragma unroll
            for (int dt = 0; dt < 2; ++dt) {
                const int dcol = 16 * (2 * wave + dt) + fr;
#pragma unroll
                for (int j = 0; j < 4; ++j) CbN[(4 * fq + j) * 264 + dcol] = (bf16_t)f2bf(Cacc[dt][j]);
                if (fq == 0) nvecN[dcol] = Nacc[dt][0];
            }
            m = sb[127] + MtL;
        }
        if (wave == 0 && c < 31)
            mlstm_scalars((LAS float*)(lds + ML_A + (par ^ 1) * ML_SC2), (LAS float*)(lds + ML_MT + (par ^ 1) * ML_SC2), (LAS float*)(lds + ML_B + (par ^ 1) * ML_SC2), pf0, pf1, pi0, pi1, m, lane);
        __syncthreads();
    }
#undef ML_FETCH
}
__device__ __forceinline__ void phase_mlstm(const Params& P, LAS unsigned char* lds) {
    for (int it = blockIdx.x; it < 256; it += gridDim.x) { mlstm_item(P, lds, it); __syncthreads(); }
}

__device__ __forceinline__ void phase_htnorm(const Params& P) {
    const int wave = otid() >> 6, lane = otid() & 63;
    const float* HT = (const float*)(P.ws + OFF_AUX2); const bf16_t* BIG = (const bf16_t*)(P.ws + OFF_BIG); bf16_t* ABUF = (bf16_t*)(P.ws + OFF_ABUF);
    const float* mn = P.in[12];
    for (int row = blockIdx.x * 8 + wave; row < MTOK; row += gridDim.x * 8) {
        float4 vv[4], gg[4]; u32x2 ov[4];
#pragma unroll
        for (int h = 0; h < 4; ++h) { gg[h] = *(const float4*)(mn + h * 256 + 4 * lane); vv[h] = *(const float4*)(HT + (size_t)row * 1024 + h * 256 + 4 * lane); ov[h] = *(const u32x2*)(BIG + (size_t)row * 6144 + 5120 + h * 256 + 4 * lane); }
#pragma unroll
        for (int h = 0; h < 4; ++h) {
            const float4 v = vv[h];
            float ss = v.x * v.x + v.y * v.y + v.z * v.z + v.w * v.w;
            ss = wave_sum(ss);
            const float r = rsqrtf(ss * (1.0f / 256.0f) + EPSN);
            const float4 g = gg[h];
            const u32x2 oo = ov[h];
            u32x2 o = {pack2(sigm(bflo(oo.x)) * v.x * r * g.x, sigm(bfhi(oo.x)) * v.y * r * g.y), pack2(sigm(bflo(oo.y)) * v.z * r * g.z, sigm(bfhi(oo.y)) * v.w * r * g.w)};
            *(u32x2*)(ABUF + (size_t)row * 2048 + 1024 + h * 256 + 4 * lane) = o;
        }
    }
}


__device__ __forceinline__ int kv_col(int br, int kv, int g) { return 2048 + ((br * 2 + kv) * 4 + g) * 128; }

__device__ __forceinline__ void vt_wave_item(const Params& P, int item, int lane) {
    const bf16_t* BIG = (const bf16_t*)(P.ws + OFF_BIG); bf16_t* VTG = (bf16_t*)(P.ws + OFF_KT);
    const int tgp = item >> 4, cgp = item & 15;
    const int brm = cgp >> 3, g = (cgp >> 1) & 3, half = cgp & 1;
    const int tg = lane & 7, cg = lane >> 3;
    const int tok0 = tgp * 64 + 8 * tg, b = tok0 >> 12, pos0 = tok0 & 4095;
    const int col = kv_col(brm + 1, 1, g) + half * 64 + 8 * cg;
    bf16x8 x[8];
#pragma unroll
    for (int i = 0; i < 8; ++i) x[i] = ld8(BIG + (size_t)(tok0 + i) * 5120 + col);
    const size_t rb = (size_t)(((b * 2 + brm) * 4 + g) * 128 + half * 64 + 8 * cg);
#pragma unroll
    for (int j = 0; j < 8; ++j) {
        bf16x8 v; for (int i = 0; i < 8; ++i) v[i] = x[i][j];
        *(bf16x8*)(VTG + (rb + j) * 4096 + pos0) = v;
    }
}

__device__ __forceinline__ void cmp_item(const Params& P, LAS unsigned char* lds, int item) {
    const int tid = otid(), wave = tid >> 6, lane = tid & 63, fr = lane & 15, fq = lane >> 4;
    LAS float* pos = (LAS float*)lds;
    LAS bf16_t* H = (LAS bf16_t*)(lds + 16384);
    const bf16_t* BIG = (const bf16_t*)(P.ws + OFF_BIG);
    const int rt = item & 15, g = (item >> 4) & 3, b = (item >> 6) & 3, kv = item >> 8;
    const bf16_t* W1 = (const bf16_t*)(P.ws + OFF_WC1) + (size_t)kv * 128 * 4096;
    const bf16_t* W2 = (const bf16_t*)(P.ws + OFF_WC2) + (size_t)kv * 128 * 128;
    const float* pe = P.in[15] + (size_t)kv * 4096;
    for (int i = tid; i < 1024; i += 512) *(LAS f32x4*)(pos + 4 * i) = *(const f32x4*)(pe + 4 * i);
    __syncthreads();
    int cr = rt * 16 + fr; if (cr > 254) cr = 254;
    const bf16_t* ap = BIG + (size_t)(b * 4096 + 16 * cr) * 5120 + kv_col(0, kv, g) + 8 * fq;
    const bf16_t* wp = W1 + (size_t)(16 * wave + fr) * 4096 + 8 * fq;
    f32x4 acc = (f32x4){0.f, 0.f, 0.f, 0.f};
#pragma unroll 8
    for (int ks = 0; ks < 128; ++ks) {
        const int l = ks >> 2, d0 = (ks & 3) * 32;
        const bf16x8 xv = ld8(ap + (size_t)l * 5120 + d0);
        const f32x4 p0 = *(const LAS f32x4*)(pos + l * 128 + d0 + 8 * fq), p1 = *(const LAS f32x4*)(pos + l * 128 + d0 + 8 * fq + 4);
        const bf16x8 Y = mk8(bfs(xv[0]) + p0[0], bfs(xv[1]) + p0[1], bfs(xv[2]) + p0[2], bfs(xv[3]) + p0[3], bfs(xv[4]) + p1[0], bfs(xv[5]) + p1[1], bfs(xv[6]) + p1[2], bfs(xv[7]) + p1[3]);
        const bf16x8 X = ld8(wp + 32 * ks);
        acc = mfma16(X, Y, acc);
    }
    { u32x2 o = {pack2(gelu_t(acc[0]), gelu_t(acc[1])), pack2(gelu_t(acc[2]), gelu_t(acc[3]))}; *(LAS u32x2*)(H + fr * 136 + 16 * wave + 4 * fq) = o; }
    __syncthreads();
    f32x4 a2 = (f32x4){0.f, 0.f, 0.f, 0.f};
    if (kv == 0) {
#pragma unroll
        for (int ks = 0; ks < 4; ++ks) { const bf16x8 X = ld8(W2 + (size_t)(16 * wave + fr) * 128 + 32 * ks + 8 * fq), Y = lds8(H + fr * 136 + 32 * ks + 8 * fq); a2 = mfma16(X, Y, a2); }
        bf16_t* KC = (bf16_t*)(P.ws + OFF_KCMP);
        u32x2 o = {pack2(a2[0], a2[1]), pack2(a2[2], a2[3])};
        *(u32x2*)(KC + (size_t)((b * 4 + g) * 256 + rt * 16 + fr) * 128 + 16 * wave + 4 * fq) = o;
    } else {
#pragma unroll
        for (int ks = 0; ks < 4; ++ks) { const bf16x8 Y = ld8(W2 + (size_t)(16 * wave + fr) * 128 + 32 * ks + 8 * fq), X = lds8(H + fr * 136 + 32 * ks + 8 * fq); a2 = mfma16(X, Y, a2); }
        bf16_t* VC = (bf16_t*)(P.ws + OFF_VCMPT);
        u32x2 o = {pack2(a2[0], a2[1]), pack2(a2[2], a2[3])};
        *(u32x2*)(VC + (size_t)((b * 4 + g) * 128 + 16 * wave + fr) * 256 + rt * 16 + 4 * fq) = o;
    }
    __syncthreads();
}
__device__ __forceinline__ void phase_compress(const Params& P, LAS unsigned char* lds) {
    for (int it = blockIdx.x; it < 512; it += gridDim.x) cmp_item(P, lds, it);
    const int wave = otid() >> 6, lane = otid() & 63;
    for (int it = blockIdx.x * 8 + wave; it < 4096; it += gridDim.x * 8) vt_wave_item(P, it, lane);
}

constexpr int AT_KB = 0, AT_VT = 17408, AT_PS = 35840, AT_IMP = 72704, AT_SEL = 138240;
struct KVRegs { bf16x8 k[2], v[2]; };
__device__ __forceinline__ void at_fetch(KVRegs& R, const bf16_t* ksrc, size_t kpitch, const bf16_t* vsrc, size_t vpitch, int tid, bool wantv) {
#pragma unroll
    for (int i = 0; i < 2; ++i) {
        const int p = tid + 512 * i;
        R.k[i] = ld8(ksrc + (size_t)(p >> 4) * kpitch + 8 * (p & 15));
        if (wantv) R.v[i] = ld8(vsrc + (size_t)(p >> 3) * vpitch + 8 * (p & 7));
    }
}
__device__ __forceinline__ void at_stage(LAS unsigned char* lds, const KVRegs& R, int tid, bool wantv, int bofs = 0) {
    LAS bf16_t* Kb = (LAS bf16_t*)(lds + bofs + AT_KB); LAS bf16_t* Vb = (LAS bf16_t*)(lds + bofs + AT_VT);
#pragma unroll
    for (int i = 0; i < 2; ++i) {
        const int p = tid + 512 * i;
        *(LAS bf16x8*)(Kb + (p >> 4) * 136 + 8 * (p & 15)) = R.k[i];
        if (wantv) {
            const int c8 = p & 7, cc = c8 & 3, base = (p >> 3) * 72 + 32 * (c8 >> 2) + 16 * (cc & 1) + 4 * (cc >> 1);
            const u32x4 vv = __builtin_bit_cast(u32x4, R.v[i]);
            *(LAS u32x2*)(Vb + base) = (u32x2){vv[0], vv[1]};
            *(LAS u32x2*)(Vb + base + 8) = (u32x2){vv[2], vv[3]};
        }
    }
}
__device__ __forceinline__ void at_scores2(LAS unsigned char* lds, const bf16x8 (&qf)[2][4], f32x4 (&sc)[2][4], int fr, int fq, int bofs = 0) {
    const LAS bf16_t* Kb = (const LAS bf16_t*)(lds + bofs + AT_KB);
#pragma unroll
    for (int kt = 0; kt < 4; ++kt) {
        f32x4 a0 = (f32x4){0.f, 0.f, 0.f, 0.f}, a1 = (f32x4){0.f, 0.f, 0.f, 0.f};
#pragma unroll
        for (int ks = 0; ks < 4; ++ks) { const bf16x8 X = lds8(Kb + (16 * kt + fr) * 136 + 32 * ks + 8 * fq); a0 = mfma16(X, qf[0][ks], a0); a1 = mfma16(X, qf[1][ks], a1); }
        sc[0][kt] = a0; sc[1][kt] = a1;
    }
}
__device__ __forceinline__ void at_pv2(LAS unsigned char* lds, const f32x4 (&p)[2][4], f32x4 (&o)[2][8], int wave, int fr, int fq, int bofs = 0) {
    const LAS bf16_t* Vb = (const LAS bf16_t*)(lds + bofs + AT_VT);
#pragma unroll
    for (int kk = 0; kk < 2; ++kk) {
        const bf16x8 Y0 = mk8(p[0][2 * kk][0], p[0][2 * kk][1], p[0][2 * kk][2], p[0][2 * kk][3], p[0][2 * kk + 1][0], p[0][2 * kk + 1][1], p[0][2 * kk + 1][2], p[0][2 * kk + 1][3]);
        const bf16x8 Y1 = mk8(p[1][2 * kk][0], p[1][2 * kk][1], p[1][2 * kk][2], p[1][2 * kk][3], p[1][2 * kk + 1][0], p[1][2 * kk + 1][1], p[1][2 * kk + 1][2], p[1][2 * kk + 1][3]);
#pragma unroll
        for (int dt = 0; dt < 8; ++dt) { const bf16x8 X = lds8(Vb + (16 * dt + fr) * 72 + 32 * kk + 8 * fq); o[0][dt] = mfma16(X, Y0, o[0][dt]); o[1][dt] = mfma16(X, Y1, o[1][dt]); }
    }
}
__device__ __forceinline__ void at_online2(LAS unsigned char* lds, const bf16x8 (&qf)[2][4], float (&mrun)[2], float (&lrun)[2], f32x4 (&o)[2][8], const int (&lo)[2], const int (&hi)[2], const bool (&rowok)[2], bool fullvis, int wave, int fr, int fq, int bofs) {
    f32x4 sc[2][4];
    at_scores2(lds, qf, sc, fr, fq, bofs);
    float bm[2];
#pragma unroll
    for (int rt = 0; rt < 2; ++rt) {
        if (!fullvis) {
            const bool mok = hi[rt] >= lo[rt];
            const int moff = mok ? -lo[rt] : -100000; const unsigned mspan = mok ? (unsigned)(hi[rt] - lo[rt]) : 0u;
#pragma unroll
            for (int kt = 0; kt < 4; ++kt)
#pragma unroll
                for (int j = 0; j < 4; ++j) sc[rt][kt][j] = ((unsigned)(16 * kt + j + moff) <= mspan) ? sc[rt][kt][j] : -3.0e38f;
        }
        float b = -3.0e38f;
#pragma unroll
        for (int kt = 0; kt < 4; ++kt)
#pragma unroll
            for (int j = 0; j < 4; ++j) b = fmaxf(b, sc[rt][kt][j]);
        bm[rt] = b;
    }
    if (__any((bm[0] > mrun[0] + 6.0f) || (bm[1] > mrun[1] + 6.0f))) {
#pragma unroll
        for (int rt = 0; rt < 2; ++rt) {
            const float mnew = fmaxf(mrun[rt], xmax4(bm[rt])), mns = (mnew < -1.0e37f) ? 0.f : mnew;
            const float alpha = __builtin_amdgcn_exp2f(mrun[rt] - mns);
            lrun[rt] *= alpha; mrun[rt] = mnew;
#pragma unroll
            for (int dt = 0; dt < 8; ++dt) o[rt][dt] *= alpha;
        }
    }
#pragma unroll
    for (int rt = 0; rt < 2; ++rt) {
        const float mns = (mrun[rt] < -1.0e37f) ? 0.f : mrun[rt];
        const float mex = (fullvis && !rowok[rt]) ? 3.0e38f : mns;
        float ps = 0.f;
#pragma unroll
        for (int kt = 0; kt < 4; ++kt)
#pragma unroll
            for (int j = 0; j < 4; ++j) { const float e = __builtin_amdgcn_exp2f(sc[rt][kt][j] - mex); sc[rt][kt][j] = e; ps += e; }
        lrun[rt] += ps;
    }
    at_pv2(lds, sc, o, wave, fr, fq, bofs);
}

template <bool FIRST>
__device__ __forceinline__ void y_accum(bf16_t* yp0, bf16_t* yp1, const f32x4 (&o)[2][8], float s0, float s1) {
    u32x2 p[2][8];
    if (!FIRST) {
#pragma unroll
        for (int dt = 0; dt < 8; ++dt) { p[0][dt] = *(const u32x2*)(yp0 + 16 * dt); p[1][dt] = *(const u32x2*)(yp1 + 16 * dt); }
    }
#pragma unroll
    for (int rt = 0; rt < 2; ++rt) {
        bf16_t* yp = rt ? yp1 : yp0; const float scale = rt ? s1 : s0;
#pragma unroll
        for (int dt = 0; dt < 8; ++dt) {
            float a0 = o[rt][dt][0] * scale, a1 = o[rt][dt][1] * scale, a2 = o[rt][dt][2] * scale, a3 = o[rt][dt][3] * scale;
            if (!FIRST) { a0 += bflo(p[rt][dt].x); a1 += bfhi(p[rt][dt].x); a2 += bflo(p[rt][dt].y); a3 += bfhi(p[rt][dt].y); }
            u32x2 v = {pack2(a0, a1), pack2(a2, a3)};
            *(u32x2*)(yp + 16 * dt) = v;
        }
    }
}

__device__ __forceinline__ void attn_item(const Params& P, LAS unsigned char* lds, int item) {
    const int tid = otid(), wave = tid >> 6, lane = tid & 63, fr = lane & 15, fq = lane >> 4;
    const bf16_t* BIG = (const bf16_t*)(P.ws + OFF_BIG); const bf16_t* VTG = (const bf16_t*)(P.ws + OFF_KT);
    const bf16_t* KC = (const bf16_t*)(P.ws + OFF_KCMP); const bf16_t* VC = (const bf16_t*)(P.ws + OFF_VCMPT);
    const float* GT = (const float*)(P.ws + OFF_GATES); bf16_t* Y = (bf16_t*)(P.ws + OFF_ABUF);
    LAS float* impW = (LAS float*)(lds + AT_IMP);
    LAS unsigned* selw = (LAS unsigned*)(lds + AT_SEL);
    const int kk_ = item >> 8, blk_ = item & 255, j_ = blk_ >> 3;
    const int qt = (kk_ & 1) ? 63 - j_ : j_, pair_ = ((blk_ & 7) << 1) + (kk_ >> 1), g = pair_ & 3, b = pair_ >> 2;
    const int t0 = qt * 64, tokb = b * 4096;
    const int head = g * 4 + (wave >> 1), qoff = 32 * (wave & 1);
    const int cur = qt;
    int pos[2]; pos[0] = t0 + qoff + fr; pos[1] = pos[0] + 16;
    bf16x8 qf[2][4];
#pragma unroll
    for (int rt = 0; rt < 2; ++rt)
#pragma unroll
        for (int ks = 0; ks < 4; ++ks) qf[rt][ks] = ld8(BIG + (size_t)(tokb + pos[rt]) * 5120 + head * 128 + 32 * ks + 8 * fq);
    KVRegs R;
    const bf16_t* kc0 = KC + (size_t)((b * 4 + g) * 256) * 128;
    const bf16_t* vc0 = VC + (size_t)((b * 4 + g) * 128) * 256;
    {
        int cmaxq[2]; cmaxq[0] = (pos[0] - 31) >> 4; cmaxq[1] = (pos[1] - 31) >> 4;
        float mx[2] = {-3.0e38f, -3.0e38f}, sum[2] = {0.f, 0.f};
        const int nblk = min(4, ((4 * qt + 2) >> 6) + 1);
        at_fetch(R, kc0, 128, vc0, 256, tid, false);
#pragma unroll 1
        for (int blk = 0; blk < nblk; ++blk) {
            __syncthreads();
            at_stage(lds, R, tid, false);
            __syncthreads();
            if (blk + 1 < nblk) at_fetch(R, kc0 + (size_t)(blk + 1) * 64 * 128, 128, vc0, 256, tid, false);
            else at_fetch(R, kc0, 128, vc0, 256, tid, true);
            f32x4 s4[2][4]; at_scores2(lds, qf, s4, fr, fq);
#pragma unroll
            for (int rt = 0; rt < 2; ++rt) {
                const int lim = cmaxq[rt] - 64 * blk - 4 * fq;
                float bm = -3.0e38f;
#pragma unroll
                for (int kt = 0; kt < 4; ++kt)
#pragma unroll
                    for (int j = 0; j < 4; ++j) { const float s = (16 * kt + j <= lim) ? s4[rt][kt][j] : -3.0e38f; s4[rt][kt][j] = s; bm = fmaxf(bm, s); }
                bm = xmax4(bm);
                const float mnew = fmaxf(mx[rt], bm), mns = (mnew < -1.0e37f) ? 0.f : mnew;
                float ps = 0.f;
#pragma unroll
                for (int kt = 0; kt < 4; ++kt)
#pragma unroll
                    for (int j = 0; j < 4; ++j) ps += __builtin_amdgcn_exp2f(s4[rt][kt][j] - mns);
                sum[rt] = sum[rt] * __builtin_amdgcn_exp2f(mx[rt] - mns) + ps; mx[rt] = mnew;
            }
        }
        float inv[2], mxs[2];
#pragma unroll
        for (int rt = 0; rt < 2; ++rt) {
            const float s = xsum4(sum[rt]);
            inv[rt] = s > 0.f ? 1.0f / s : 0.f; mxs[rt] = (mx[rt] < -1.0e37f) ? 0.f : mx[rt];
        }
        f32x4 oc[2][8];
#pragma unroll
        for (int rt = 0; rt < 2; ++rt)
#pragma unroll
            for (int dt = 0; dt < 8; ++dt) oc[rt][dt] = (f32x4){0.f, 0.f, 0.f, 0.f};
        float eprev[2] = {0.f, 0.f};
        if (nblk < 4) {
            for (int r = 0; r < 32; ++r) { const int J = 16 * nblk + lane; if (J < 64) impW[(wave * 32 + r) * 64 + J] = 0.f; }
        }
#pragma unroll 1
        for (int blk = 0; blk < nblk; ++blk) {
            __syncthreads();
            at_stage(lds, R, tid, true);
            __syncthreads();
            if (blk + 1 < nblk) at_fetch(R, kc0 + (size_t)(blk + 1) * 64 * 128, 128, vc0 + (blk + 1) * 64, 256, tid, true);
            f32x4 s4[2][4]; at_scores2(lds, qf, s4, fr, fq);
#pragma unroll
            for (int rt = 0; rt < 2; ++rt) {
                const int lim = cmaxq[rt] - 64 * blk - 4 * fq;
#pragma unroll
                for (int kt = 0; kt < 4; ++kt) {
#pragma unroll
                    for (int j = 0; j < 4; ++j) s4[rt][kt][j] = (16 * kt + j <= lim) ? __builtin_amdgcn_exp2f(s4[rt][kt][j] - mxs[rt]) * inv[rt] : 0.f;
                    const float a = s4[rt][kt][0] + s4[rt][kt][1] + s4[rt][kt][2] + s4[rt][kt][3], e = 0.5f * s4[rt][kt][3];
                    const float src = (fq == 3) ? eprev[rt] : e;
                    const float got = __shfl(src, (lane + 48) & 63);
                    impW[(wave * 32 + 16 * rt + fr) * 64 + 16 * blk + 4 * kt + fq] = a - e + got;
                    eprev[rt] = e;
                }
            }
            at_pv2(lds, s4, oc, wave, fr, fq);
        }
        y_accum<true>(Y + (size_t)(tokb + pos[0]) * 2048 + head * 128 + 4 * fq, Y + (size_t)(tokb + pos[1]) * 2048 + head * 128 + 4 * fq, oc,
                      GT[(size_t)(tokb + pos[0]) * 48 + 0 * 16 + head], GT[(size_t)(tokb + pos[1]) * 48 + 0 * 16 + head]);
    }
    __syncthreads();
    {
#pragma unroll 1
        for (int i = 0; i < 8; ++i) {
            const int q = 8 * wave + i;
            float v = 0.f;
#pragma unroll
            for (int r = 0; r < 4; ++r) v += impW[((2 * r + (q >> 5)) * 32 + (q & 31)) * 64 + lane];
            const int J = lane;
            if (J == 0 || J == cur || J == cur - 1) v = 1.0e9f; else if (J > cur) v = -1.0e9f;
            int rank = 0;
            for (int o = 0; o < 64; ++o) { const float vo = __shfl(v, o); rank += (vo > v || (vo == v && o < J)) ? 1 : 0; }
            const unsigned long long mask = __ballot((rank < 16) && (J <= cur));
            if (lane == 0) { selw[2 * q] = (unsigned)mask; selw[2 * q + 1] = (unsigned)(mask >> 32); }
        }
    }
    __syncthreads();
    unsigned long long un = 0ull;
#pragma unroll 1
    for (int q = 0; q < 64; ++q) un |= ((unsigned long long)selw[2 * q + 1] << 32) | selw[2 * q];
    {
        unsigned long long mysel[2];
#pragma unroll
        for (int rt = 0; rt < 2; ++rt) mysel[rt] = ((unsigned long long)selw[2 * (qoff + 16 * rt + fr) + 1] << 32) | selw[2 * (qoff + 16 * rt + fr)];
        float mrun[2] = {-3.0e38f, -3.0e38f}, lrun[2] = {0.f, 0.f};
        f32x4 o[2][8];
#pragma unroll
        for (int rt = 0; rt < 2; ++rt)
#pragma unroll
            for (int dt = 0; dt < 8; ++dt) o[rt][dt] = (f32x4){0.f, 0.f, 0.f, 0.f};
        const bf16_t* kb = BIG + (size_t)tokb * 5120 + kv_col(1, 0, g);
        const bf16_t* vb = VTG + (size_t)(((b * 2 + 0) * 4 + g) * 128) * 4096;
        unsigned long long rem = un;
        int jb = __builtin_ctzll(rem); rem &= rem - 1;
        at_fetch(R, kb + (size_t)jb * 64 * 5120, 5120, vb + jb * 64, 4096, tid, true);
        __syncthreads();
        at_stage(lds, R, tid, true, 0);
        int jn = rem ? (int)__builtin_ctzll(rem) : -1;
        if (jn >= 0) at_fetch(R, kb + (size_t)jn * 64 * 5120, 5120, vb + jn * 64, 4096, tid, true);
        __syncthreads();
        int cb = 0;
#pragma unroll 1
        for (;;) {
            int jn2 = -1;
            if (jn >= 0) {
                at_stage(lds, R, tid, true, cb ? 0 : AT_IMP);
                rem &= rem - 1; jn2 = rem ? (int)__builtin_ctzll(rem) : -1;
                if (jn2 >= 0) at_fetch(R, kb + (size_t)jn2 * 64 * 5120, 5120, vb + jn2 * 64, 4096, tid, true);
            }
            int lo[2], hi[2]; bool rowok[2];
#pragma unroll
            for (int rt = 0; rt < 2; ++rt) { rowok[rt] = (mysel[rt] >> jb) & 1ull; lo[rt] = rowok[rt] ? 0 : 1000; hi[rt] = pos[rt] - 64 * jb - 4 * fq; }
            at_online2(lds, qf, mrun, lrun, o, lo, hi, rowok, jb < cur, wave, fr, fq, cb ? AT_IMP : 0);
            __syncthreads();
            if (jn < 0) break;
            jb = jn; jn = jn2; cb ^= 1;
        }
        {
            const float g0 = GT[(size_t)(tokb + pos[0]) * 48 + 1 * 16 + head], g1 = GT[(size_t)(tokb + pos[1]) * 48 + 1 * 16 + head];
            const float l0 = xsum4(lrun[0]), l1 = xsum4(lrun[1]);
            y_accum<false>(Y + (size_t)(tokb + pos[0]) * 2048 + head * 128 + 4 * fq, Y + (size_t)(tokb + pos[1]) * 2048 + head * 128 + 4 * fq, o,
                           l0 > 0.f ? g0 / l0 : 0.f, l1 > 0.f ? g1 / l1 : 0.f);
        }
    }
    {
        float mrun[2] = {-3.0e38f, -3.0e38f}, lrun[2] = {0.f, 0.f};
        f32x4 o[2][8];
#pragma unroll
        for (int rt = 0; rt < 2; ++rt)
#pragma unroll
            for (int dt = 0; dt < 8; ++dt) o[rt][dt] = (f32x4){0.f, 0.f, 0.f, 0.f};
        const bf16_t* kb = BIG + (size_t)tokb * 5120 + kv_col(2, 0, g);
        const bf16_t* vb = VTG + (size_t)(((b * 2 + 1) * 4 + g) * 128) * 4096;
        const int lo0 = t0 - 511, jlo = lo0 < 0 ? 0 : (lo0 >> 6);
        at_fetch(R, kb + (size_t)jlo * 64 * 5120, 5120, vb + jlo * 64, 4096, tid, true);
        at_stage(lds, R, tid, true, 0);
        if (jlo < cur) at_fetch(R, kb + (size_t)(jlo + 1) * 64 * 5120, 5120, vb + (jlo + 1) * 64, 4096, tid, true);
        __syncthreads();
        int cb = 0;
#pragma unroll 1
        for (int jb = jlo; jb <= cur; ++jb) {
            if (jb < cur) {
                at_stage(lds, R, tid, true, cb ? 0 : AT_IMP);
                if (jb + 1 < cur) at_fetch(R, kb + (size_t)(jb + 2) * 64 * 5120, 5120, vb + (jb + 2) * 64, 4096, tid, true);
            }
            int lo[2], hi[2]; bool rowok[2] = {true, true};
#pragma unroll
            for (int rt = 0; rt < 2; ++rt) { hi[rt] = pos[rt] - 64 * jb - 4 * fq; lo[rt] = hi[rt] - 511; }
            at_online2(lds, qf, mrun, lrun, o, lo, hi, rowok, (jb < cur) && (jb >= cur - 7), wave, fr, fq, cb ? AT_IMP : 0);
            __syncthreads();
            cb ^= 1;
        }
        {
            const float g0 = GT[(size_t)(tokb + pos[0]) * 48 + 2 * 16 + head], g1 = GT[(size_t)(tokb + pos[1]) * 48 + 2 * 16 + head];
            const float l0 = xsum4(lrun[0]), l1 = xsum4(lrun[1]);
            y_accum<false>(Y + (size_t)(tokb + pos[0]) * 2048 + head * 128 + 4 * fq, Y + (size_t)(tokb + pos[1]) * 2048 + head * 128 + 4 * fq, o,
                           l0 > 0.f ? g0 / l0 : 0.f, l1 > 0.f ? g1 / l1 : 0.f);
        }
    }
    __syncthreads();
}
__device__ __forceinline__ void phase_attn(const Params& P, LAS unsigned char* lds) {
    for (int it = blockIdx.x; it < 1024; it += gridDim.x) attn_item(P, lds, it);
}


#ifndef FBAR_SLEEP
#define FBAR_SLEEP 127
#endif
#ifndef FBAR_SLEEP2
#define FBAR_SLEEP2 0
#endif
constexpr int N_PHASES = 25;
constexpr int LDS_BYTES = 139264;

template <class Epi>
__device__ __forceinline__ void run_gemm(LAS unsigned char* lds, const bf16_t* A, const bf16_t* Bt, int N, int K, const Epi& E) {
    pg8::Gemm g{A, Bt, MTOK, N, K};
    pg8::StaticOrder S; S.init(MTOK, N, (int)gridDim.x, (int)blockIdx.x);
    pg8::gemm_phase<Epi, pg8::StaticOrder, false>((PG8_LAS unsigned char*)lds, g, S, E, nullptr);
}

__device__ __forceinline__ unsigned xbar_setup(unsigned char* ws) {
    const unsigned* slot = (const unsigned*)(ws + OFF_XB);
    const int lane = threadIdx.x & 63;
    const unsigned mine = __hip_atomic_load(slot + blockIdx.x, __ATOMIC_RELAXED, __HIP_MEMORY_SCOPE_AGENT) & 0xFu;
    unsigned nx = 0, seen = 0;
    for (unsigned i = lane; i < gridDim.x; i += 64) { const unsigned x = __hip_atomic_load(slot + i, __ATOMIC_RELAXED, __HIP_MEMORY_SCOPE_AGENT) & 0xFu; nx += (x == mine) ? 1u : 0u; seen |= 1u << x; }
#pragma unroll
    for (int o = 32; o; o >>= 1) { nx += __shfl_xor(nx, o); seen |= __shfl_xor(seen, o); }
    return mine | (nx << 4) | ((unsigned)__builtin_popcount(seen) << 16);
}
__device__ __forceinline__ void xbar_sync(unsigned char* ws, LAS unsigned char* lds, unsigned k) {
    __syncthreads();
    if (threadIdx.x == 0) {
        const unsigned info = *(const LAS unsigned*)(lds + 139008);
        unsigned* sub = (unsigned*)(ws + OFF_XB + 1024 + 256 * (info & 0xFu)); unsigned* top = (unsigned*)(ws + OFF_XB + 1024 + 256 * 16);
        const unsigned nx = (info >> 4) & 0xFFFu, nxcc = info >> 16;
        const unsigned old = __hip_atomic_fetch_add(sub, 1u, __ATOMIC_RELAXED, __HIP_MEMORY_SCOPE_AGENT);
        if (old + 1u == nx * k) {
            __builtin_amdgcn_fence(__ATOMIC_RELEASE, "agent");
            asm volatile("s_waitcnt vmcnt(0)" ::: "memory");
            __hip_atomic_fetch_add(top, 1u, __ATOMIC_RELAXED, __HIP_MEMORY_SCOPE_AGENT);
        }
        const unsigned want = nxcc * k;
        unsigned spins = 0;
        while (__hip_atomic_load(top, __ATOMIC_RELAXED, __HIP_MEMORY_SCOPE_AGENT) < want && ++spins < (1u << 21)) __builtin_amdgcn_s_sleep(FBAR_SLEEP);
        __builtin_amdgcn_fence(__ATOMIC_ACQUIRE, "agent");
        asm volatile("s_waitcnt vmcnt(0)" ::: "memory");
    }
    __syncthreads();
}

__device__ __forceinline__ int stage_rstd(LAS unsigned char* lds, const float* SS, int N) {
    pg8::StaticOrder S; S.init(MTOK, N, (int)gridDim.x, (int)blockIdx.x);
    Unit u0; if (!S.next(0, u0)) u0.pm = 0;
    LAS float* l = (LAS float*)(lds + 131072);
    const int tid = otid();
    if (tid < 256) l[tid] = rsqrtf(SS[u0.pm * 256 + tid] * (1.0f / 2048.0f) + EPSN);
    __syncthreads();
    return u0.pm;
}

__global__ void __launch_bounds__(512, 2) mega(Params P) {
    extern __shared__ __attribute__((aligned(16))) unsigned char shm[];
    LAS unsigned char* lds = (LAS unsigned char*)shm;
    cg::grid_group grid = cg::this_grid();
    unsigned char* ws = P.ws;
    bf16_t* ABUF = (bf16_t*)(ws + OFF_ABUF); bf16_t* BIG = (bf16_t*)(ws + OFF_BIG);
    float* H = P.out;
    unsigned xk = 0;
    for (int ph = P.ph_lo; ph < P.ph_hi; ++ph) {
        int f = -1, sub = -1;
        if (ph >= 1 && ph <= 3) { f = 0; sub = ph - 1; }
        else if (ph >= 10 && ph <= 12) { f = 1; sub = ph - 10; }
        else if (ph >= 13 && ph <= 15) { f = 2; sub = ph - 13; }
        else if (ph >= 21 && ph <= 23) { f = 3; sub = ph - 21; }
        int reps = 1;
#ifdef PROBE_REPS
        if (ph == 0) reps += REP_PREP;
        if (ph == 7) reps += REP_ML;
        if (ph == 18 || ph == 19) reps += REP_AT;
        if (sub == 1 || ph == 5 || ph == 17) reps += REP_GEMM;
        if (ph == 6 || ph == 8) reps += REP_L0X;
#ifdef REP_DOWN3
        if (ph == 23) reps += REP_DOWN3;
#endif
#endif
        if (sub == 0 || ph == 4 || ph == 16) continue;
        float* SSQ = (float*)(ws + OFF_SS); bf16_t* AUX1B = (bf16_t*)(ws + OFF_AUX1);
        for (int rep = 0; rep < reps; ++rep) {
        if (rep) grid.sync();
        if (ph == 0) phase_prep(P, lds);
        else if (f >= 0) {
            if (sub == 1) {
                const int si = (f == 0) ? 0 : (f == 1) ? 2 : (f == 2) ? 3 : 5;
                const int pm0 = stage_rstd(lds, SSQ + (size_t)si * MTOK, 11264);
                EpiSwiGLU E{BIG, SSQ + (size_t)si * MTOK, (const LAS float*)(lds + 131072), pm0};
                run_gemm(lds, (f == 1 || f == 3) ? AUX1B : ABUF, (const bf16_t*)(ws + OFF_WGU + f * SZ_GU), 11264, 2048, E);
            } else {
                const int so = (f == 0) ? 1 : (f == 1) ? 3 : 4;
                if (f == 3) { EpiResid<false> E{H, H, nullptr, nullptr, 0.5f / (float)reps}; run_gemm(lds, BIG, (const bf16_t*)(ws + OFF_WDN + f * SZ_DN), 2048, 5632, E); }
                else { EpiResid<true> E{f == 0 ? P.in[0] : H, H, ABUF, SSQ + (size_t)so * MTOK, 0.5f}; run_gemm(lds, BIG, (const bf16_t*)(ws + OFF_WDN + f * SZ_DN), 2048, 5632, E); }
            }
        }
        else if (ph == 5) {
            phase_skinny<1, 0>(lds, ABUF, (const bf16_t*)(ws + OFF_WABIN) + (size_t)6144 * 2048, (float*)(ws + OFF_GATES), P.in[7], SSQ + (size_t)1 * MTOK);
            const int pm0 = stage_rstd(lds, SSQ + (size_t)1 * MTOK, 6144);
            EpiProj0 E{BIG, SSQ + (size_t)1 * MTOK, (const LAS float*)(lds + 131072), pm0}; run_gemm(lds, ABUF, (const bf16_t*)(ws + OFF_WABIN), 6144, 2048, E);
        }
        else if (ph == 6) phase_conv_gmlp(P, lds);
        else if (ph == 7) phase_mlstm(P, lds);
        else if (ph == 8) phase_htnorm(P);
        else if (ph == 9) { EpiResid<true> E{H, H, AUX1B, SSQ + (size_t)2 * MTOK, 1.0f}; run_gemm(lds, ABUF, (const bf16_t*)(ws + OFF_WABOUT), 2048, 2048, E); }
        else if (ph == 17) {
            phase_skinny<3, 1>(lds, ABUF, (const bf16_t*)(ws + OFF_WNSAIN) + (size_t)5120 * 2048, (float*)(ws + OFF_GATES), nullptr, SSQ + (size_t)4 * MTOK);
            const int pm0 = stage_rstd(lds, SSQ + (size_t)4 * MTOK, 5120);
            EpiProj1 E{BIG, (const float*)(ws + OFF_ROPE), SSQ + (size_t)4 * MTOK, (const LAS float*)(lds + 131072), pm0}; run_gemm(lds, ABUF, (const bf16_t*)(ws + OFF_WNSAIN), 5120, 2048, E);
        }
        else if (ph == 18) phase_compress(P, lds);
        else if (ph == 19) phase_attn(P, lds);
        else if (ph == 20) { EpiResid<true> E{H, H, AUX1B, SSQ + (size_t)5 * MTOK, 1.0f}; run_gemm(lds, ABUF, (const bf16_t*)(ws + OFF_WNSAOUT), 2048, 2048, E); }
        else if (ph == 24) phase_final_norm(H, P.in[19]);
        }
#ifdef FBAR_SLEEP
        if (ph + 1 < P.ph_hi) { if (ph == 0) { grid.sync(); if (threadIdx.x < 64) { const unsigned xi = xbar_setup(ws); if (threadIdx.x == 0) *(LAS unsigned*)(lds + 139008) = xi; } } else { ++xk; xbar_sync(ws, lds, xk); } }
#else
        if (ph + 1 < P.ph_hi) grid.sync();
#endif
#ifdef PROBE_SYNCS
        if (ph == 5) { for (int i = 0; i < PROBE_SYNCS; ++i) grid.sync(); }
#endif
    }
}

extern "C" void kernel_launch(void* const* d_in, const int* in_sizes, int n_in, void* d_out, int out_size, void* d_ws, size_t ws_size, hipStream_t stream) {
    static int grid = 0;
    if (grid == 0) {
        if (n_in != 20 || out_size != MTOK * DM || ws_size < WS_END) { fprintf(stderr, "kernel_launch: unexpected shapes (n_in %d out %d ws %zu need %zu)\n", n_in, out_size, ws_size, (size_t)WS_END); grid = -1; return; }
        int dev = 0, cus = 0, per_cu = 0;
        hipGetDevice(&dev);
        hipDeviceGetAttribute(&cus, hipDeviceAttributeMultiprocessorCount, dev);
        if (hipFuncSetAttribute((const void*)mega, hipFuncAttributeMaxDynamicSharedMemorySize, LDS_BYTES) != hipSuccess) { fprintf(stderr, "kernel_launch: hipFuncSetAttribute failed\n"); grid = -1; return; }
        if (hipOccupancyMaxActiveBlocksPerMultiprocessor(&per_cu, (const void*)mega, 512, LDS_BYTES) != hipSuccess || per_cu < 1) { fprintf(stderr, "kernel_launch: occupancy query says %d\n", per_cu); per_cu = 1; }
        (void)hipGetLastError();
        grid = cus * per_cu;
        if (grid > 256) grid = 256;
    }
    if (grid < 0) return;
    Params p{};
    for (int i = 0; i < 20; ++i) p.in[i] = (const float*)d_in[i];
    p.out = (float*)d_out; p.ws = (unsigned char*)d_ws;
#ifndef MULTI_LAUNCH
    p.ph_lo = 0; p.ph_hi = N_PHASES;
    void* args[] = {&p};
    hipError_t e = hipLaunchCooperativeKernel((const void*)mega, dim3(grid), dim3(512), args, LDS_BYTES, stream);
    if (e != hipSuccess) fprintf(stderr, "cooperative launch failed: %s (grid %d)\n", hipGetErrorString(e), grid);
#else
    for (int ph = 0; ph < N_PHASES; ++ph) {
        p.ph_lo = ph; p.ph_hi = ph + 1;
        void* args[] = {&p};
        hipError_t e = hipLaunchCooperativeKernel((const void*)mega, dim3(grid), dim3(512), args, LDS_BYTES, stream);
        if (e != hipSuccess) { fprintf(stderr, "launch %d failed: %s\n", ph, hipGetErrorString(e)); break; }
    }
#endif
}
```

```cpp
#define SKIP_ALPHA 1
#include <hip/hip_runtime.h>
#include <hip/hip_cooperative_groups.h>
#include <cstdio>
namespace cg = cooperative_groups;
namespace pg8 {
#define PG8_LAS __attribute__((address_space(3)))
typedef unsigned short bf16_t;
typedef short bf16x8 __attribute__((ext_vector_type(8)));
typedef float f32x4 __attribute__((ext_vector_type(4)));
typedef unsigned u32x4 __attribute__((ext_vector_type(4)));
constexpr int BM = 256, BK = 64, HALF = 128, HTB = HALF * BK * 2  , STAGE_BYTES = 8 * HTB, NXCD = 8, WGM = 8;

__host__ __device__ __forceinline__ int lds_byte(int r, int c) { const int st = (r >> 4) * 2 + (c >> 5), rr = r & 15, cc = c & 31, ob = rr * 64 + cc * 2; return st * 1024 + (ob ^ (((ob >> 9) & 1) << 5)); }
__host__ __device__ __forceinline__ void stage_rc(int b, int& R, int& C) { const int st = b / 1024, sb = b % 1024, swz = sb ^ (((sb >> 9) & 1) << 5); R = (st >> 1) * 16 + swz / 64; C = (st & 1) * 32 + (swz % 64) / 2; }
__host__ __device__ __forceinline__ int perm32(int rho) { const int n = rho >> 4, i = rho & 15; return 8 * (i >> 2) + 4 * n + (i & 3); }

struct Unit { int pm, pn; };
struct Gemm { const bf16_t* A; const bf16_t* Bt; int M, N, K; };

struct StaticOrder {
    int nM, nN, nwg, G, c;
    __host__ __device__ void init(int M, int N, int G_, int c_) { nM = M / BM; nN = N / BM; nwg = nM * nN; G = G_; c = c_; }
    __host__ __device__ bool next(int i, Unit& u) const {
        const long L = (long)i * G + c; if (L >= nwg) return false;
        int wgid = (int)L; { const int q = nwg / NXCD, r = nwg % NXCD, xcd = wgid % NXCD, off = wgid / NXCD; wgid = (xcd < r ? xcd * (q + 1) : r * (q + 1) + (xcd - r) * q) + off; }
        const int nig = WGM * nN, gid = wgid / nig, fm = gid * WGM, gsz = (nM - fm) < WGM ? (nM - fm) : WGM;
        u.pm = fm + ((wgid % nig) % gsz); u.pn = (wgid % nig) / gsz; return true;
    }
    __device__ __forceinline__ void a_ready(const Unit&) const {}
    __device__ __forceinline__ void done(const Unit&) const {}
};
template <class Epi, class Sched, bool STAMP = false>
__device__ __forceinline__ void gemm_phase(PG8_LAS unsigned char* lds, const Gemm g, const Sched& S, const Epi& E, unsigned long long* stamps) {
    int tid_ = threadIdx.x; asm volatile("" : "+v"(tid_)); const int tid = tid_, wid = __builtin_amdgcn_readfirstlane(tid >> 6), lane = tid & 63, wr = wid >> 2, wc = wid & 3, fr = lane & 15, fq = lane >> 4;
    const int K = g.K, nt = K / BK;
#define PG8_STAMP() do {} while (0)
    PG8_STAMP();
    unsigned voffA[2], voffB[2];
#pragma unroll
    for (int i = 0; i < 2; ++i) { int R, C; stage_rc(tid * 16 + i * 8192, R, C); const int Rb = Epi::PERM ? ((R & ~31) + perm32(R & 31)) : R;
        voffA[i] = (unsigned)(R * K + C) * 2u; voffB[i] = (unsigned)(Rb * K + C) * 2u; }
    const size_t kstep = (size_t)(BK * 2);
    const size_t hstep = (size_t)HALF * K * 2;
    const size_t tstep = 2 * hstep;
    const unsigned ldsw = (unsigned)wid * 1024u;
    const int aoff = lds_byte(wr * 64 + fr, fq * 8), boff = lds_byte(wc * 32 + fr, fq * 8);
#define PG8_SA(b, h) (((b) * 2 + (h)) * HTB)
#define PG8_SB(b, h) ((4 + (b) * 2 + (h)) * HTB)
#define PG8_STAGE(bufoff, gbase, voff) do { _Pragma("unroll") for (int _i = 0; _i < 2; ++_i) \
        __builtin_amdgcn_global_load_lds((const unsigned*)((const char*)(gbase) + (voff)[_i]), (PG8_LAS unsigned*)(lds + (bufoff) + ldsw + _i * 8192), 16, 0, 0); } while (0)
#define PG8_LDA(dst, b, h) do { _Pragma("unroll") for (int m = 0; m < 4; ++m) _Pragma("unroll") for (int k = 0; k < 2; ++k) dst[m][k] = *(const PG8_LAS bf16x8*)(lds + PG8_SA(b, h) + aoff + m * 2048 + k * 1024); } while (0)
#define PG8_LDB(dst, b, h) do { _Pragma("unroll") for (int n = 0; n < 2; ++n) _Pragma("unroll") for (int k = 0; k < 2; ++k) dst[n][k] = *(const PG8_LAS bf16x8*)(lds + PG8_SB(b, h) + boff + n * 2048 + k * 1024); } while (0)
#define PG8_MMA(ai, bj, At, Bt) do { __builtin_amdgcn_s_setprio(1); _Pragma("unroll") for (int m = 0; m < 4; ++m) _Pragma("unroll") for (int n = 0; n < 2; ++n) _Pragma("unroll") for (int k = 0; k < 2; ++k) \
        acc[ai][bj][m][n] = __builtin_amdgcn_mfma_f32_16x16x32_bf16(Bt[n][k], At[m][k], acc[ai][bj][m][n], 0, 0, 0); __builtin_amdgcn_s_setprio(0); } while (0)
#define PG8_WAIT_V(n) asm volatile("s_waitcnt vmcnt(" #n ")" ::: "memory")
#define PG8_WAIT_L(n) asm volatile("s_waitcnt lgkmcnt(" #n ")" ::: "memory")
#define PG8_BAR __builtin_amdgcn_s_barrier()
#define PG8_SCHED __builtin_amdgcn_sched_barrier(0)
    Unit cur, nxt; int ui = 0;
    if (!S.next(0, cur)) return;
    f32x4 acc[2][2][4][2];
#pragma unroll
    for (int a = 0; a < 2; ++a)
#pragma unroll
        for (int b = 0; b < 2; ++b)
#pragma unroll
            for (int m = 0; m < 4; ++m)
#pragma unroll
                for (int n = 0; n < 2; ++n) acc[a][b][m][n] = (f32x4){0.f, 0.f, 0.f, 0.f};
    bf16x8 At[4][2], B0[2][2], B1[2][2];
    const char* cA = (const char*)g.A + (size_t)cur.pm * tstep; const char* cB = (const char*)g.Bt + (size_t)cur.pn * tstep;
    S.a_ready(cur);
    typename Epi::Pre pre = E.pre(cur, wr, fr);
    PG8_STAGE(PG8_SB(0, 0), cB, voffB); PG8_STAGE(PG8_SA(0, 0), cA, voffA); PG8_STAGE(PG8_SB(0, 1), cB + hstep, voffB); PG8_STAGE(PG8_SA(0, 1), cA + hstep, voffA);
    if (wr == 1) PG8_BAR;
    PG8_WAIT_V(4); PG8_BAR;
    PG8_STAGE(PG8_SB(1, 0), cB + kstep, voffB); PG8_STAGE(PG8_SA(1, 0), cA + kstep, voffA); PG8_STAGE(PG8_SB(1, 1), cB + hstep + kstep, voffB);
    PG8_WAIT_V(6); PG8_BAR;
    PG8_STAMP();
    for (;;) {
        const bool has_next = S.next(ui + 1, nxt);
        const char* nA = has_next ? (const char*)g.A + (size_t)nxt.pm * tstep : cA; const char* nB = has_next ? (const char*)g.Bt + (size_t)nxt.pn * tstep : cB;
        for (int t = 0; t < nt; t += 2) {
            const bool last = (t == nt - 2);
            const char* a1 = cA + (size_t)(t + 1) * kstep;
            const char* a2 = last ? nA : cA + (size_t)(t + 2) * kstep; const char* b2 = last ? nB : cB + (size_t)(t + 2) * kstep;
            const char* a3 = a2 + kstep; const char* b3 = b2 + kstep;
            if (last && has_next) S.a_ready(nxt);
            PG8_LDB(B0, 0, 0); PG8_SCHED; PG8_LDA(At, 0, 0); PG8_STAGE(PG8_SA(1, 1), a1 + hstep, voffA);
            PG8_WAIT_L(8); PG8_BAR; PG8_WAIT_L(0); PG8_MMA(0, 0, At, B0); PG8_BAR; PG8_SCHED;
            PG8_LDB(B1, 0, 1); PG8_STAGE(PG8_SB(0, 0), b2, voffB);
            PG8_BAR; PG8_WAIT_L(0); PG8_MMA(0, 1, At, B1); PG8_BAR;
            PG8_LDA(At, 0, 1); PG8_STAGE(PG8_SA(0, 0), a2, voffA);
            PG8_BAR; PG8_WAIT_L(0); PG8_MMA(1, 0, At, B0); PG8_BAR; PG8_SCHED;
            PG8_STAGE(PG8_SB(0, 1), b2 + hstep, voffB);
            PG8_WAIT_V(6); PG8_BAR; PG8_MMA(1, 1, At, B1); PG8_BAR;
            PG8_LDB(B0, 1, 0); PG8_SCHED; PG8_LDA(At, 1, 0); PG8_STAGE(PG8_SA(0, 1), a2 + hstep, voffA);
            PG8_WAIT_L(8); PG8_BAR; PG8_WAIT_L(0); PG8_MMA(0, 0, At, B0); PG8_BAR; PG8_SCHED;
            PG8_LDB(B1, 1, 1); PG8_STAGE(PG8_SB(1, 0), b3, voffB);
            PG8_BAR; PG8_WAIT_L(0); PG8_MMA(0, 1, At, B1); PG8_BAR;
            PG8_LDA(At, 1, 1); PG8_STAGE(PG8_SA(1, 0), a3, voffA);
            PG8_BAR; PG8_WAIT_L(0); PG8_MMA(1, 0, At, B0); PG8_BAR; PG8_SCHED;
            PG8_STAGE(PG8_SB(1, 1), b3 + hstep, voffB);
            PG8_WAIT_V(6); PG8_BAR; PG8_MMA(1, 1, At, B1); PG8_BAR;
        }
        PG8_STAMP();
        if constexpr (!Epi::AFTER_DRAIN) { E(acc, cur, wr, wc, fr, fq, pre); S.done(cur); }
        PG8_STAMP();
        if (!has_next) break;
#pragma unroll
        for (int a = 0; a < 2; ++a)
#pragma unroll
            for (int b = 0; b < 2; ++b)
#pragma unroll
                for (int m = 0; m < 4; ++m)
#pragma unroll
                    for (int n = 0; n < 2; ++n) acc[a][b][m][n] = (f32x4){0.f, 0.f, 0.f, 0.f};
        cur = nxt; cA = nA; cB = nB; ++ui;
        pre = E.pre(cur, wr, fr);
    }
    PG8_WAIT_V(0);
    if (wr == 0) PG8_BAR;
    PG8_BAR;
    if constexpr (Epi::AFTER_DRAIN) { E.fused(acc, cur, wr, wc, fr, fq, lds, wid, lane); S.done(cur); }
    PG8_STAMP();
#undef PG8_STAMP
#undef PG8_SA
#undef PG8_SB
#undef PG8_STAGE
#undef PG8_LDA
#undef PG8_LDB
#undef PG8_MMA
#undef PG8_WAIT_V
#undef PG8_WAIT_L
#undef PG8_BAR
#undef PG8_SCHED
}
}
using pg8::bf16_t; using pg8::bf16x8; using pg8::f32x4; using pg8::u32x4; using pg8::Unit;
#define LAS __attribute__((address_space(3)))
typedef unsigned u32x2 __attribute__((ext_vector_type(2)));

constexpr int MTOK = 16384, DM = 2048, DFF = 5632, SEQL = 4096;
constexpr float EPSN = 1e-6f;

struct Params { const float* in[20]; float* out; unsigned char* ws; int ph_lo, ph_hi; };

constexpr size_t SZ_GU = (size_t)11264 * 2048 * 2, SZ_DN = (size_t)2048 * 5632 * 2;
constexpr size_t OFF_WGU = 0;
constexpr size_t OFF_WDN = OFF_WGU + 4 * SZ_GU;
constexpr size_t OFF_WABIN = OFF_WDN + 4 * SZ_DN;
constexpr size_t OFF_WABOUT = OFF_WABIN + (size_t)6208 * 2048 * 2;
constexpr size_t OFF_WNSAIN = OFF_WABOUT + (size_t)2048 * 2048 * 2;
constexpr size_t OFF_WNSAOUT = OFF_WNSAIN + (size_t)5184 * 2048 * 2;
constexpr size_t OFF_WC1 = OFF_WNSAOUT + (size_t)2048 * 2048 * 2;
constexpr size_t OFF_WC2 = OFF_WC1 + (size_t)2 * 128 * 4096 * 2;
constexpr size_t OFF_ABUF = OFF_WC2 + (size_t)2 * 128 * 128 * 2;
constexpr size_t OFF_BIG = OFF_ABUF + (size_t)MTOK * 2048 * 2;
constexpr size_t OFF_AUX1 = OFF_BIG + (size_t)MTOK * 6144 * 2 + 262144;
constexpr size_t OFF_AUX2 = OFF_AUX1 + (size_t)MTOK * 2048 * 2;
constexpr size_t OFF_KT = OFF_AUX2 + (size_t)MTOK * 1024 * 4;
constexpr size_t OFF_GATES = OFF_KT + (size_t)MTOK * 1024 * 2;
constexpr size_t OFF_ROPE = OFF_GATES + (size_t)MTOK * 48 * 4;
constexpr size_t OFF_KCMP = OFF_ROPE + (size_t)4096 * 32 * 4;
constexpr size_t OFF_VCMPT = OFF_KCMP + (size_t)16 * 256 * 128 * 2;
constexpr size_t OFF_SS = OFF_VCMPT + (size_t)16 * 128 * 256 * 2;
constexpr size_t OFF_BAR = OFF_SS + (size_t)6 * MTOK * 4;
constexpr size_t OFF_XB = OFF_BAR + 256;
constexpr size_t WS_END = OFF_XB + 1024 + 17 * 256;

__device__ __forceinline__ int otid() { int t = threadIdx.x; asm volatile("" : "+v"(t)); return t; }
__device__ __forceinline__ unsigned f2bf(float f) { unsigned u = __float_as_uint(f); u += 0x7FFFu + ((u >> 16) & 1u); return u >> 16; }
typedef float f32x2v __attribute__((ext_vector_type(2)));
typedef __bf16 bf16x2v __attribute__((ext_vector_type(2)));
__device__ __forceinline__ unsigned pack2(float a, float b) { f32x2v v = {a, b}; bf16x2v r = __builtin_convertvector(v, bf16x2v); return __builtin_bit_cast(unsigned, r); }
__device__ __forceinline__ float bflo(unsigned u) { return __uint_as_float(u << 16); }
__device__ __forceinline__ float bfhi(unsigned u) { return __uint_as_float(u & 0xFFFF0000u); }
__device__ __forceinline__ float bfs(short s) { return __uint_as_float(((unsigned)(unsigned short)s) << 16); }
__device__ __forceinline__ f32x4 mfma16(bf16x8 x, bf16x8 y, f32x4 c) { return __builtin_amdgcn_mfma_f32_16x16x32_bf16(x, y, c, 0, 0, 0); }
__device__ __forceinline__ bf16x8 ld8(const bf16_t* p) { return *(const bf16x8*)p; }
__device__ __forceinline__ bf16x8 lds8(const LAS bf16_t* p) { return *(const LAS bf16x8*)p; }
typedef short s16x4 __attribute__((ext_vector_type(4)));
__device__ __forceinline__ s16x4 lds_tr4(const LAS bf16_t* p) { return __builtin_amdgcn_ds_read_tr16_b64_v4i16((LAS s16x4*)p); }
__device__ __forceinline__ bf16x8 mk8(float a, float b, float c, float d, float e, float f, float g, float h) {
    u32x4 u = {pack2(a, b), pack2(c, d), pack2(e, f), pack2(g, h)}; return __builtin_bit_cast(bf16x8, u); }
__device__ __forceinline__ float xmax4(float x) {
    auto r = __builtin_amdgcn_permlane32_swap(__float_as_uint(x), __float_as_uint(x), false, false);
    x = fmaxf(__uint_as_float(r[0]), __uint_as_float(r[1]));
    auto r2 = __builtin_amdgcn_permlane16_swap(__float_as_uint(x), __float_as_uint(x), false, false);
    return fmaxf(__uint_as_float(r2[0]), __uint_as_float(r2[1]));
}
__device__ __forceinline__ float xsum4(float x) {
    auto r = __builtin_amdgcn_permlane32_swap(__float_as_uint(x), __float_as_uint(x), false, false);
    x = __uint_as_float(r[0]) + __uint_as_float(r[1]);
    auto r2 = __builtin_amdgcn_permlane16_swap(__float_as_uint(x), __float_as_uint(x), false, false);
    return __uint_as_float(r2[0]) + __uint_as_float(r2[1]);
}
__device__ __forceinline__ float wave_sum(float v) { for (int o = 32; o; o >>= 1) v += __shfl_xor(v, o); return v; }
__device__ __forceinline__ float sigm(float x) { return __builtin_amdgcn_rcpf(1.f + __expf(-x)); }
__device__ __forceinline__ float silu(float x) { return x * __builtin_amdgcn_rcpf(1.f + __expf(-x)); }
__device__ __forceinline__ float gelu_t(float x) { return x * __builtin_amdgcn_rcpf(1.f + __expf(-1.5957691216f * (x + 0.044715f * x * x * x))); }

struct EpiSwiGLU {
    static constexpr bool PERM = true, AFTER_DRAIN = false;
    bf16_t* O; const float* SS; const LAS float* lrs; int pm0;
    struct Pre { };
    __device__ __forceinline__ Pre pre(const Unit&, int, int) const { return Pre{}; }
    __device__ __forceinline__ float rstd_of(const Unit& u, int lrow) const {
        if (u.pm == pm0) return lrs[lrow];
        return rsqrtf(SS[u.pm * 256 + lrow] * (1.0f / 2048.0f) + EPSN);
    }
    __device__ __forceinline__ void operator()(const f32x4 (&acc)[2][2][4][2], const Unit& u, int wr, int wc, int fr, int fq, const Pre& pre) const {
        const int row0 = u.pm * 256 + wr * 64 + fr, col0 = u.pn * 128 + wc * 32 + 8 * fq;
#pragma unroll
        for (int ai = 0; ai < 2; ++ai)
#pragma unroll
            for (int m = 0; m < 4; ++m) {
                const float rs = rstd_of(u, wr * 64 + ai * 128 + m * 16 + fr);
                float h[8];
#pragma unroll
                for (int n = 0; n < 2; ++n)
#pragma unroll
                    for (int j = 0; j < 4; ++j) h[4 * n + j] = silu(acc[ai][0][m][n][j] * rs) * (acc[ai][1][m][n][j] * rs);
                u32x4 o = {pack2(h[0], h[1]), pack2(h[2], h[3]), pack2(h[4], h[5]), pack2(h[6], h[7])};
                *(u32x4*)(O + (size_t)(row0 + ai * 128 + m * 16) * DFF + col0) = o;
            }
    }
};
template <bool COPY> struct EpiResid {
    static constexpr bool PERM = false, AFTER_DRAIN = false;
    const float* R; float* O; bf16_t* Ob; float* SS; float scale;
    struct Pre { };
    __device__ __forceinline__ Pre pre(const Unit&, int, int) const { return Pre{}; }
    __device__ __forceinline__ void operator()(const f32x4 (&acc)[2][2][4][2], const Unit& u, int wr, int wc, int fr, int fq, const Pre& pre) const {
        const int row0 = u.pm * 256 + wr * 64 + fr, col0 = u.pn * 256 + wc * 32 + 4 * fq;
#pragma unroll
        for (int ai = 0; ai < 2; ++ai) {
            f32x4 rv[4][2][2];
#pragma unroll
            for (int m = 0; m < 4; ++m)
#pragma unroll
                for (int bj = 0; bj < 2; ++bj)
#pragma unroll
                    for (int n = 0; n < 2; ++n) rv[m][bj][n] = *(const f32x4*)(R + (size_t)(row0 + ai * 128 + m * 16) * DM + col0 + bj * 128 + n * 16);
#pragma unroll
            for (int m = 0; m < 4; ++m) {
                const size_t ro = (size_t)(row0 + ai * 128 + m * 16) * DM + col0;
                float ss = 0.f;
#pragma unroll
                for (int bj = 0; bj < 2; ++bj)
#pragma unroll
                    for (int n = 0; n < 2; ++n) {
                        const f32x4 hv = rv[m][bj][n] + acc[ai][bj][m][n] * scale;
                        *(f32x4*)(O + ro + bj * 128 + n * 16) = hv;
                        if (COPY) {
                            u32x2 o = {pack2(hv[0], hv[1]), pack2(hv[2], hv[3])};
                            *(u32x2*)(Ob + ro + bj * 128 + n * 16) = o;
                            ss += hv[0] * hv[0] + hv[1] * hv[1] + hv[2] * hv[2] + hv[3] * hv[3];
                        }
                    }
                if (COPY) { ss = xsum4(ss); if (fq == 0) (void)__hip_atomic_fetch_add(SS + row0 + ai * 128 + m * 16, ss, __ATOMIC_RELAXED, __HIP_MEMORY_SCOPE_AGENT); }
            }
        }
    }
};
struct EpiProj0 {
    static constexpr bool PERM = true, AFTER_DRAIN = false;
    bf16_t* O; const float* SS; const LAS float* lrs; int pm0;
    struct Pre { };
    __device__ __forceinline__ Pre pre(const Unit&, int, int) const { return Pre{}; }
    __device__ __forceinline__ float rstd_of(const Unit& u, int lrow) const {
        if (u.pm == pm0) return lrs[lrow];
        return rsqrtf(SS[u.pm * 256 + lrow] * (1.0f / 2048.0f) + EPSN);
    }
    __device__ __forceinline__ void operator()(const f32x4 (&acc)[2][2][4][2], const Unit& u, int wr, int wc, int fr, int fq, const Pre& pre) const {
        const int row0 = u.pm * 256 + wr * 64 + fr, col0 = u.pn * 256 + wc * 32 + 8 * fq;
        const bool g = u.pn < 8;
#pragma unroll
        for (int ai = 0; ai < 2; ++ai)
#pragma unroll
            for (int m = 0; m < 4; ++m) {
                const float rs = rstd_of(u, wr * 64 + ai * 128 + m * 16 + fr);
#pragma unroll
                for (int bj = 0; bj < 2; ++bj) {
                    float h[8];
#pragma unroll
                    for (int n = 0; n < 2; ++n)
#pragma unroll
                        for (int j = 0; j < 4; ++j) { const float v = acc[ai][bj][m][n][j] * rs; h[4 * n + j] = g ? gelu_t(v) : v; }
                    u32x4 o = {pack2(h[0], h[1]), pack2(h[2], h[3]), pack2(h[4], h[5]), pack2(h[6], h[7])};
                    *(u32x4*)(O + (size_t)(row0 + ai * 128 + m * 16) * 6144 + col0 + bj * 128) = o;
                }
            }
    }
};
struct EpiProj1 {
    static constexpr bool PERM = false, AFTER_DRAIN = false;
    bf16_t* O; const float* rope; const float* SS; const LAS float* lrs; int pm0;
    struct Pre { };
    __device__ __forceinline__ Pre pre(const Unit&, int, int) const { return Pre{}; }
    __device__ __forceinline__ float rstd_of(const Unit& u, int lrow) const {
        if (u.pm == pm0) return lrs[lrow];
        return rsqrtf(SS[u.pm * 256 + lrow] * (1.0f / 2048.0f) + EPSN);
    }
    __device__ __forceinline__ void operator()(const f32x4 (&acc)[2][2][4][2], const Unit& u, int wr, int wc, int fr, int fq, const Pre& pre) const {
        const int row0 = u.pm * 256 + wr * 64 + fr, col0 = u.pn * 256 + wc * 32 + 4 * fq;
#pragma unroll
        for (int ai = 0; ai < 2; ++ai) {
            f32x4 rcos[4], rsin[4];
            if (wc == 0) {
#pragma unroll
                for (int m = 0; m < 4; ++m) { const float* rp = rope + (size_t)((row0 + ai * 128 + m * 16) & 4095) * 32 + 4 * fq; rcos[m] = *(const f32x4*)rp; rsin[m] = *(const f32x4*)(rp + 16); }
            }
#pragma unroll
            for (int bj = 0; bj < 2; ++bj) {
                const int head = u.pn * 2 + bj;
                const bool isq = head < 16;
                const bool dorope = (wc == 0) && (isq || ((((head - 16) >> 2) & 1) == 0));
                const float sc = isq ? 0.08838834764831845f * 1.4426950408889634f : 1.f;
#pragma unroll
                for (int m = 0; m < 4; ++m) {
                    const int row = row0 + ai * 128 + m * 16;
                    const float rs = rstd_of(u, wr * 64 + ai * 128 + m * 16 + fr) * sc;
                    f32x4 v0 = acc[ai][bj][m][0] * rs, v1 = acc[ai][bj][m][1] * rs;
                    if (dorope) {
                        const f32x4 c = rcos[m], s = rsin[m];
                        const f32x4 a = v0 * c - v1 * s, b = v0 * s + v1 * c; v0 = a; v1 = b;
                    }
                    bf16_t* op = O + (size_t)row * 5120 + col0 + bj * 128;
                    u32x2 o0 = {pack2(v0[0], v0[1]), pack2(v0[2], v0[3])}, o1 = {pack2(v1[0], v1[1]), pack2(v1[2], v1[3])};
                    *(u32x2*)op = o0; *(u32x2*)(op + 16) = o1;
                }
            }
        }
    }
};

struct Job { const float* src; bf16_t* dst; const float* gain; int K, ldn, nvalid, ntn, remap, off; };
__device__ __forceinline__ void make_job(const Params& P, int j, Job& J) {
    unsigned char* ws = P.ws;
    J.gain = nullptr;
    if (j < 12) {
        const int fi = j / 3, kind = j - 3 * fi;
        if (kind < 2) { J.src = P.in[2 + kind] + (size_t)fi * 2048 * 5632; J.dst = (bf16_t*)(ws + OFF_WGU + fi * SZ_GU); J.K = 2048; J.ldn = 5632; J.nvalid = 5632; J.ntn = 88; J.remap = 1; J.off = kind * 128; J.gain = P.in[1] + (size_t)fi * 2048; }
        else { J.src = P.in[4] + (size_t)fi * 5632 * 2048; J.dst = (bf16_t*)(ws + OFF_WDN + fi * SZ_DN); J.K = 5632; J.ldn = 2048; J.nvalid = 2048; J.ntn = 32; J.remap = 0; J.off = 0; }
    } else if (j == 12) { J.src = P.in[6]; J.dst = (bf16_t*)(ws + OFF_WABIN); J.K = 2048; J.ldn = 6152; J.nvalid = 6152; J.ntn = 97; J.remap = 0; J.off = 0; J.gain = P.in[5]; }
    else if (j == 13) { J.src = P.in[13]; J.dst = (bf16_t*)(ws + OFF_WABOUT); J.K = 2048; J.ldn = 2048; J.nvalid = 2048; J.ntn = 32; J.remap = 0; J.off = 0; }
    else if (j == 14) { J.src = P.in[14]; J.dst = (bf16_t*)(ws + OFF_WNSAIN); J.K = 2048; J.ldn = 5168; J.nvalid = 5168; J.ntn = 81; J.remap = 0; J.off = 0; J.gain = P.in[5] + 2048; }
    else if (j == 15) { J.src = P.in[18]; J.dst = (bf16_t*)(ws + OFF_WNSAOUT); J.K = 2048; J.ldn = 2048; J.nvalid = 2048; J.ntn = 32; J.remap = 0; J.off = 0; }
    else if (j < 18) { const int kv = j - 16; J.src = P.in[16] + (size_t)kv * 4096 * 128; J.dst = (bf16_t*)(ws + OFF_WC1) + (size_t)kv * 128 * 4096; J.K = 4096; J.ldn = 128; J.nvalid = 128; J.ntn = 2; J.remap = 0; J.off = 0; }
    else { const int kv = j - 18; J.src = P.in[17] + (size_t)kv * 128 * 128; J.dst = (bf16_t*)(ws + OFF_WC2) + (size_t)kv * 128 * 128; J.K = 128; J.ldn = 128; J.nvalid = 128; J.ntn = 2; J.remap = 0; J.off = 0; }
}
constexpr int NT_CONVERT = 12 * 1408 + 16 * 97 + 16 * 32 + 16 * 81 + 16 * 32 + 2 * 64 + 2 * 2;
__device__ __forceinline__ void phase_prep(const Params& P, LAS unsigned char* lds) {
    LAS float* tile = (LAS float*)lds;
    const int tid = otid();
    if (tid == 0) ((unsigned*)(P.ws + OFF_XB))[blockIdx.x] = (unsigned)__builtin_amdgcn_s_getreg((3 << 11) | 20) & 0xFu;
    if (blockIdx.x == 0 && tid < 17) __hip_atomic_store((unsigned*)(P.ws + OFF_XB + 1024 + 256 * tid), 0u, __ATOMIC_RELAXED, __HIP_MEMORY_SCOPE_AGENT);
    {
        const int idx = blockIdx.x * 512 + tid;
        if (idx < 4096 * 16) {
            const int pos = idx >> 4, i = idx & 15;
            const float inv = 1.0f / powf(500000.0f, (float)i * (1.0f / 16.0f));
            const float ang = (float)pos * inv;
            float s, c; sincosf(ang, &s, &c);
            float* rp = (float*)(P.ws + OFF_ROPE) + (size_t)pos * 32;
            rp[i] = c; rp[16 + i] = s;
        }
    }
    {
        float* SS = (float*)(P.ws + OFF_SS); bf16_t* XB = (bf16_t*)(P.ws + OFF_ABUF);
        for (int i = blockIdx.x * 512 + tid; i < 5 * MTOK; i += gridDim.x * 512) SS[MTOK + i] = 0.f;
        const int wave = tid >> 6, lane = tid & 63;
        for (int row = blockIdx.x * 8 + wave; row < MTOK; row += gridDim.x * 8) {
            const float4* s = (const float4*)(P.in[0] + (size_t)row * DM);
            float ss = 0.f;
#pragma unroll
            for (int i = 0; i < 8; ++i) {
                const float4 v = s[lane + 64 * i];
                ss += v.x * v.x + v.y * v.y + v.z * v.z + v.w * v.w;
                u32x2 o = {pack2(v.x, v.y), pack2(v.z, v.w)};
                *(u32x2*)(XB + (size_t)row * DM + 4 * (lane + 64 * i)) = o;
            }
            ss = wave_sum(ss);
            if (lane == 0) SS[row] = ss;
        }
    }
    {
        Job J, Jn; float4 v[4]; int k0 = 0, n0 = 0, k0n = 0, n0n = 0;
#define PREP_FIND(T, JJ, K0, N0) do { int lt_ = (T), j_ = 0; for (;; ++j_) { make_job(P, j_, JJ); const int n_ = (JJ.K >> 7) * JJ.ntn; if (lt_ < n_) break; lt_ -= n_; } \
            const int nkt_ = JJ.K >> 7; K0 = (lt_ % nkt_) * 128; N0 = (lt_ / nkt_) * 64; } while (0)
#define PREP_LOAD(JJ, K0, N0) do { _Pragma("unroll") for (int i = 0; i < 4; ++i) { const int idx = tid + 512 * i, k = idx >> 4, n = (N0) + 4 * (idx & 15); \
            float4 x = make_float4(0.f, 0.f, 0.f, 0.f); if (n < JJ.nvalid) x = *(const float4*)(JJ.src + (size_t)((K0) + k) * JJ.ldn + n); \
            if (JJ.gain) { const float gk = JJ.gain[(K0) + k]; x.x *= gk; x.y *= gk; x.z *= gk; x.w *= gk; } v[i] = x; } } while (0)
        int t = blockIdx.x;
        if (t < NT_CONVERT) { PREP_FIND(t, Jn, k0n, n0n); PREP_LOAD(Jn, k0n, n0n); }
        for (; t < NT_CONVERT; t += gridDim.x) {
            J = Jn; k0 = k0n; n0 = n0n;
#pragma unroll
            for (int i = 0; i < 4; ++i) { const int idx = tid + 512 * i, k = idx >> 4, c4 = idx & 15; LAS float* tp = tile + k * 65 + 4 * c4; tp[0] = v[i].x; tp[1] = v[i].y; tp[2] = v[i].z; tp[3] = v[i].w; }
            __syncthreads();
            if (t + (int)gridDim.x < NT_CONVERT) { PREP_FIND(t + (int)gridDim.x, Jn, k0n, n0n); PREP_LOAD(Jn, k0n, n0n); }
#pragma unroll
            for (int i = 0; i < 2; ++i) {
                const int idx = tid + 512 * i, n = idx >> 4, kg = idx & 15;
                float f[8];
#pragma unroll
                for (int jj = 0; jj < 8; ++jj) f[jj] = tile[(8 * kg + jj) * 65 + n];
                u32x4 o = {pack2(f[0], f[1]), pack2(f[2], f[3]), pack2(f[4], f[5]), pack2(f[6], f[7])};
                const int nn = n0 + n, row = J.remap ? ((nn >> 7) * 256 + J.off + (nn & 127)) : nn;
                *(u32x4*)(J.dst + (size_t)row * J.K + k0 + 8 * kg) = o;
            }
            __syncthreads();
        }
#undef PREP_FIND
#undef PREP_LOAD
    }
}

__device__ __forceinline__ void phase_norm(const float* src, const float* g, bf16_t* dst) {
    const int wave = otid() >> 6, lane = otid() & 63;
    for (int row = blockIdx.x * 8 + wave; row < MTOK; row += gridDim.x * 8) {
        const float4* s = (const float4*)(src + (size_t)row * DM);
        float4 v[8]; float ss = 0.f;
#pragma unroll
        for (int i = 0; i < 8; ++i) { v[i] = s[lane + 64 * i]; ss += v[i].x * v[i].x + v[i].y * v[i].y + v[i].z * v[i].z + v[i].w * v[i].w; }
        ss = wave_sum(ss);
        const float r = rsqrtf(ss * (1.0f / 2048.0f) + EPSN);
#pragma unroll
        for (int i = 0; i < 8; ++i) {
            const float4 gg = ((const float4*)g)[lane + 64 * i];
            u32x2 o = {pack2(v[i].x * r * gg.x, v[i].y * r * gg.y), pack2(v[i].z * r * gg.z, v[i].w * r * gg.w)};
            *(u32x2*)(dst + (size_t)row * DM + 4 * (lane + 64 * i)) = o;
        }
    }
}
__device__ __forceinline__ void phase_final_norm(float* io, const float* g) {
    const int wave = otid() >> 6, lane = otid() & 63;
    for (int row = blockIdx.x * 8 + wave; row < MTOK; row += gridDim.x * 8) {
        float4* s = (float4*)(io + (size_t)row * DM);
        float4 v[8]; float ss = 0.f;
#pragma unroll
        for (int i = 0; i < 8; ++i) { v[i] = s[lane + 64 * i]; ss += v[i].x * v[i].x + v[i].y * v[i].y + v[i].z * v[i].z + v[i].w * v[i].w; }
        ss = wave_sum(ss);
        const float r = rsqrtf(ss * (1.0f / 2048.0f) + EPSN);
#pragma unroll
        for (int i = 0; i < 8; ++i) {
            const float4 gg = ((const float4*)g)[lane + 64 * i];
            s[lane + 64 * i] = make_float4(v[i].x * r * gg.x, v[i].y * r * gg.y, v[i].z * r * gg.z, v[i].w * r * gg.w);
        }
    }
}

template <int NT, int MODE>
__device__ __forceinline__ void phase_skinny(LAS unsigned char* lds, const bf16_t* A, const bf16_t* Bt, float* G, const float* bias, const float* SS) {
    const int wave = otid() >> 6, lane = otid() & 63, fr = lane & 15, fq = lane >> 4, half = wave >> 2, w4 = wave & 3;
    LAS f32x4* xch = (LAS f32x4*)lds;
    for (int rt0 = blockIdx.x * 4; rt0 < MTOK / 16; rt0 += gridDim.x * 4) {
        const int rt = rt0 + w4;
        f32x4 acc[NT];
#pragma unroll
        for (int n = 0; n < NT; ++n) acc[n] = (f32x4){0.f, 0.f, 0.f, 0.f};
        const bf16_t* ap = A + (size_t)(rt * 16 + fr) * DM + 8 * fq + 1024 * half;
        const bf16_t* bp = Bt + (size_t)fr * DM + 8 * fq + 1024 * half;
#pragma unroll 8
        for (int ks = 0; ks < 32; ++ks) {
            const bf16x8 a = ld8(ap + 32 * ks);
#pragma unroll
            for (int n = 0; n < NT; ++n) { const bf16x8 b = ld8(bp + (size_t)n * 16 * DM + 32 * ks); acc[n] = mfma16(b, a, acc[n]); }
        }
        if (half) {
#pragma unroll
            for (int n = 0; n < NT; ++n) xch[(w4 * NT + n) * 64 + lane] = acc[n];
        }
        __syncthreads();
        if (!half) {
#pragma unroll
            for (int n = 0; n < NT; ++n) acc[n] += xch[(w4 * NT + n) * 64 + lane];
            const int token = rt * 16 + fr;
            const float rs = rsqrtf(SS[token] * (1.0f / 2048.0f) + EPSN);
            if (MODE == 0) {
                if (fq < 2) { const f32x4 b = *(const f32x4*)(bias + 4 * fq); *(f32x4*)(G + (size_t)token * 8 + 4 * fq) = acc[0] * rs + b; }
            } else {
#pragma unroll
                for (int n = 0; n < NT; ++n) { f32x4 o; for (int j = 0; j < 4; ++j) o[j] = sigm(acc[n][j] * rs); *(f32x4*)(G + (size_t)token * 48 + 16 * n + 4 * fq) = o; }
            }
        }
        __syncthreads();
    }
}

__device__ __forceinline__ void conv_wave_item(const Params& P, int item, int lane) {
    const bf16_t* BIG = (const bf16_t*)(P.ws + OFF_BIG); bf16_t* QK = (bf16_t*)(P.ws + OFF_AUX1); bf16_t* KT = (bf16_t*)(P.ws + OFF_KT);
    const float* cw = P.in[11];
    const int tgp = item >> 5, cgp = item & 31, tg = lane & 7, cg = lane >> 3;
    const int tok0 = tgp * 64 + 8 * tg, c0 = cgp * 64 + 8 * cg, pos0 = tok0 & 4095;
    float w[4][8];
#pragma unroll
    for (int jj = 0; jj < 4; ++jj) { const float4 a = *(const float4*)(cw + jj * 2048 + c0), b = *(const float4*)(cw + jj * 2048 + c0 + 4);
        w[jj][0] = a.x; w[jj][1] = a.y; w[jj][2] = a.z; w[jj][3] = a.w; w[jj][4] = b.x; w[jj][5] = b.y; w[jj][6] = b.z; w[jj][7] = b.w; }
    bf16x8 xr[11];
#pragma unroll
    for (int r = 0; r < 11; ++r) {
        const bool ok = (r >= 3) || (pos0 != 0);
        const int t = ok ? (tok0 - 3 + r) : tok0;
        const bf16x8 v = ld8(BIG + (size_t)t * 6144 + 2048 + c0);
        xr[r] = ok ? v : (bf16x8){0, 0, 0, 0, 0, 0, 0, 0};
    }
    const float ksc = (c0 >= 1024) ? 0.0625f : 1.0f;
    float o[8][8];
#pragma unroll
    for (int i = 0; i < 8; ++i)
#pragma unroll
        for (int j = 0; j < 8; ++j) {
            float a = 0.f;
#pragma unroll
            for (int jj = 0; jj < 4; ++jj) a += w[jj][j] * bfs(xr[i + jj][j]);
            o[i][j] = silu(a) * ksc;
        }
#pragma unroll
    for (int i = 0; i < 8; ++i) {
        u32x4 v = {pack2(o[i][0], o[i][1]), pack2(o[i][2], o[i][3]), pack2(o[i][4], o[i][5]), pack2(o[i][6], o[i][7])};
        *(u32x4*)(QK + (size_t)(tok0 + i) * 2048 + c0) = v;
    }
    if (c0 >= 1024) {
        const int b = tok0 >> 12;
#pragma unroll
        for (int j = 0; j < 8; ++j) {
            u32x4 v = {pack2(o[0][j], o[1][j]), pack2(o[2][j], o[3][j]), pack2(o[4][j], o[5][j]), pack2(o[6][j], o[7][j])};
            *(u32x4*)(KT + (size_t)(b * 1024 + (c0 - 1024) + j) * 4096 + pos0) = v;
        }
    }
}

__device__ __forceinline__ void gmlp_item(const Params& P, LAS unsigned char* lds, int item2) {
    const int item = item2 >> 1, g0 = (item2 & 1) * 4;
    const int tid = otid(), wave = tid >> 6, lane = tid & 63, fr = lane & 15, fq = lane >> 4;
    LAS bf16_t* VT = (LAS bf16_t*)lds;
    LAS float* rstd = (LAS float*)(lds + 34816);
    const bf16_t* BIG = (const bf16_t*)(P.ws + OFF_BIG); bf16_t* ABUF = (bf16_t*)(P.ws + OFF_ABUF);
    const float* gn = P.in[8]; const float* wsp = P.in[9]; const float* bsp = P.in[10];
    const int T0 = item * 128;
    for (int r = 0; r < 16; ++r) {
        const int row = wave * 16 + r;
        const bf16_t* p = BIG + (size_t)(T0 + row) * 6144 + 1024 + 16 * lane;
        const bf16x8 a = ld8(p), b = ld8(p + 8);
        float ss = 0.f;
#pragma unroll
        for (int j = 0; j < 8; ++j) { const float x = bfs(a[j]), y = bfs(b[j]); ss += x * x + y * y; }
        ss = wave_sum(ss);
        if (lane == 0) rstd[row] = rsqrtf(ss * (1.0f / 1024.0f) + EPSN);
    }
    __syncthreads();
    for (int g = g0; g < g0 + 4; ++g) {
        {
            const int s = tid & 127, eg0 = tid >> 7; const float rs = rstd[s];
#pragma unroll
            for (int it = 0; it < 4; ++it) {
                const int eg = eg0 + 4 * it;
                const bf16x8 v = ld8(BIG + (size_t)(T0 + s) * 6144 + 1024 + g * 128 + 8 * eg);
                const float4 g0 = *(const float4*)(gn + g * 128 + 8 * eg), g1 = *(const float4*)(gn + g * 128 + 8 * eg + 4);
                const float gg[8] = {g0.x, g0.y, g0.z, g0.w, g1.x, g1.y, g1.z, g1.w};
#pragma unroll
                for (int jj = 0; jj < 8; ++jj) VT[(8 * eg + jj) * 136 + s] = (bf16_t)f2bf(bfs(v[jj]) * rs * gg[jj]);
            }
        }
        __syncthreads();
        f32x4 acc[8];
#pragma unroll
        for (int e = 0; e < 8; ++e) acc[e] = (f32x4){0.f, 0.f, 0.f, 0.f};
        const int t = wave * 16 + fr;
        for (int ks = 0; ks < 4; ++ks) {
            if (32 * ks <= wave * 16 + 15) {
                const float* wp = wsp + ((size_t)(g * 128 + t)) * 128 + 32 * ks + 8 * fq;
                const float4 w0 = *(const float4*)wp, w1 = *(const float4*)(wp + 4);
                const int s0 = 32 * ks + 8 * fq;
                const bf16x8 Y = mk8(s0 + 0 <= t ? w0.x : 0.f, s0 + 1 <= t ? w0.y : 0.f, s0 + 2 <= t ? w0.z : 0.f, s0 + 3 <= t ? w0.w : 0.f,
                                     s0 + 4 <= t ? w1.x : 0.f, s0 + 5 <= t ? w1.y : 0.f, s0 + 6 <= t ? w1.z : 0.f, s0 + 7 <= t ? w1.w : 0.f);
#pragma unroll
                for (int e = 0; e < 8; ++e) { const bf16x8 X = lds8(VT + (16 * e + fr) * 136 + 32 * ks + 8 * fq); acc[e] = mfma16(X, Y, acc[e]); }
            }
        }
        const float bsv = bsp[g * 128 + t]; const size_t tok = (size_t)(T0 + t);
        u32x2 uall[8];
#pragma unroll
        for (int e = 0; e < 8; ++e) uall[e] = *(const u32x2*)(BIG + tok * 6144 + g * 128 + 16 * e + 4 * fq);
#pragma unroll
        for (int e = 0; e < 8; ++e) {
            const int e0 = 16 * e + 4 * fq;
            const u32x2 uu = uall[e];
            u32x2 o = {pack2(bflo(uu.x) * (acc[e][0] + bsv), bfhi(uu.x) * (acc[e][1] + bsv)), pack2(bflo(uu.y) * (acc[e][2] + bsv), bfhi(uu.y) * (acc[e][3] + bsv))};
            *(u32x2*)(ABUF + tok * 2048 + g * 128 + e0) = o;
        }
        __syncthreads();
    }
}

__device__ __forceinline__ void phase_conv_gmlp(const Params& P, LAS unsigned char* lds) {
    for (int it = blockIdx.x; it < 256; it += gridDim.x) gmlp_item(P, lds, it);
    const int wave = otid() >> 6, lane = otid() & 63;
    for (int it = blockIdx.x * 8 + wave; it < 8192; it += gridDim.x * 8) conv_wave_item(P, it, lane);
}

constexpr int ML_KS = 0, ML_PS = 67584, ML_VT = 102400, ML_VTW = 106752, ML_CB = 111104, ML_N = 119552, ML_A = 120576, ML_MT = 121088, ML_B = 121600, ML_WS = 122112;
constexpr int ML_CB2 = 122624, ML_N2 = 131072, ML_SC2 = 132096 - ML_A;
__device__ __forceinline__ void mlstm_scalars(LAS float* sa, LAS float* sMt, LAS float* sb, float f0, float f1, float i0, float i1, float m, int lane) {
    const float l0 = (f0 >= 0.f) ? -log1pf(__expf(-f0)) : (f0 - log1pf(__expf(f0)));
    const float l1 = (f1 >= 0.f) ? -log1pf(__expf(-f1)) : (f1 - log1pf(__expf(f1)));
    float v = l0 + l1;
#pragma unroll
    for (int o = 1; o < 64; o <<= 1) { const float y = __shfl_up(v, o); if (lane >= o) v += y; }
    const float excl = v - (l0 + l1);
    const float b0 = excl + l0, b1 = excl + l0 + l1;
    const float a0 = i0 - b0, a1 = i1 - b1;
    float q = fmaxf(a0, a1);
#pragma unroll
    for (int o = 1; o < 64; o <<= 1) { const float y = __shfl_up(q, o); if (lane >= o) q = fmaxf(q, y); }
    float qe = __shfl_up(q, 1); if (lane == 0) qe = -3.0e38f;
    const float pm0 = fmaxf(qe, a0), pm1 = fmaxf(pm0, a1);
    sa[2 * lane] = a0; sa[2 * lane + 1] = a1; sb[2 * lane] = b0; sb[2 * lane + 1] = b1;
    sMt[2 * lane] = fmaxf(pm0, m); sMt[2 * lane + 1] = fmaxf(pm1, m);
}
__device__ __forceinline__ void mlstm_item(const Params& P, LAS unsigned char* lds, int item) {
    const int tid = otid(), wave = tid >> 6, lane = tid & 63, fr = lane & 15, fq = lane >> 4;
    LAS bf16_t* Ks = (LAS bf16_t*)(lds + ML_KS);
    LAS bf16_t* Ps = (LAS bf16_t*)(lds + ML_PS);
    LAS bf16_t* VT = (LAS bf16_t*)(lds + ML_VT);
    LAS bf16_t* VTW = (LAS bf16_t*)(lds + ML_VTW);
    const bf16_t* BIG = (const bf16_t*)(P.ws + OFF_BIG); const bf16_t* QK = (const bf16_t*)(P.ws + OFF_AUX1);
    const float* G0 = (const float*)(P.ws + OFF_GATES); float* HT = (float*)(P.ws + OFF_AUX2);
    const int bh_ = ((item & 7) << 1) + ((item >> 7) & 1), es = (item >> 3) & 15, h = bh_ & 3, b = bh_ >> 2;
    { LAS bf16_t* Cb0 = (LAS bf16_t*)(lds + ML_CB); LAS float* n0 = (LAS float*)(lds + ML_N);
      for (int i = tid; i < 16 * 264; i += 512) Cb0[i] = 0;
      if (tid < 256) n0[tid] = 0.f; }
    f32x4 Cacc[2] = {(f32x4){0.f, 0.f, 0.f, 0.f}, (f32x4){0.f, 0.f, 0.f, 0.f}}, Nacc[2] = {(f32x4){0.f, 0.f, 0.f, 0.f}, (f32x4){0.f, 0.f, 0.f, 0.f}};
    float m = 0.f;
    bf16x8 gk[8], gq[8], gv = (bf16x8){0, 0, 0, 0, 0, 0, 0, 0};
    float pf0 = 0.f, pf1 = 0.f, pi0 = 0.f, pi1 = 0.f;
#define ML_FETCH(TB) do { const int tb_ = (TB); \
        _Pragma("unroll") for (int i = 0; i < 8; ++i) { const int idx = tid + 512 * i; gk[i] = ld8(QK + (size_t)(tb_ + (idx >> 5)) * 2048 + 1024 + h * 256 + 8 * (idx & 31)); } \
        _Pragma("unroll") for (int ks = 0; ks < 8; ++ks) gq[ks] = ld8(QK + (size_t)(tb_ + 16 * wave + fr) * 2048 + h * 256 + 32 * ks + 8 * fq); \
        if (tid < 256) gv = ld8(BIG + (size_t)(tb_ + (tid & 127)) * 6144 + 4096 + h * 256 + es * 16 + 8 * (tid >> 7)); \
        if (wave == 0) { pf0 = G0[(size_t)(tb_ + 2 * lane) * 8 + 4 + h]; pf1 = G0[(size_t)(tb_ + 2 * lane + 1) * 8 + 4 + h]; pi0 = G0[(size_t)(tb_ + 2 * lane) * 8 + h]; pi1 = G0[(size_t)(tb_ + 2 * lane + 1) * 8 + h]; } } while (0)
    ML_FETCH(b * 4096);
    if (wave == 0) mlstm_scalars((LAS float*)(lds + ML_A), (LAS float*)(lds + ML_MT), (LAS float*)(lds + ML_B), pf0, pf1, pi0, pi1, m, lane);
    __syncthreads();
    for (int c = 0; c < 32; ++c) {
        const int T0 = b * 4096 + c * 128, par = c & 1;
        LAS float* sa = (LAS float*)(lds + ML_A + par * ML_SC2); LAS float* sMt = (LAS float*)(lds + ML_MT + par * ML_SC2);
        LAS float* sb = (LAS float*)(lds + ML_B + par * ML_SC2); LAS float* sws = (LAS float*)(lds + ML_WS + par * ML_SC2);
        LAS bf16_t* Cb = (LAS bf16_t*)(lds + (par ? ML_CB2 : ML_CB)); LAS bf16_t* CbN = (LAS bf16_t*)(lds + (par ? ML_CB : ML_CB2));
        LAS float* nvec = (LAS float*)(lds + (par ? ML_N2 : ML_N)); LAS float* nvecN = (LAS float*)(lds + (par ? ML_N : ML_N2));
        const float MtL = sMt[127];
        if (tid < 128) sws[tid] = __expf(sa[tid] - MtL);
#pragma unroll
        for (int i = 0; i < 8; ++i) {
            const int idx = tid + 512 * i, s = idx >> 5, dp = idx & 31;
            *(LAS bf16x8*)(Ks + s * 264 + 8 * dp) = gk[i];
        }
        if (tid < 256) {
            const int s = tid & 127, hf = tid >> 7;
            const bf16x8 v = gv;
            const float w = __expf(sa[s] - MtL);
            const int sp = (s & ~31) + 8 * ((s >> 2) & 3) + 4 * ((s >> 4) & 1) + (s & 3);
#pragma unroll
            for (int jj = 0; jj < 8; ++jj) { VT[(8 * hf + jj) * 136 + sp] = (bf16_t)v[jj]; VTW[(8 * hf + jj) * 136 + s] = (bf16_t)f2bf(bfs(v[jj]) * w); }
        }
        bf16x8 qf[8];
#pragma unroll
        for (int ks = 0; ks < 8; ++ks) qf[ks] = gq[ks];
        if (c < 31) ML_FETCH(T0 + 128);
        __syncthreads();
        const int t = 16 * wave + fr;
        const float Mt_t = sMt[t];
        float rsum = 0.f;
        f32x4 a1 = (f32x4){0.f, 0.f, 0.f, 0.f};
        for (int kk = 0; kk <= (wave >> 1); ++kk) {
            f32x4 acc0 = (f32x4){0.f, 0.f, 0.f, 0.f}, acc1 = (f32x4){0.f, 0.f, 0.f, 0.f};
#pragma unroll
            for (int ks = 0; ks < 8; ++ks) {
                const bf16x8 X0 = lds8(Ks + (32 * kk + fr) * 264 + 32 * ks + 8 * fq), X1 = lds8(Ks + (32 * kk + 16 + fr) * 264 + 32 * ks + 8 * fq);
                acc0 = mfma16(X0, qf[ks], acc0); acc1 = mfma16(X1, qf[ks], acc1);
            }
            float pv[2][4];
#pragma unroll
            for (int hh = 0; hh < 2; ++hh) {
                const f32x4 acc = hh ? acc1 : acc0;
                const int s0 = 32 * kk + 16 * hh + 4 * fq;
                const f32x4 av = *(const LAS f32x4*)(sa + s0);
#pragma unroll
                for (int j = 0; j < 4; ++j) { const float d = (s0 + j <= t) ? __expf(av[j] - Mt_t) : 0.f; pv[hh][j] = acc[j] * d; rsum += pv[hh][j]; }
            }
            const bf16x8 Y = mk8(pv[0][0], pv[0][1], pv[0][2], pv[0][3], pv[1][0], pv[1][1], pv[1][2], pv[1][3]);
            a1 = mfma16(lds8(VT + fr * 136 + 32 * kk + 8 * fq), Y, a1);
        }
        rsum = xsum4(rsum);
        {
            f32x4 a2 = (f32x4){0.f, 0.f, 0.f, 0.f};
            float qn = 0.f;
#pragma unroll
            for (int ks = 0; ks < 8; ++ks) {
                const bf16x8 X = lds8(Cb + fr * 264 + 32 * ks + 8 * fq);
                a2 = mfma16(X, qf[ks], a2);
                const f32x4 n0 = *(const LAS f32x4*)(nvec + 32 * ks + 8 * fq), n1 = *(const LAS f32x4*)(nvec + 32 * ks + 8 * fq + 4);
#pragma unroll
                for (int jj = 0; jj < 4; ++jj) qn += bfs(qf[ks][jj]) * n0[jj] + bfs(qf[ks][4 + jj]) * n1[jj];
            }
            qn = xsum4(qn);
            const float wi = __expf(m - Mt_t);
            const float den = rsum + wi * qn;
            const float dn = fmaxf(fabsf(den), __expf(-(sb[t] + Mt_t)));
            const float inv = 1.0f / dn;
            f32x4 o; for (int j = 0; j < 4; ++j) o[j] = (a1[j] + wi * a2[j]) * inv;
            *(f32x4*)(HT + (size_t)(T0 + t) * 1024 + h * 256 + es * 16 + 4 * fq) = o;
        }
        {
            const float wprev = __expf(m - MtL);
            Cacc[0] *= wprev; Cacc[1] *= wprev; Nacc[0] *= wprev; Nacc[1] *= wprev;
#pragma unroll
            for (int kk = 0; kk < 4; ++kk) {
                const bf16x8 X = lds8(VTW + fr * 136 + 32 * kk + 8 * fq);
                const f32x4 w0 = *(const LAS f32x4*)(sws + 32 * kk + 8 * fq), w1 = *(const LAS f32x4*)(sws + 32 * kk + 8 * fq + 4);
                const bf16x8 XWf = mk8(w0[0], w0[1], w0[2], w0[3], w1[0], w1[1], w1[2], w1[3]);
                const bf16x8 XW = (fr == 0) ? XWf : (bf16x8){0, 0, 0, 0, 0, 0, 0, 0};
#pragma unroll
                for (int dt = 0; dt < 2; ++dt) {
                    const int dcol = 16 * (2 * wave + dt) + fr;
                    const LAS bf16_t* yp = Ks + (32 * kk + 8 * fq + (fr >> 2)) * 264 + 16 * (2 * wave + dt) + 4 * (fr & 3);
                    const s16x4 ylo = lds_tr4(yp), yhi = lds_tr4(yp + 4 * 264);
                    const bf16x8 Y = {ylo[0], ylo[1], ylo[2], ylo[3], yhi[0], yhi[1], yhi[2], yhi[3]};
                    Cacc[dt] = mfma16(X, Y, Cacc[dt]);
                    Nacc[dt] = mfma16(XW, Y, Nacc[dt]);
                }
            }
#pragma unroll
            for (int dt = 0; dt < 2; ++dt) {
                const int dcol = 16 * (2 * wave + dt) + fr;
#pragma unroll
                for (int j = 0; j < 4; ++j) CbN[(4 * fq + j) * 264 + dcol] = (bf16_t)f2bf(Cacc[dt][j]);
                if (fq == 0) nvecN[dcol] = Nacc[dt][0];
            }
            m = sb[127] + MtL;
        }
        if (wave == 0 && c < 31)
            mlstm_scalars((LAS float*)(lds + ML_A + (par ^ 1) * ML_SC2), (LAS float*)(lds + ML_MT + (par ^ 1) * ML_SC2), (LAS float*)(lds + ML_B + (par ^ 1) * ML_SC2), pf0, pf1, pi0, pi1, m, lane);
        __syncthreads();
    }
#undef ML_FETCH
}
__device__ __forceinline__ void phase_mlstm(const Params& P, LAS unsigned char* lds) {
    for (int it = blockIdx.x; it < 256; it += gridDim.x) { mlstm_item(P, lds, it); __syncthreads(); }
}

__device__ __forceinline__ void phase_htnorm(const Params& P) {
    const int wave = otid() >> 6, lane = otid() & 63;
    const float* HT = (const float*)(P.ws + OFF_AUX2); const bf16_t* BIG = (const bf16_t*)(P.ws + OFF_BIG); bf16_t* ABUF = (bf16_t*)(P.ws + OFF_ABUF);
    const float* mn = P.in[12];
    for (int row = blockIdx.x * 8 + wave; row < MTOK; row += gridDim.x * 8) {
        float4 vv[4], gg[4]; u32x2 ov[4];
#pragma unroll
        for (int h = 0; h < 4; ++h) { gg[h] = *(const float4*)(mn + h * 256 + 4 * lane); vv[h] = *(const float4*)(HT + (size_t)row * 1024 + h * 256 + 4 * lane); ov[h] = *(const u32x2*)(BIG + (size_t)row * 6144 + 5120 + h * 256 + 4 * lane); }
#pragma unroll
        for (int h = 0; h < 4; ++h) {
            const float4 v = vv[h];
            float ss = v.x * v.x + v.y * v.y + v.z * v.z + v.w * v.w;
            ss = wave_sum(ss);
            const float r = rsqrtf(ss * (1.0f / 256.0f) + EPSN);
            const float4 g = gg[h];
            const u32x2 oo = ov[h];
            u32x2 o = {pack2(sigm(bflo(oo.x)) * v.x * r * g.x, sigm(bfhi(oo.x)) * v.y * r * g.y), pack2(sigm(bflo(oo.y)) * v.z * r * g.z, sigm(bfhi(oo.y)) * v.w * r * g.w)};
            *(u32x2*)(ABUF + (size_t)row * 2048 + 1024 + h * 256 + 4 * lane) = o;
        }
    }
}


__device__ __forceinline__ int kv_col(int br, int kv, int g) { return 2048 + ((br * 2 + kv) * 4 + g) * 128; }

__device__ __forceinline__ void vt_wave_item(const Params& P, int item, int lane) {
    const bf16_t* BIG = (const bf16_t*)(P.ws + OFF_BIG); bf16_t* VTG = (bf16_t*)(P.ws + OFF_KT);
    const int tgp = item >> 4, cgp = item & 15;
    const int brm = cgp >> 3, g = (cgp >> 1) & 3, half = cgp & 1;
    const int tg = lane & 7, cg = lane >> 3;
    const int tok0 = tgp * 64 + 8 * tg, b = tok0 >> 12, pos0 = tok0 & 4095;
    const int col = kv_col(brm + 1, 1, g) + half * 64 + 8 * cg;
    bf16x8 x[8];
#pragma unroll
    for (int i = 0; i < 8; ++i) x[i] = ld8(BIG + (size_t)(tok0 + i) * 5120 + col);
    const size_t rb = (size_t)(((b * 2 + brm) * 4 + g) * 128 + half * 64 + 8 * cg);
#pragma unroll
    for (int j = 0; j < 8; ++j) {
        bf16x8 v; for (int i = 0; i < 8; ++i) v[i] = x[i][j];
        *(bf16x8*)(VTG + (rb + j) * 4096 + pos0) = v;
    }
}

__device__ __forceinline__ void cmp_item(const Params& P, LAS unsigned char* lds, int item) {
    const int tid = otid(), wave = tid >> 6, lane = tid & 63, fr = lane & 15, fq = lane >> 4;
    LAS float* pos = (LAS float*)lds;
    LAS bf16_t* H = (LAS bf16_t*)(lds + 16384);
    const bf16_t* BIG = (const bf16_t*)(P.ws + OFF_BIG);
    const int blk_ = item & 255, j_ = blk_ >> 3, grp_ = ((blk_ & 7) << 2) + ((item >> 8) << 1) + (j_ >> 4);
    const int rt = j_ & 15, g = grp_ & 3, b = (grp_ >> 2) & 3, kv = grp_ >> 4;
    const bf16_t* W1 = (const bf16_t*)(P.ws + OFF_WC1) + (size_t)kv * 128 * 4096;
    const bf16_t* W2 = (const bf16_t*)(P.ws + OFF_WC2) + (size_t)kv * 128 * 128;
    const float* pe = P.in[15] + (size_t)kv * 4096;
    for (int i = tid; i < 1024; i += 512) *(LAS f32x4*)(pos + 4 * i) = *(const f32x4*)(pe + 4 * i);
    __syncthreads();
    int cr = rt * 16 + fr; if (cr > 254) cr = 254;
    const bf16_t* ap = BIG + (size_t)(b * 4096 + 16 * cr) * 5120 + kv_col(0, kv, g) + 8 * fq;
    const bf16_t* wp = W1 + (size_t)(16 * wave + fr) * 4096 + 8 * fq;
    f32x4 acc = (f32x4){0.f, 0.f, 0.f, 0.f};
#pragma unroll 8
    for (int ks = 0; ks < 128; ++ks) {
        const int l = ks >> 2, d0 = (ks & 3) * 32;
        const bf16x8 xv = ld8(ap + (size_t)l * 5120 + d0);
        const f32x4 p0 = *(const LAS f32x4*)(pos + l * 128 + d0 + 8 * fq), p1 = *(const LAS f32x4*)(pos + l * 128 + d0 + 8 * fq + 4);
        const bf16x8 Y = mk8(bfs(xv[0]) + p0[0], bfs(xv[1]) + p0[1], bfs(xv[2]) + p0[2], bfs(xv[3]) + p0[3], bfs(xv[4]) + p1[0], bfs(xv[5]) + p1[1], bfs(xv[6]) + p1[2], bfs(xv[7]) + p1[3]);
        const bf16x8 X = ld8(wp + 32 * ks);
        acc = mfma16(X, Y, acc);
    }
    { u32x2 o = {pack2(gelu_t(acc[0]), gelu_t(acc[1])), pack2(gelu_t(acc[2]), gelu_t(acc[3]))}; *(LAS u32x2*)(H + fr * 136 + 16 * wave + 4 * fq) = o; }
    __syncthreads();
    f32x4 a2 = (f32x4){0.f, 0.f, 0.f, 0.f};
    if (kv == 0) {
#pragma unroll
        for (int ks = 0; ks < 4; ++ks) { const bf16x8 X = ld8(W2 + (size_t)(16 * wave + fr) * 128 + 32 * ks + 8 * fq), Y = lds8(H + fr * 136 + 32 * ks + 8 * fq); a2 = mfma16(X, Y, a2); }
        bf16_t* KC = (bf16_t*)(P.ws + OFF_KCMP);
        u32x2 o = {pack2(a2[0], a2[1]), pack2(a2[2], a2[3])};
        *(u32x2*)(KC + (size_t)((b * 4 + g) * 256 + rt * 16 + fr) * 128 + 16 * wave + 4 * fq) = o;
    } else {
#pragma unroll
        for (int ks = 0; ks < 4; ++ks) { const bf16x8 Y = ld8(W2 + (size_t)(16 * wave + fr) * 128 + 32 * ks + 8 * fq), X = lds8(H + fr * 136 + 32 * ks + 8 * fq); a2 = mfma16(X, Y, a2); }
        bf16_t* VC = (bf16_t*)(P.ws + OFF_VCMPT);
        u32x2 o = {pack2(a2[0], a2[1]), pack2(a2[2], a2[3])};
        *(u32x2*)(VC + (size_t)((b * 4 + g) * 128 + 16 * wave + fr) * 256 + rt * 16 + 4 * fq) = o;
    }
    __syncthreads();
}
__device__ __forceinline__ void phase_compress(const Params& P, LAS unsigned char* lds) {
    for (int it = blockIdx.x; it < 512; it += gridDim.x) cmp_item(P, lds, it);
    const int wave = otid() >> 6, lane = otid() & 63;
    for (int it = blockIdx.x * 8 + wave; it < 4096; it += gridDim.x * 8) vt_wave_item(P, it, lane);
}

constexpr int AT_KB = 0, AT_VT = 17408, AT_PS = 35840, AT_IMP = 72704, AT_SEL = 138240;
struct KVRegs { bf16x8 k[2], v[2]; };
__device__ __forceinline__ void at_fetch(KVRegs& R, const bf16_t* ksrc, size_t kpitch, const bf16_t* vsrc, size_t vpitch, int tid, bool wantv) {
#pragma unroll
    for (int i = 0; i < 2; ++i) {
        const int p = tid + 512 * i;
        R.k[i] = ld8(ksrc + (size_t)(p >> 4) * kpitch + 8 * (p & 15));
        if (wantv) R.v[i] = ld8(vsrc + (size_t)(p >> 3) * vpitch + 8 * (p & 7));
    }
}
__device__ __forceinline__ void at_stage(LAS unsigned char* lds, const KVRegs& R, int tid, bool wantv, int bofs = 0) {
    LAS bf16_t* Kb = (LAS bf16_t*)(lds + bofs + AT_KB); LAS bf16_t* Vb = (LAS bf16_t*)(lds + bofs + AT_VT);
#pragma unroll
    for (int i = 0; i < 2; ++i) {
        const int p = tid + 512 * i;
        *(LAS bf16x8*)(Kb + (p >> 4) * 136 + 8 * (p & 15)) = R.k[i];
        if (wantv) {
            const int c8 = p & 7, cc = c8 & 3, base = (p >> 3) * 72 + 32 * (c8 >> 2) + 16 * (cc & 1) + 4 * (cc >> 1);
            const u32x4 vv = __builtin_bit_cast(u32x4, R.v[i]);
            *(LAS u32x2*)(Vb + base) = (u32x2){vv[0], vv[1]};
            *(LAS u32x2*)(Vb + base + 8) = (u32x2){vv[2], vv[3]};
        }
    }
}
__device__ __forceinline__ void at_scores2(LAS unsigned char* lds, const bf16x8 (&qf)[2][4], f32x4 (&sc)[2][4], int fr, int fq, int bofs = 0) {
    const LAS bf16_t* Kb = (const LAS bf16_t*)(lds + bofs + AT_KB);
#pragma unroll
    for (int kt = 0; kt < 4; ++kt) {
        f32x4 a0 = (f32x4){0.f, 0.f, 0.f, 0.f}, a1 = (f32x4){0.f, 0.f, 0.f, 0.f};
#pragma unroll
        for (int ks = 0; ks < 4; ++ks) { const bf16x8 X = lds8(Kb + (16 * kt + fr) * 136 + 32 * ks + 8 * fq); a0 = mfma16(X, qf[0][ks], a0); a1 = mfma16(X, qf[1][ks], a1); }
        sc[0][kt] = a0; sc[1][kt] = a1;
    }
}
__device__ __forceinline__ void at_pv2(LAS unsigned char* lds, const f32x4 (&p)[2][4], f32x4 (&o)[2][8], int wave, int fr, int fq, int bofs = 0) {
    const LAS bf16_t* Vb = (const LAS bf16_t*)(lds + bofs + AT_VT);
#pragma unroll
    for (int kk = 0; kk < 2; ++kk) {
        const bf16x8 Y0 = mk8(p[0][2 * kk][0], p[0][2 * kk][1], p[0][2 * kk][2], p[0][2 * kk][3], p[0][2 * kk + 1][0], p[0][2 * kk + 1][1], p[0][2 * kk + 1][2], p[0][2 * kk + 1][3]);
        const bf16x8 Y1 = mk8(p[1][2 * kk][0], p[1][2 * kk][1], p[1][2 * kk][2], p[1][2 * kk][3], p[1][2 * kk + 1][0], p[1][2 * kk + 1][1], p[1][2 * kk + 1][2], p[1][2 * kk + 1][3]);
#pragma unroll
        for (int dt = 0; dt < 8; ++dt) { const bf16x8 X = lds8(Vb + (16 * dt + fr) * 72 + 32 * kk + 8 * fq); o[0][dt] = mfma16(X, Y0, o[0][dt]); o[1][dt] = mfma16(X, Y1, o[1][dt]); }
    }
}
__device__ __forceinline__ void at_online2(LAS unsigned char* lds, const bf16x8 (&qf)[2][4], float (&mrun)[2], float (&lrun)[2], f32x4 (&o)[2][8], const int (&lo)[2], const int (&hi)[2], const bool (&rowok)[2], bool fullvis, int wave, int fr, int fq, int bofs) {
    f32x4 sc[2][4];
    at_scores2(lds, qf, sc, fr, fq, bofs);
    float bm[2];
#pragma unroll
    for (int rt = 0; rt < 2; ++rt) {
        if (!fullvis) {
            const bool mok = hi[rt] >= lo[rt];
            const int moff = mok ? -lo[rt] : -100000; const unsigned mspan = mok ? (unsigned)(hi[rt] - lo[rt]) : 0u;
#pragma unroll
            for (int kt = 0; kt < 4; ++kt)
#pragma unroll
                for (int j = 0; j < 4; ++j) sc[rt][kt][j] = ((unsigned)(16 * kt + j + moff) <= mspan) ? sc[rt][kt][j] : -3.0e38f;
        }
        float b = -3.0e38f;
#pragma unroll
        for (int kt = 0; kt < 4; ++kt)
#pragma unroll
            for (int j = 0; j < 4; ++j) b = fmaxf(b, sc[rt][kt][j]);
        bm[rt] = b;
    }
    if (__any((bm[0] > mrun[0] + 6.0f) || (bm[1] > mrun[1] + 6.0f))) {
#pragma unroll
        for (int rt = 0; rt < 2; ++rt) {
            const float mnew = fmaxf(mrun[rt], xmax4(bm[rt])), mns = (mnew < -1.0e37f) ? 0.f : mnew;
            const float alpha = __builtin_amdgcn_exp2f(mrun[rt] - mns);
            lrun[rt] *= alpha; mrun[rt] = mnew;
#pragma unroll
            for (int dt = 0; dt < 8; ++dt) o[rt][dt] *= alpha;
        }
    }
#pragma unroll
    for (int rt = 0; rt < 2; ++rt) {
        const float mns = (mrun[rt] < -1.0e37f) ? 0.f : mrun[rt];
        const float mex = (fullvis && !rowok[rt]) ? 3.0e38f : mns;
        float ps = 0.f;
#pragma unroll
        for (int kt = 0; kt < 4; ++kt)
#pragma unroll
            for (int j = 0; j < 4; ++j) { const float e = __builtin_amdgcn_exp2f(sc[rt][kt][j] - mex); sc[rt][kt][j] = e; ps += e; }
        lrun[rt] += ps;
    }
    at_pv2(lds, sc, o, wave, fr, fq, bofs);
}

template <bool FIRST>
__device__ __forceinline__ void y_accum(bf16_t* yp0, bf16_t* yp1, const f32x4 (&o)[2][8], float s0, float s1) {
    u32x2 p[2][8];
    if (!FIRST) {
#pragma unroll
        for (int dt = 0; dt < 8; ++dt) { p[0][dt] = *(const u32x2*)(yp0 + 16 * dt); p[1][dt] = *(const u32x2*)(yp1 + 16 * dt); }
    }
#pragma unroll
    for (int rt = 0; rt < 2; ++rt) {
        bf16_t* yp = rt ? yp1 : yp0; const float scale = rt ? s1 : s0;
#pragma unroll
        for (int dt = 0; dt < 8; ++dt) {
            float a0 = o[rt][dt][0] * scale, a1 = o[rt][dt][1] * scale, a2 = o[rt][dt][2] * scale, a3 = o[rt][dt][3] * scale;
            if (!FIRST) { a0 += bflo(p[rt][dt].x); a1 += bfhi(p[rt][dt].x); a2 += bflo(p[rt][dt].y); a3 += bfhi(p[rt][dt].y); }
            u32x2 v = {pack2(a0, a1), pack2(a2, a3)};
            *(u32x2*)(yp + 16 * dt) = v;
        }
    }
}

__device__ __forceinline__ void attn_item(const Params& P, LAS unsigned char* lds, int item) {
    const int tid = otid(), wave = tid >> 6, lane = tid & 63, fr = lane & 15, fq = lane >> 4;
    const bf16_t* BIG = (const bf16_t*)(P.ws + OFF_BIG); const bf16_t* VTG = (const bf16_t*)(P.ws + OFF_KT);
    const bf16_t* KC = (const bf16_t*)(P.ws + OFF_KCMP); const bf16_t* VC = (const bf16_t*)(P.ws + OFF_VCMPT);
    const float* GT = (const float*)(P.ws + OFF_GATES); bf16_t* Y = (bf16_t*)(P.ws + OFF_ABUF);
    LAS float* impW = (LAS float*)(lds + AT_IMP);
    LAS unsigned* selw = (LAS unsigned*)(lds + AT_SEL);
    const int kk_ = item >> 8, blk_ = item & 255, j_ = blk_ >> 3;
    const int qt = (kk_ & 1) ? 63 - j_ : j_, pair_ = ((blk_ & 7) << 1) + (kk_ >> 1), g = pair_ & 3, b = pair_ >> 2;
    const int t0 = qt * 64, tokb = b * 4096;
    const int head = g * 4 + (wave >> 1), qoff = 32 * (wave & 1);
    const int cur = qt;
    int pos[2]; pos[0] = t0 + qoff + fr; pos[1] = pos[0] + 16;
    bf16x8 qf[2][4];
#pragma unroll
    for (int rt = 0; rt < 2; ++rt)
#pragma unroll
        for (int ks = 0; ks < 4; ++ks) qf[rt][ks] = ld8(BIG + (size_t)(tokb + pos[rt]) * 5120 + head * 128 + 32 * ks + 8 * fq);
    KVRegs R;
    const bf16_t* kc0 = KC + (size_t)((b * 4 + g) * 256) * 128;
    const bf16_t* vc0 = VC + (size_t)((b * 4 + g) * 128) * 256;
    {
        int cmaxq[2]; cmaxq[0] = (pos[0] - 31) >> 4; cmaxq[1] = (pos[1] - 31) >> 4;
        float mx[2] = {-3.0e38f, -3.0e38f}, sum[2] = {0.f, 0.f};
        const int nblk = min(4, ((4 * qt + 2) >> 6) + 1);
        at_fetch(R, kc0, 128, vc0, 256, tid, false);
#pragma unroll 1
        for (int blk = 0; blk < nblk; ++blk) {
            __syncthreads();
            at_stage(lds, R, tid, false);
            __syncthreads();
            if (blk + 1 < nblk) at_fetch(R, kc0 + (size_t)(blk + 1) * 64 * 128, 128, vc0, 256, tid, false);
            else at_fetch(R, kc0, 128, vc0, 256, tid, true);
            f32x4 s4[2][4]; at_scores2(lds, qf, s4, fr, fq);
#pragma unroll
            for (int rt = 0; rt < 2; ++rt) {
                const int lim = cmaxq[rt] - 64 * blk - 4 * fq;
                float bm = -3.0e38f;
#pragma unroll
                for (int kt = 0; kt < 4; ++kt)
#pragma unroll
                    for (int j = 0; j < 4; ++j) { const float s = (16 * kt + j <= lim) ? s4[rt][kt][j] : -3.0e38f; s4[rt][kt][j] = s; bm = fmaxf(bm, s); }
                bm = xmax4(bm);
                const float mnew = fmaxf(mx[rt], bm), mns = (mnew < -1.0e37f) ? 0.f : mnew;
                float ps = 0.f;
#pragma unroll
                for (int kt = 0; kt < 4; ++kt)
#pragma unroll
                    for (int j = 0; j < 4; ++j) ps += __builtin_amdgcn_exp2f(s4[rt][kt][j] - mns);
                sum[rt] = sum[rt] * __builtin_amdgcn_exp2f(mx[rt] - mns) + ps; mx[rt] = mnew;
            }
        }
        float inv[2], mxs[2];
#pragma unroll
        for (int rt = 0; rt < 2; ++rt) {
            const float s = xsum4(sum[rt]);
            inv[rt] = s > 0.f ? 1.0f / s : 0.f; mxs[rt] = (mx[rt] < -1.0e37f) ? 0.f : mx[rt];
        }
        f32x4 oc[2][8];
#pragma unroll
        for (int rt = 0; rt < 2; ++rt)
#pragma unroll
            for (int dt = 0; dt < 8; ++dt) oc[rt][dt] = (f32x4){0.f, 0.f, 0.f, 0.f};
        float eprev[2] = {0.f, 0.f};
        if (nblk < 4) {
            for (int r = 0; r < 32; ++r) { const int J = 16 * nblk + lane; if (J < 64) impW[(wave * 32 + r) * 64 + J] = 0.f; }
        }
#pragma unroll 1
        for (int blk = 0; blk < nblk; ++blk) {
            __syncthreads();
            at_stage(lds, R, tid, true);
            __syncthreads();
            if (blk + 1 < nblk) at_fetch(R, kc0 + (size_t)(blk + 1) * 64 * 128, 128, vc0 + (blk + 1) * 64, 256, tid, true);
            f32x4 s4[2][4]; at_scores2(lds, qf, s4, fr, fq);
#pragma unroll
            for (int rt = 0; rt < 2; ++rt) {
                const int lim = cmaxq[rt] - 64 * blk - 4 * fq;
#pragma unroll
                for (int kt = 0; kt < 4; ++kt) {
#pragma unroll
                    for (int j = 0; j < 4; ++j) s4[rt][kt][j] = (16 * kt + j <= lim) ? __builtin_amdgcn_exp2f(s4[rt][kt][j] - mxs[rt]) * inv[rt] : 0.f;
                    const float a = s4[rt][kt][0] + s4[rt][kt][1] + s4[rt][kt][2] + s4[rt][kt][3], e = 0.5f * s4[rt][kt][3];
                    const float src = (fq == 3) ? eprev[rt] : e;
                    const float got = __shfl(src, (lane + 48) & 63);
                    impW[(wave * 32 + 16 * rt + fr) * 64 + 16 * blk + 4 * kt + fq] = a - e + got;
                    eprev[rt] = e;
                }
            }
            at_pv2(lds, s4, oc, wave, fr, fq);
        }
        y_accum<true>(Y + (size_t)(tokb + pos[0]) * 2048 + head * 128 + 4 * fq, Y + (size_t)(tokb + pos[1]) * 2048 + head * 128 + 4 * fq, oc,
                      GT[(size_t)(tokb + pos[0]) * 48 + 0 * 16 + head], GT[(size_t)(tokb + pos[1]) * 48 + 0 * 16 + head]);
    }
    __syncthreads();
    {
#pragma unroll 1
        for (int i = 0; i < 8; ++i) {
            const int q = 8 * wave + i;
            float v = 0.f;
#pragma unroll
            for (int r = 0; r < 4; ++r) v += impW[((2 * r + (q >> 5)) * 32 + (q & 31)) * 64 + lane];
            const int J = lane;
            if (J == 0 || J == cur || J == cur - 1) v = 1.0e9f; else if (J > cur) v = -1.0e9f;
            int rank = 0;
            for (int o = 0; o < 64; ++o) { const float vo = __shfl(v, o); rank += (vo > v || (vo == v && o < J)) ? 1 : 0; }
            const unsigned long long mask = __ballot((rank < 16) && (J <= cur));
            if (lane == 0) { selw[2 * q] = (unsigned)mask; selw[2 * q + 1] = (unsigned)(mask >> 32); }
        }
    }
    __syncthreads();
    unsigned long long un = 0ull;
#pragma unroll 1
    for (int q = 0; q < 64; ++q) un |= ((unsigned long long)selw[2 * q + 1] << 32) | selw[2 * q];
    {
        unsigned long long mysel[2];
#pragma unroll
        for (int rt = 0; rt < 2; ++rt) mysel[rt] = ((unsigned long long)selw[2 * (qoff + 16 * rt + fr) + 1] << 32) | selw[2 * (qoff + 16 * rt + fr)];
        float mrun[2] = {-3.0e38f, -3.0e38f}, lrun[2] = {0.f, 0.f};
        f32x4 o[2][8];
#pragma unroll
        for (int rt = 0; rt < 2; ++rt)
#pragma unroll
            for (int dt = 0; dt < 8; ++dt) o[rt][dt] = (f32x4){0.f, 0.f, 0.f, 0.f};
        const bf16_t* kb = BIG + (size_t)tokb * 5120 + kv_col(1, 0, g);
        const bf16_t* vb = VTG + (size_t)(((b * 2 + 0) * 4 + g) * 128) * 4096;
        unsigned long long rem = un;
        int jb = __builtin_ctzll(rem); rem &= rem - 1;
        at_fetch(R, kb + (size_t)jb * 64 * 5120, 5120, vb + jb * 64, 4096, tid, true);
        __syncthreads();
        at_stage(lds, R, tid, true, 0);
        int jn = rem ? (int)__builtin_ctzll(rem) : -1;
        if (jn >= 0) at_fetch(R, kb + (size_t)jn * 64 * 5120, 5120, vb + jn * 64, 4096, tid, true);
        __syncthreads();
        int cb = 0;
#pragma unroll 1
        for (;;) {
            int jn2 = -1;
            if (jn >= 0) {
                at_stage(lds, R, tid, true, cb ? 0 : AT_IMP);
                rem &= rem - 1; jn2 = rem ? (int)__builtin_ctzll(rem) : -1;
                if (jn2 >= 0) at_fetch(R, kb + (size_t)jn2 * 64 * 5120, 5120, vb + jn2 * 64, 4096, tid, true);
            }
            int lo[2], hi[2]; bool rowok[2];
#pragma unroll
            for (int rt = 0; rt < 2; ++rt) { rowok[rt] = (mysel[rt] >> jb) & 1ull; lo[rt] = rowok[rt] ? 0 : 1000; hi[rt] = pos[rt] - 64 * jb - 4 * fq; }
            at_online2(lds, qf, mrun, lrun, o, lo, hi, rowok, jb < cur, wave, fr, fq, cb ? AT_IMP : 0);
            __syncthreads();
            if (jn < 0) break;
            jb = jn; jn = jn2; cb ^= 1;
        }
        {
            const float g0 = GT[(size_t)(tokb + pos[0]) * 48 + 1 * 16 + head], g1 = GT[(size_t)(tokb + pos[1]) * 48 + 1 * 16 + head];
            const float l0 = xsum4(lrun[0]), l1 = xsum4(lrun[1]);
            y_accum<false>(Y + (size_t)(tokb + pos[0]) * 2048 + head * 128 + 4 * fq, Y + (size_t)(tokb + pos[1]) * 2048 + head * 128 + 4 * fq, o,
                           l0 > 0.f ? g0 / l0 : 0.f, l1 > 0.f ? g1 / l1 : 0.f);
        }
    }
    {
        float mrun[2] = {-3.0e38f, -3.0e38f}, lrun[2] = {0.f, 0.f};
        f32x4 o[2][8];
#pragma unroll
        for (int rt = 0; rt < 2; ++rt)
#pragma unroll
            for (int dt = 0; dt < 8; ++dt) o[rt][dt] = (f32x4){0.f, 0.f, 0.f, 0.f};
        const bf16_t* kb = BIG + (size_t)tokb * 5120 + kv_col(2, 0, g);
        const bf16_t* vb = VTG + (size_t)(((b * 2 + 1) * 4 + g) * 128) * 4096;
        const int lo0 = t0 - 511, jlo = lo0 < 0 ? 0 : (lo0 >> 6);
        at_fetch(R, kb + (size_t)jlo * 64 * 5120, 5120, vb + jlo * 64, 4096, tid, true);
        at_stage(lds, R, tid, true, 0);
        if (jlo < cur) at_fetch(R, kb + (size_t)(jlo + 1) * 64 * 5120, 5120, vb + (jlo + 1) * 64, 4096, tid, true);
        __syncthreads();
        int cb = 0;
#pragma unroll 1
        for (int jb = jlo; jb <= cur; ++jb) {
            if (jb < cur) {
                at_stage(lds, R, tid, true, cb ? 0 : AT_IMP);
                if (jb + 1 < cur) at_fetch(R, kb + (size_t)(jb + 2) * 64 * 5120, 5120, vb + (jb + 2) * 64, 4096, tid, true);
            }
            int lo[2], hi[2]; bool rowok[2] = {true, true};
#pragma unroll
            for (int rt = 0; rt < 2; ++rt) { hi[rt] = pos[rt] - 64 * jb - 4 * fq; lo[rt] = hi[rt] - 511; }
            at_online2(lds, qf, mrun, lrun, o, lo, hi, rowok, (jb < cur) && (jb >= cur - 7), wave, fr, fq, cb ? AT_IMP : 0);
            __syncthreads();
            cb ^= 1;
        }
        {
            const float g0 = GT[(size_t)(tokb + pos[0]) * 48 + 2 * 16 + head], g1 = GT[(size_t)(tokb + pos[1]) * 48 + 2 * 16 + head];
            const float l0 = xsum4(lrun[0]), l1 = xsum4(lrun[1]);
            y_accum<false>(Y + (size_t)(tokb + pos[0]) * 2048 + head * 128 + 4 * fq, Y + (size_t)(tokb + pos[1]) * 2048 + head * 128 + 4 * fq, o,
                           l0 > 0.f ? g0 / l0 : 0.f, l1 > 0.f ? g1 / l1 : 0.f);
        }
    }
    __syncthreads();
}
__device__ __forceinline__ void phase_attn(const Params& P, LAS unsigned char* lds) {
    for (int it = blockIdx.x; it < 1024; it += gridDim.x) attn_item(P, lds, it);
}


#ifndef FBAR_SLEEP
#define FBAR_SLEEP 127
#endif
#ifndef FBAR_SLEEP2
#define FBAR_SLEEP2 0
#endif
constexpr int N_PHASES = 25;
constexpr int LDS_BYTES = 139264;

template <class Epi>
__device__ __forceinline__ void run_gemm(LAS unsigned char* lds, const bf16_t* A, const bf16_t* Bt, int N, int K, const Epi& E) {
    pg8::Gemm g{A, Bt, MTOK, N, K};
    pg8::StaticOrder S; S.init(MTOK, N, (int)gridDim.x, (int)blockIdx.x);
    pg8::gemm_phase<Epi, pg8::StaticOrder, false>((PG8_LAS unsigned char*)lds, g, S, E, nullptr);
}

__device__ __forceinline__ unsigned xbar_setup(unsigned char* ws) {
    const unsigned* slot = (const unsigned*)(ws + OFF_XB);
    const int lane = threadIdx.x & 63;
    const unsigned mine = __hip_atomic_load(slot + blockIdx.x, __ATOMIC_RELAXED, __HIP_MEMORY_SCOPE_AGENT) & 0xFu;
    unsigned nx = 0, seen = 0;
    for (unsigned i = lane; i < gridDim.x; i += 64) { const unsigned x = __hip_atomic_load(slot + i, __ATOMIC_RELAXED, __HIP_MEMORY_SCOPE_AGENT) & 0xFu; nx += (x == mine) ? 1u : 0u; seen |= 1u << x; }
#pragma unroll
    for (int o = 32; o; o >>= 1) { nx += __shfl_xor(nx, o); seen |= __shfl_xor(seen, o); }
    return mine | (nx << 4) | ((unsigned)__builtin_popcount(seen) << 16);
}
__device__ __forceinline__ void xbar_sync(unsigned char* ws, LAS unsigned char* lds, unsigned k) {
    __syncthreads();
    if (threadIdx.x == 0) {
        const unsigned info = *(const LAS unsigned*)(lds + 139008);
        unsigned* sub = (unsigned*)(ws + OFF_XB + 1024 + 256 * (info & 0xFu)); unsigned* top = (unsigned*)(ws + OFF_XB + 1024 + 256 * 16);
        const unsigned nx = (info >> 4) & 0xFFFu, nxcc = info >> 16;
        const unsigned old = __hip_atomic_fetch_add(sub, 1u, __ATOMIC_RELAXED, __HIP_MEMORY_SCOPE_AGENT);
        if (old + 1u == nx * k) {
            __builtin_amdgcn_fence(__ATOMIC_RELEASE, "agent");
            asm volatile("s_waitcnt vmcnt(0)" ::: "memory");
            __hip_atomic_fetch_add(top, 1u, __ATOMIC_RELAXED, __HIP_MEMORY_SCOPE_AGENT);
        }
        const unsigned want = nxcc * k;
        unsigned spins = 0;
        while (__hip_atomic_load(top, __ATOMIC_RELAXED, __HIP_MEMORY_SCOPE_AGENT) < want && ++spins < (1u << 21)) __builtin_amdgcn_s_sleep(FBAR_SLEEP);
        __builtin_amdgcn_fence(__ATOMIC_ACQUIRE, "agent");
        asm volatile("s_waitcnt vmcnt(0)" ::: "memory");
    }
    __syncthreads();
}

__device__ __forceinline__ int stage_rstd(LAS unsigned char* lds, const float* SS, int N) {
    pg8::StaticOrder S; S.init(MTOK, N, (int)gridDim.x, (int)blockIdx.x);
    Unit u0; if (!S.next(0, u0)) u0.pm = 0;
    LAS float* l = (LAS float*)(lds + 131072);
    const int tid = otid();
    if (tid < 256) l[tid] = rsqrtf(SS[u0.pm * 256 + tid] * (1.0f / 2048.0f) + EPSN);
    __syncthreads();
    return u0.pm;
}

__global__ void __launch_bounds__(512, 2) mega(Params P) {
    extern __shared__ __attribute__((aligned(16))) unsigned char shm[];
    LAS unsigned char* lds = (LAS unsigned char*)shm;
    cg::grid_group grid = cg::this_grid();
    unsigned char* ws = P.ws;
    bf16_t* ABUF = (bf16_t*)(ws + OFF_ABUF); bf16_t* BIG = (bf16_t*)(ws + OFF_BIG);
    float* H = P.out;
    unsigned xk = 0;
    for (int ph = P.ph_lo; ph < P.ph_hi; ++ph) {
        int f = -1, sub = -1;
        if (ph >= 1 && ph <= 3) { f = 0; sub = ph - 1; }
        else if (ph >= 10 && ph <= 12) { f = 1; sub = ph - 10; }
        else if (ph >= 13 && ph <= 15) { f = 2; sub = ph - 13; }
        else if (ph >= 21 && ph <= 23) { f = 3; sub = ph - 21; }
        int reps = 1;
#ifdef PROBE_REPS
        if (ph == 0) reps += REP_PREP;
        if (ph == 7) reps += REP_ML;
        if (ph == 18 || ph == 19) reps += REP_AT;
        if (sub == 1 || ph == 5 || ph == 17) reps += REP_GEMM;
        if (ph == 6 || ph == 8) reps += REP_L0X;
#ifdef REP_DOWN3
        if (ph == 23) reps += REP_DOWN3;
#endif
#endif
        if (sub == 0 || ph == 4 || ph == 16) continue;
        float* SSQ = (float*)(ws + OFF_SS); bf16_t* AUX1B = (bf16_t*)(ws + OFF_AUX1);
        for (int rep = 0; rep < reps; ++rep) {
        if (rep) grid.sync();
        if (ph == 0) phase_prep(P, lds);
        else if (f >= 0) {
            if (sub == 1) {
                const int si = (f == 0) ? 0 : (f == 1) ? 2 : (f == 2) ? 3 : 5;
                const int pm0 = stage_rstd(lds, SSQ + (size_t)si * MTOK, 11264);
                EpiSwiGLU E{BIG, SSQ + (size_t)si * MTOK, (const LAS float*)(lds + 131072), pm0};
                run_gemm(lds, (f == 1 || f == 3) ? AUX1B : ABUF, (const bf16_t*)(ws + OFF_WGU + f * SZ_GU), 11264, 2048, E);
            } else {
                const int so = (f == 0) ? 1 : (f == 1) ? 3 : 4;
                if (f == 3) { EpiResid<false> E{H, H, nullptr, nullptr, 0.5f / (float)reps}; run_gemm(lds, BIG, (const bf16_t*)(ws + OFF_WDN + f * SZ_DN), 2048, 5632, E); }
                else { EpiResid<true> E{f == 0 ? P.in[0] : H, H, ABUF, SSQ + (size_t)so * MTOK, 0.5f}; run_gemm(lds, BIG, (const bf16_t*)(ws + OFF_WDN + f * SZ_DN), 2048, 5632, E); }
            }
        }
        else if (ph == 5) {
            phase_skinny<1, 0>(lds, ABUF, (const bf16_t*)(ws + OFF_WABIN) + (size_t)6144 * 2048, (float*)(ws + OFF_GATES), P.in[7], SSQ + (size_t)1 * MTOK);
            const int pm0 = stage_rstd(lds, SSQ + (size_t)1 * MTOK, 6144);
            EpiProj0 E{BIG, SSQ + (size_t)1 * MTOK, (const LAS float*)(lds + 131072), pm0}; run_gemm(lds, ABUF, (const bf16_t*)(ws + OFF_WABIN), 6144, 2048, E);
        }
        else if (ph == 6) phase_conv_gmlp(P, lds);
        else if (ph == 7) phase_mlstm(P, lds);
        else if (ph == 8) phase_htnorm(P);
        else if (ph == 9) { EpiResid<true> E{H, H, AUX1B, SSQ + (size_t)2 * MTOK, 1.0f}; run_gemm(lds, ABUF, (const bf16_t*)(ws + OFF_WABOUT), 2048, 2048, E); }
        else if (ph == 17) {
            phase_skinny<3, 1>(lds, ABUF, (const bf16_t*)(ws + OFF_WNSAIN) + (size_t)5120 * 2048, (float*)(ws + OFF_GATES), nullptr, SSQ + (size_t)4 * MTOK);
            const int pm0 = stage_rstd(lds, SSQ + (size_t)4 * MTOK, 5120);
            EpiProj1 E{BIG, (const float*)(ws + OFF_ROPE), SSQ + (size_t)4 * MTOK, (const LAS float*)(lds + 131072), pm0}; run_gemm(lds, ABUF, (const bf16_t*)(ws + OFF_WNSAIN), 5120, 2048, E);
        }
        else if (ph == 18) phase_compress(P, lds);
        else if (ph == 19) phase_attn(P, lds);
        else if (ph == 20) { EpiResid<true> E{H, H, AUX1B, SSQ + (size_t)5 * MTOK, 1.0f}; run_gemm(lds, ABUF, (const bf16_t*)(ws + OFF_WNSAOUT), 2048, 2048, E); }
        else if (ph == 24) phase_final_norm(H, P.in[19]);
        }
#ifdef FBAR_SLEEP
        if (ph + 1 < P.ph_hi) { if (ph == 0) { grid.sync(); if (threadIdx.x < 64) { const unsigned xi = xbar_setup(ws); if (threadIdx.x == 0) *(LAS unsigned*)(lds + 139008) = xi; } } else { ++xk; xbar_sync(ws, lds, xk); } }
#else
        if (ph + 1 < P.ph_hi) grid.sync();
#endif
#ifdef PROBE_SYNCS
        if (ph == 5) { for (int i = 0; i < PROBE_SYNCS; ++i) grid.sync(); }
#endif
    }
}

extern "C" void kernel_launch(void* const* d_in, const int* in_sizes, int n_in, void* d_out, int out_size, void* d_ws, size_t ws_size, hipStream_t stream) {
    static int grid = 0;
    if (grid == 0) {
        if (n_in != 20 || out_size != MTOK * DM || ws_size < WS_END) { fprintf(stderr, "kernel_launch: unexpected shapes (n_in %d out %d ws %zu need %zu)\n", n_in, out_size, ws_size, (size_t)WS_END); grid = -1; return; }
        int dev = 0, cus = 0, per_cu = 0;
        hipGetDevice(&dev);
        hipDeviceGetAttribute(&cus, hipDeviceAttributeMultiprocessorCount, dev);
        if (hipFuncSetAttribute((const void*)mega, hipFuncAttributeMaxDynamicSharedMemorySize, LDS_BYTES) != hipSuccess) { fprintf(stderr, "kernel_launch: hipFuncSetAttribute failed\n"); grid = -1; return; }
        if (hipOccupancyMaxActiveBlocksPerMultiprocessor(&per_cu, (const void*)mega, 512, LDS_BYTES) != hipSuccess || per_cu < 1) { fprintf(stderr, "kernel_launch: occupancy query says %d\n", per_cu); per_cu = 1; }
        (void)hipGetLastError();
        grid = cus * per_cu;
        if (grid > 256) grid = 256;
    }
    if (grid < 0) return;
    Params p{};
    for (int i = 0; i < 20; ++i) p.in[i] = (const float*)d_in[i];
    p.out = (float*)d_out; p.ws = (unsigned char*)d_ws;
#ifndef MULTI_LAUNCH
    p.ph_lo = 0; p.ph_hi = N_PHASES;
    void* args[] = {&p};
    hipError_t e = hipLaunchCooperativeKernel((const void*)mega, dim3(grid), dim3(512), args, LDS_BYTES, stream);
    if (e != hipSuccess) fprintf(stderr, "cooperative launch failed: %s (grid %d)\n", hipGetErrorString(e), grid);
#else
    for (int ph = 0; ph < N_PHASES; ++ph) {
        p.ph_lo = ph; p.ph_hi = ph + 1;
        void* args[] = {&p};
        hipError_t e = hipLaunchCooperativeKernel((const void*)mega, dim3(grid), dim3(512), args, LDS_BYTES, stream);
        if (e != hipSuccess) { fprintf(stderr, "launch %d failed: %s\n", ph, hipGetErrorString(e)); break; }
    }
#endif
}
```

```cpp
#define SKIP_ALPHA 1
#include <hip/hip_runtime.h>
#include <hip/hip_cooperative_groups.h>
#include <cstdio>
namespace cg = cooperative_groups;
namespace pg8 {
#define PG8_LAS __attribute__((address_space(3)))
typedef unsigned short bf16_t;
typedef short bf16x8 __attribute__((ext_vector_type(8)));
typedef float f32x4 __attribute__((ext_vector_type(4)));
typedef unsigned u32x4 __attribute__((ext_vector_type(4)));
constexpr int BM = 256, BK = 64, HALF = 128, HTB = HALF * BK * 2  , STAGE_BYTES = 8 * HTB, NXCD = 8, WGM = 8;

__host__ __device__ __forceinline__ int lds_byte(int r, int c) { const int st = (r >> 4) * 2 + (c >> 5), rr = r & 15, cc = c & 31, ob = rr * 64 + cc * 2; return st * 1024 + (ob ^ (((ob >> 9) & 1) << 5)); }
__host__ __device__ __forceinline__ void stage_rc(int b, int& R, int& C) { const int st = b / 1024, sb = b % 1024, swz = sb ^ (((sb >> 9) & 1) << 5); R = (st >> 1) * 16 + swz / 64; C = (st & 1) * 32 + (swz % 64) / 2; }
__host__ __device__ __forceinline__ int perm32(int rho) { const int n = rho >> 4, i = rho & 15; return 8 * (i >> 2) + 4 * n + (i & 3); }

struct Unit { int pm, pn; };
struct Gemm { const bf16_t* A; const bf16_t* Bt; int M, N, K; };

struct StaticOrder {
    int nM, nN, nwg, G, c;
    __host__ __device__ void init(int M, int N, int G_, int c_) { nM = M / BM; nN = N / BM; nwg = nM * nN; G = G_; c = c_; }
    __host__ __device__ bool next(int i, Unit& u) const {
        const long L = (long)i * G + c; if (L >= nwg) return false;
        int wgid = (int)L; { const int q = nwg / NXCD, r = nwg % NXCD, xcd = wgid % NXCD, off = wgid / NXCD; wgid = (xcd < r ? xcd * (q + 1) : r * (q + 1) + (xcd - r) * q) + off; }
        const int nig = WGM * nN, gid = wgid / nig, fm = gid * WGM, gsz = (nM - fm) < WGM ? (nM - fm) : WGM;
        u.pm = fm + ((wgid % nig) % gsz); u.pn = (wgid % nig) / gsz; return true;
    }
    __device__ __forceinline__ void a_ready(const Unit&) const {}
    __device__ __forceinline__ void done(const Unit&) const {}
};
template <class Epi, class Sched, bool STAMP = false>
__device__ __forceinline__ void gemm_phase(PG8_LAS unsigned char* lds, const Gemm g, const Sched& S, const Epi& E, unsigned long long* stamps) {
    int tid_ = threadIdx.x; asm volatile("" : "+v"(tid_)); const int tid = tid_, wid = __builtin_amdgcn_readfirstlane(tid >> 6), lane = tid & 63, wr = wid >> 2, wc = wid & 3, fr = lane & 15, fq = lane >> 4;
    const int K = g.K, nt = K / BK;
#define PG8_STAMP() do {} while (0)
    PG8_STAMP();
    unsigned voffA[2], voffB[2];
#pragma unroll
    for (int i = 0; i < 2; ++i) { int R, C; stage_rc(tid * 16 + i * 8192, R, C); const int Rb = Epi::PERM ? ((R & ~31) + perm32(R & 31)) : R;
        voffA[i] = (unsigned)(R * K + C) * 2u; voffB[i] = (unsigned)(Rb * K + C) * 2u; }
    const size_t kstep = (size_t)(BK * 2);
    const size_t hstep = (size_t)HALF * K * 2;
    const size_t tstep = 2 * hstep;
    const unsigned ldsw = (unsigned)wid * 1024u;
    const int aoff = lds_byte(wr * 64 + fr, fq * 8), boff = lds_byte(wc * 32 + fr, fq * 8);
#define PG8_SA(b, h) (((b) * 2 + (h)) * HTB)
#define PG8_SB(b, h) ((4 + (b) * 2 + (h)) * HTB)
#define PG8_STAGE(bufoff, gbase, voff) do { _Pragma("unroll") for (int _i = 0; _i < 2; ++_i) \
        __builtin_amdgcn_global_load_lds((const unsigned*)((const char*)(gbase) + (voff)[_i]), (PG8_LAS unsigned*)(lds + (bufoff) + ldsw + _i * 8192), 16, 0, 0); } while (0)
#define PG8_LDA(dst, b, h) do { _Pragma("unroll") for (int m = 0; m < 4; ++m) _Pragma("unroll") for (int k = 0; k < 2; ++k) dst[m][k] = *(const PG8_LAS bf16x8*)(lds + PG8_SA(b, h) + aoff + m * 2048 + k * 1024); } while (0)
#define PG8_LDB(dst, b, h) do { _Pragma("unroll") for (int n = 0; n < 2; ++n) _Pragma("unroll") for (int k = 0; k < 2; ++k) dst[n][k] = *(const PG8_LAS bf16x8*)(lds + PG8_SB(b, h) + boff + n * 2048 + k * 1024); } while (0)
#define PG8_MMA(ai, bj, At, Bt) do { __builtin_amdgcn_s_setprio(1); _Pragma("unroll") for (int m = 0; m < 4; ++m) _Pragma("unroll") for (int n = 0; n < 2; ++n) _Pragma("unroll") for (int k = 0; k < 2; ++k) \
        acc[ai][bj][m][n] = __builtin_amdgcn_mfma_f32_16x16x32_bf16(Bt[n][k], At[m][k], acc[ai][bj][m][n], 0, 0, 0); __builtin_amdgcn_s_setprio(0); } while (0)
#define PG8_WAIT_V(n) asm volatile("s_waitcnt vmcnt(" #n ")" ::: "memory")
#define PG8_WAIT_L(n) asm volatile("s_waitcnt lgkmcnt(" #n ")" ::: "memory")
#define PG8_BAR __builtin_amdgcn_s_barrier()
#define PG8_SCHED __builtin_amdgcn_sched_barrier(0)
    Unit cur, nxt; int ui = 0;
    if (!S.next(0, cur)) return;
    f32x4 acc[2][2][4][2];
#pragma unroll
    for (int a = 0; a < 2; ++a)
#pragma unroll
        for (int b = 0; b < 2; ++b)
#pragma unroll
            for (int m = 0; m < 4; ++m)
#pragma unroll
                for (int n = 0; n < 2; ++n) acc[a][b][m][n] = (f32x4){0.f, 0.f, 0.f, 0.f};
    bf16x8 At[4][2], B0[2][2], B1[2][2];
    const char* cA = (const char*)g.A + (size_t)cur.pm * tstep; const char* cB = (const char*)g.Bt + (size_t)cur.pn * tstep;
    S.a_ready(cur);
    typename Epi::Pre pre = E.pre(cur, wr, fr);
    PG8_STAGE(PG8_SB(0, 0), cB, voffB); PG8_STAGE(PG8_SA(0, 0), cA, voffA); PG8_STAGE(PG8_SB(0, 1), cB + hstep, voffB); PG8_STAGE(PG8_SA(0, 1), cA + hstep, voffA);
    if (wr == 1) PG8_BAR;
    PG8_WAIT_V(4); PG8_BAR;
    PG8_STAGE(PG8_SB(1, 0), cB + kstep, voffB); PG8_STAGE(PG8_SA(1, 0), cA + kstep, voffA); PG8_STAGE(PG8_SB(1, 1), cB + hstep + kstep, voffB);
    PG8_WAIT_V(6); PG8_BAR;
    PG8_STAMP();
    for (;;) {
        const bool has_next = S.next(ui + 1, nxt);
        const char* nA = has_next ? (const char*)g.A + (size_t)nxt.pm * tstep : cA; const char* nB = has_next ? (const char*)g.Bt + (size_t)nxt.pn * tstep : cB;
        for (int t = 0; t < nt; t += 2) {
            const bool last = (t == nt - 2);
            const char* a1 = cA + (size_t)(t + 1) * kstep;
            const char* a2 = last ? nA : cA + (size_t)(t + 2) * kstep; const char* b2 = last ? nB : cB + (size_t)(t + 2) * kstep;
            const char* a3 = a2 + kstep; const char* b3 = b2 + kstep;
            if (last && has_next) S.a_ready(nxt);
            PG8_LDB(B0, 0, 0); PG8_SCHED; PG8_LDA(At, 0, 0); PG8_STAGE(PG8_SA(1, 1), a1 + hstep, voffA);
            PG8_WAIT_L(8); PG8_BAR; PG8_WAIT_L(0); PG8_MMA(0, 0, At, B0); PG8_BAR; PG8_SCHED;
            PG8_LDB(B1, 0, 1); PG8_STAGE(PG8_SB(0, 0), b2, voffB);
            PG8_BAR; PG8_WAIT_L(0); PG8_MMA(0, 1, At, B1); PG8_BAR;
            PG8_LDA(At, 0, 1); PG8_STAGE(PG8_SA(0, 0), a2, voffA);
            PG8_BAR; PG8_WAIT_L(0); PG8_MMA(1, 0, At, B0); PG8_BAR; PG8_SCHED;
            PG8_STAGE(PG8_SB(0, 1), b2 + hstep, voffB);
            PG8_WAIT_V(6); PG8_BAR; PG8_MMA(1, 1, At, B1); PG8_BAR;
            PG8_LDB(B0, 1, 0); PG8_SCHED; PG8_LDA(At, 1, 0); PG8_STAGE(PG8_SA(0, 1), a2 + hstep, voffA);
            PG8_WAIT_L(8); PG8_BAR; PG8_WAIT_L(0); PG8_MMA(0, 0, At, B0); PG8_BAR; PG8_SCHED;
            PG8_LDB(B1, 1, 1); PG8_STAGE(PG8_SB(1, 0), b3, voffB);
            PG8_BAR; PG8_WAIT_L(0); PG8_MMA(0, 1, At, B1); PG8_BAR;
            PG8_LDA(At, 1, 1); PG8_STAGE(PG8_SA(1, 0), a3, voffA);
            PG8_BAR; PG8_WAIT_L(0); PG8_MMA(1, 0, At, B0); PG8_BAR; PG8_SCHED;
            PG8_STAGE(PG8_SB(1, 1), b3 + hstep, voffB);
            PG8_WAIT_V(6); PG8_BAR; PG8_MMA(1, 1, At, B1); PG8_BAR;
        }
        PG8_STAMP();
        if constexpr (!Epi::AFTER_DRAIN) { E(acc, cur, wr, wc, fr, fq, pre); S.done(cur); }
        PG8_STAMP();
        if (!has_next) break;
#pragma unroll
        for (int a = 0; a < 2; ++a)
#pragma unroll
            for (int b = 0; b < 2; ++b)
#pragma unroll
                for (int m = 0; m < 4; ++m)
#pragma unroll
                    for (int n = 0; n < 2; ++n) acc[a][b][m][n] = (f32x4){0.f, 0.f, 0.f, 0.f};
        cur = nxt; cA = nA; cB = nB; ++ui;
        pre = E.pre(cur, wr, fr);
    }
    PG8_WAIT_V(0);
    if (wr == 0) PG8_BAR;
    PG8_BAR;
    if constexpr (Epi::AFTER_DRAIN) { E.fused(acc, cur, wr, wc, fr, fq, lds, wid, lane); S.done(cur); }
    PG8_STAMP();
#undef PG8_STAMP
#undef PG8_SA
#undef PG8_SB
#undef PG8_STAGE
#undef PG8_LDA
#undef PG8_LDB
#undef PG8_MMA
#undef PG8_WAIT_V
#undef PG8_WAIT_L
#undef PG8_BAR
#undef PG8_SCHED
}
}
using pg8::bf16_t; using pg8::bf16x8; using pg8::f32x4; using pg8::u32x4; using pg8::Unit;
#define LAS __attribute__((address_space(3)))
typedef unsigned u32x2 __attribute__((ext_vector_type(2)));

constexpr int MTOK = 16384, DM = 2048, DFF = 5632, SEQL = 4096;
constexpr float EPSN = 1e-6f;

struct Params { const float* in[20]; float* out; unsigned char* ws; int ph_lo, ph_hi; };

constexpr size_t SZ_GU = (size_t)11264 * 2048 * 2, SZ_DN = (size_t)2048 * 5632 * 2;
constexpr size_t OFF_WGU = 0;
constexpr size_t OFF_WDN = OFF_WGU + 4 * SZ_GU;
constexpr size_t OFF_WABIN = OFF_WDN + 4 * SZ_DN;
constexpr size_t OFF_WABOUT = OFF_WABIN + (size_t)6208 * 2048 * 2;
constexpr size_t OFF_WNSAIN = OFF_WABOUT + (size_t)2048 * 2048 * 2;
constexpr size_t OFF_WNSAOUT = OFF_WNSAIN + (size_t)5184 * 2048 * 2;
constexpr size_t OFF_WC1 = OFF_WNSAOUT + (size_t)2048 * 2048 * 2;
constexpr size_t OFF_WC2 = OFF_WC1 + (size_t)2 * 128 * 4096 * 2;
constexpr size_t OFF_ABUF = OFF_WC2 + (size_t)2 * 128 * 128 * 2;
constexpr size_t OFF_BIG = OFF_ABUF + (size_t)MTOK * 2048 * 2;
constexpr size_t OFF_AUX1 = OFF_BIG + (size_t)MTOK * 6144 * 2 + 262144;
constexpr size_t OFF_AUX2 = OFF_AUX1 + (size_t)MTOK * 2048 * 2;
constexpr size_t OFF_KT = OFF_AUX2 + (size_t)MTOK * 1024 * 4;
constexpr size_t OFF_GATES = OFF_KT + (size_t)MTOK * 1024 * 2;
constexpr size_t OFF_ROPE = OFF_GATES + (size_t)MTOK * 48 * 4;
constexpr size_t OFF_KCMP = OFF_ROPE + (size_t)4096 * 32 * 4;
constexpr size_t OFF_VCMPT = OFF_KCMP + (size_t)16 * 256 * 128 * 2;
constexpr size_t OFF_SS = OFF_VCMPT + (size_t)16 * 128 * 256 * 2;
constexpr size_t OFF_BAR = OFF_SS + (size_t)6 * MTOK * 4;
constexpr size_t OFF_XB = OFF_BAR + 256;
constexpr size_t WS_END = OFF_XB + 1024 + 17 * 256;

__device__ __forceinline__ int otid() { int t = threadIdx.x; asm volatile("" : "+v"(t)); return t; }
__device__ __forceinline__ unsigned f2bf(float f) { unsigned u = __float_as_uint(f); u += 0x7FFFu + ((u >> 16) & 1u); return u >> 16; }
typedef float f32x2v __attribute__((ext_vector_type(2)));
typedef __bf16 bf16x2v __attribute__((ext_vector_type(2)));
__device__ __forceinline__ unsigned pack2(float a, float b) { f32x2v v = {a, b}; bf16x2v r = __builtin_convertvector(v, bf16x2v); return __builtin_bit_cast(unsigned, r); }
__device__ __forceinline__ float bflo(unsigned u) { return __uint_as_float(u << 16); }
__device__ __forceinline__ float bfhi(unsigned u) { return __uint_as_float(u & 0xFFFF0000u); }
__device__ __forceinline__ float bfs(short s) { return __uint_as_float(((unsigned)(unsigned short)s) << 16); }
__device__ __forceinline__ f32x4 mfma16(bf16x8 x, bf16x8 y, f32x4 c) { return __builtin_amdgcn_mfma_f32_16x16x32_bf16(x, y, c, 0, 0, 0); }
__device__ __forceinline__ bf16x8 ld8(const bf16_t* p) { return *(const bf16x8*)p; }
__device__ __forceinline__ bf16x8 lds8(const LAS bf16_t* p) { return *(const LAS bf16x8*)p; }
typedef short s16x4 __attribute__((ext_vector_type(4)));
__device__ __forceinline__ s16x4 lds_tr4(const LAS bf16_t* p) { return __builtin_amdgcn_ds_read_tr16_b64_v4i16((LAS s16x4*)p); }
__device__ __forceinline__ bf16x8 mk8(float a, float b, float c, float d, float e, float f, float g, float h) {
    u32x4 u = {pack2(a, b), pack2(c, d), pack2(e, f), pack2(g, h)}; return __builtin_bit_cast(bf16x8, u); }
__device__ __forceinline__ float xmax4(float x) {
    auto r = __builtin_amdgcn_permlane32_swap(__float_as_uint(x), __float_as_uint(x), false, false);
    x = fmaxf(__uint_as_float(r[0]), __uint_as_float(r[1]));
    auto r2 = __builtin_amdgcn_permlane16_swap(__float_as_uint(x), __float_as_uint(x), false, false);
    return fmaxf(__uint_as_float(r2[0]), __uint_as_float(r2[1]));
}
__device__ __forceinline__ float xsum4(float x) {
    auto r = __builtin_amdgcn_permlane32_swap(__float_as_uint(x), __float_as_uint(x), false, false);
    x = __uint_as_float(r[0]) + __uint_as_float(r[1]);
    auto r2 = __builtin_amdgcn_permlane16_swap(__float_as_uint(x), __float_as_uint(x), false, false);
    return __uint_as_float(r2[0]) + __uint_as_float(r2[1]);
}
__device__ __forceinline__ float wave_sum(float v) { for (int o = 32; o; o >>= 1) v += __shfl_xor(v, o); return v; }
__device__ __forceinline__ float sigm(float x) { return __builtin_amdgcn_rcpf(1.f + __expf(-x)); }
__device__ __forceinline__ float silu(float x) { return x * __builtin_amdgcn_rcpf(1.f + __expf(-x)); }
__device__ __forceinline__ float gelu_t(float x) { return x * __builtin_amdgcn_rcpf(1.f + __expf(-1.5957691216f * (x + 0.044715f * x * x * x))); }

struct EpiSwiGLU {
    static constexpr bool PERM = true, AFTER_DRAIN = false;
    bf16_t* O; const float* SS; const LAS float* lrs; int pm0;
    struct Pre { };
    __device__ __forceinline__ Pre pre(const Unit&, int, int) const { return Pre{}; }
    __device__ __forceinline__ float rstd_of(const Unit& u, int lrow) const {
        if (u.pm == pm0) return lrs[lrow];
        return rsqrtf(SS[u.pm * 256 + lrow] * (1.0f / 2048.0f) + EPSN);
    }
    __device__ __forceinline__ void operator()(const f32x4 (&acc)[2][2][4][2], const Unit& u, int wr, int wc, int fr, int fq, const Pre& pre) const {
        const int row0 = u.pm * 256 + wr * 64 + fr, col0 = u.pn * 128 + wc * 32 + 8 * fq;
#pragma unroll
        for (int ai = 0; ai < 2; ++ai)
#pragma unroll
            for (int m = 0; m < 4; ++m) {
                const float rs = rstd_of(u, wr * 64 + ai * 128 + m * 16 + fr);
                float h[8];
#pragma unroll
                for (int n = 0; n < 2; ++n)
#pragma unroll
                    for (int j = 0; j < 4; ++j) h[4 * n + j] = silu(acc[ai][0][m][n][j] * rs) * (acc[ai][1][m][n][j] * rs);
                u32x4 o = {pack2(h[0], h[1]), pack2(h[2], h[3]), pack2(h[4], h[5]), pack2(h[6], h[7])};
                *(u32x4*)(O + (size_t)(row0 + ai * 128 + m * 16) * DFF + col0) = o;
            }
    }
};
template <bool COPY> struct EpiResid {
    static constexpr bool PERM = false, AFTER_DRAIN = false;
    const float* R; float* O; bf16_t* Ob; float* SS; float scale;
    struct Pre { };
    __device__ __forceinline__ Pre pre(const Unit&, int, int) const { return Pre{}; }
    __device__ __forceinline__ void operator()(const f32x4 (&acc)[2][2][4][2], const Unit& u, int wr, int wc, int fr, int fq, const Pre& pre) const {
        const int row0 = u.pm * 256 + wr * 64 + fr, col0 = u.pn * 256 + wc * 32 + 4 * fq;
#pragma unroll
        for (int ai = 0; ai < 2; ++ai) {
            f32x4 rv[4][2][2];
#pragma unroll
            for (int m = 0; m < 4; ++m)
#pragma unroll
                for (int bj = 0; bj < 2; ++bj)
#pragma unroll
                    for (int n = 0; n < 2; ++n) rv[m][bj][n] = *(const f32x4*)(R + (size_t)(row0 + ai * 128 + m * 16) * DM + col0 + bj * 128 + n * 16);
#pragma unroll
            for (int m = 0; m < 4; ++m) {
                const size_t ro = (size_t)(row0 + ai * 128 + m * 16) * DM + col0;
                float ss = 0.f;
#pragma unroll
                for (int bj = 0; bj < 2; ++bj)
#pragma unroll
                    for (int n = 0; n < 2; ++n) {
                        const f32x4 hv = rv[m][bj][n] + acc[ai][bj][m][n] * scale;
                        *(f32x4*)(O + ro + bj * 128 + n * 16) = hv;
                        if (COPY) {
                            u32x2 o = {pack2(hv[0], hv[1]), pack2(hv[2], hv[3])};
                            *(u32x2*)(Ob + ro + bj * 128 + n * 16) = o;
                            ss += hv[0] * hv[0] + hv[1] * hv[1] + hv[2] * hv[2] + hv[3] * hv[3];
                        }
                    }
                if (COPY) { ss = xsum4(ss); if (fq == 0) (void)__hip_atomic_fetch_add(SS + row0 + ai * 128 + m * 16, ss, __ATOMIC_RELAXED, __HIP_MEMORY_SCOPE_AGENT); }
            }
        }
    }
};
struct EpiProj0 {
    static constexpr bool PERM = true, AFTER_DRAIN = false;
    bf16_t* O; const float* SS; const LAS float* lrs; int pm0;
    struct Pre { };
    __device__ __forceinline__ Pre pre(const Unit&, int, int) const { return Pre{}; }
    __device__ __forceinline__ float rstd_of(const Unit& u, int lrow) const {
        if (u.pm == pm0) return lrs[lrow];
        return rsqrtf(SS[u.pm * 256 + lrow] * (1.0f / 2048.0f) + EPSN);
    }
    __device__ __forceinline__ void operator()(const f32x4 (&acc)[2][2][4][2], const Unit& u, int wr, int wc, int fr, int fq, const Pre& pre) const {
        const int row0 = u.pm * 256 + wr * 64 + fr, col0 = u.pn * 256 + wc * 32 + 8 * fq;
        const bool g = u.pn < 8;
#pragma unroll
        for (int ai = 0; ai < 2; ++ai)
#pragma unroll
            for (int m = 0; m < 4; ++m) {
                const float rs = rstd_of(u, wr * 64 + ai * 128 + m * 16 + fr);
#pragma unroll
                for (int bj = 0; bj < 2; ++bj) {
                    float h[8];
#pragma unroll
                    for (int n = 0; n < 2; ++n)
#pragma unroll
                        for (int j = 0; j < 4; ++j) { const float v = acc[ai][bj][m][n][j] * rs; h[4 * n + j] = g ? gelu_t(v) : v; }
                    u32x4 o = {pack2(h[0], h[1]), pack2(h[2], h[3]), pack2(h[4], h[5]), pack2(h[6], h[7])};
                    *(u32x4*)(O + (size_t)(row0 + ai * 128 + m * 16) * 6144 + col0 + bj * 128) = o;
                }
            }
    }
};
struct EpiProj1 {
    static constexpr bool PERM = false, AFTER_DRAIN = false;
    bf16_t* O; const float* rope; const float* SS; const LAS float* lrs; int pm0;
    struct Pre { };
    __device__ __forceinline__ Pre pre(const Unit&, int, int) const { return Pre{}; }
    __device__ __forceinline__ float rstd_of(const Unit& u, int lrow) const {
        if (u.pm == pm0) return lrs[lrow];
        return rsqrtf(SS[u.pm * 256 + lrow] * (1.0f / 2048.0f) + EPSN);
    }
    __device__ __forceinline__ void operator()(const f32x4 (&acc)[2][2][4][2], const Unit& u, int wr, int wc, int fr, int fq, const Pre& pre) const {
        const int row0 = u.pm * 256 + wr * 64 + fr, col0 = u.pn * 256 + wc * 32 + 4 * fq;
#pragma unroll
        for (int ai = 0; ai < 2; ++ai) {
            f32x4 rcos[4], rsin[4];
            if (wc == 0) {
#pragma unroll
                for (int m = 0; m < 4; ++m) { const float* rp = rope + (size_t)((row0 + ai * 128 + m * 16) & 4095) * 32 + 4 * fq; rcos[m] = *(const f32x4*)rp; rsin[m] = *(const f32x4*)(rp + 16); }
            }
#pragma unroll
            for (int bj = 0; bj < 2; ++bj) {
                const int head = u.pn * 2 + bj;
                const bool isq = head < 16;
                const bool dorope = (wc == 0) && (isq || ((((head - 16) >> 2) & 1) == 0));
                const float sc = isq ? 0.08838834764831845f * 1.4426950408889634f : 1.f;
#pragma unroll
                for (int m = 0; m < 4; ++m) {
                    const int row = row0 + ai * 128 + m * 16;
                    const float rs = rstd_of(u, wr * 64 + ai * 128 + m * 16 + fr) * sc;
                    f32x4 v0 = acc[ai][bj][m][0] * rs, v1 = acc[ai][bj][m][1] * rs;
                    if (dorope) {
                        const f32x4 c = rcos[m], s = rsin[m];
                        const f32x4 a = v0 * c - v1 * s, b = v0 * s + v1 * c; v0 = a; v1 = b;
                    }
                    bf16_t* op = O + (size_t)row * 5120 + col0 + bj * 128;
                    u32x2 o0 = {pack2(v0[0], v0[1]), pack2(v0[2], v0[3])}, o1 = {pack2(v1[0], v1[1]), pack2(v1[2], v1[3])};
                    *(u32x2*)op = o0; *(u32x2*)(op + 16) = o1;
                }
            }
        }
    }
};

struct Job { const float* src; bf16_t* dst; const float* gain; int K, ldn, nvalid, ntn, remap, off; };
__device__ __forceinline__ void make_job(const Params& P, int j, Job& J) {
    unsigned char* ws = P.ws;
    J.gain = nullptr;
    if (j < 12) {
        const int fi = j / 3, kind = j - 3 * fi;
        if (kind < 2) { J.src = P.in[2 + kind] + (size_t)fi * 2048 * 5632; J.dst = (bf16_t*)(ws + OFF_WGU + fi * SZ_GU); J.K = 2048; J.ldn = 5632; J.nvalid = 5632; J.ntn = 88; J.remap = 1; J.off = kind * 128; J.gain = P.in[1] + (size_t)fi * 2048; }
        else { J.src = P.in[4] + (size_t)fi * 5632 * 2048; J.dst = (bf16_t*)(ws + OFF_WDN + fi * SZ_DN); J.K = 5632; J.ldn = 2048; J.nvalid = 2048; J.ntn = 32; J.remap = 0; J.off = 0; }
    } else if (j == 12) { J.src = P.in[6]; J.dst = (bf16_t*)(ws + OFF_WABIN); J.K = 2048; J.ldn = 6152; J.nvalid = 6152; J.ntn = 97; J.remap = 0; J.off = 0; J.gain = P.in[5]; }
    else if (j == 13) { J.src = P.in[13]; J.dst = (bf16_t*)(ws + OFF_WABOUT); J.K = 2048; J.ldn = 2048; J.nvalid = 2048; J.ntn = 32; J.remap = 0; J.off = 0; }
    else if (j == 14) { J.src = P.in[14]; J.dst = (bf16_t*)(ws + OFF_WNSAIN); J.K = 2048; J.ldn = 5168; J.nvalid = 5168; J.ntn = 81; J.remap = 0; J.off = 0; J.gain = P.in[5] + 2048; }
    else if (j == 15) { J.src = P.in[18]; J.dst = (bf16_t*)(ws + OFF_WNSAOUT); J.K = 2048; J.ldn = 2048; J.nvalid = 2048; J.ntn = 32; J.remap = 0; J.off = 0; }
    else if (j < 18) { const int kv = j - 16; J.src = P.in[16] + (size_t)kv * 4096 * 128; J.dst = (bf16_t*)(ws + OFF_WC1) + (size_t)kv * 128 * 4096; J.K = 4096; J.ldn = 128; J.nvalid = 128; J.ntn = 2; J.remap = 0; J.off = 0; }
    else { const int kv = j - 18; J.src = P.in[17] + (size_t)kv * 128 * 128; J.dst = (bf16_t*)(ws + OFF_WC2) + (size_t)kv * 128 * 128; J.K = 128; J.ldn = 128; J.nvalid = 128; J.ntn = 2; J.remap = 0; J.off = 0; }
}
constexpr int NT_CONVERT = 12 * 1408 + 16 * 97 + 16 * 32 + 16 * 81 + 16 * 32 + 2 * 64 + 2 * 2;
__device__ __forceinline__ void phase_prep(const Params& P, LAS unsigned char* lds) {
    LAS float* tile = (LAS float*)lds;
    const int tid = otid();
    if (tid == 0) ((unsigned*)(P.ws + OFF_XB))[blockIdx.x] = (unsigned)__builtin_amdgcn_s_getreg((3 << 11) | 20) & 0xFu;
    if (blockIdx.x == 0 && tid < 17) __hip_atomic_store((unsigned*)(P.ws + OFF_XB + 1024 + 256 * tid), 0u, __ATOMIC_RELAXED, __HIP_MEMORY_SCOPE_AGENT);
    {
        const int idx = blockIdx.x * 512 + tid;
        if (idx < 4096 * 16) {
            const int pos = idx >> 4, i = idx & 15;
            const float inv = 1.0f / powf(500000.0f, (float)i * (1.0f / 16.0f));
            const float ang = (float)pos * inv;
            float s, c; sincosf(ang, &s, &c);
            float* rp = (float*)(P.ws + OFF_ROPE) + (size_t)pos * 32;
            rp[i] = c; rp[16 + i] = s;
        }
    }
    {
        float* SS = (float*)(P.ws + OFF_SS); bf16_t* XB = (bf16_t*)(P.ws + OFF_ABUF);
        for (int i = blockIdx.x * 512 + tid; i < 5 * MTOK; i += gridDim.x * 512) SS[MTOK + i] = 0.f;
        const int wave = tid >> 6, lane = tid & 63;
        for (int row = blockIdx.x * 8 + wave; row < MTOK; row += gridDim.x * 8) {
            const float4* s = (const float4*)(P.in[0] + (size_t)row * DM);
            float ss = 0.f;
#pragma unroll
            for (int i = 0; i < 8; ++i) {
                const float4 v = s[lane + 64 * i];
                ss += v.x * v.x + v.y * v.y + v.z * v.z + v.w * v.w;
                u32x2 o = {pack2(v.x, v.y), pack2(v.z, v.w)};
                *(u32x2*)(XB + (size_t)row * DM + 4 * (lane + 64 * i)) = o;
            }
            ss = wave_sum(ss);
            if (lane == 0) SS[row] = ss;
        }
    }
    {
        Job J, Jn; float4 v[4]; int k0 = 0, n0 = 0, k0n = 0, n0n = 0;
#define PREP_FIND(T, JJ, K0, N0) do { int lt_ = (T), j_ = 0; for (;; ++j_) { make_job(P, j_, JJ); const int n_ = (JJ.K >> 7) * JJ.ntn; if (lt_ < n_) break; lt_ -= n_; } \
            const int nkt_ = JJ.K >> 7; K0 = (lt_ % nkt_) * 128; N0 = (lt_ / nkt_) * 64; } while (0)
#define PREP_LOAD(JJ, K0, N0) do { _Pragma("unroll") for (int i = 0; i < 4; ++i) { const int idx = tid + 512 * i, k = idx >> 4, n = (N0) + 4 * (idx & 15); \
            float4 x = make_float4(0.f, 0.f, 0.f, 0.f); if (n < JJ.nvalid) x = *(const float4*)(JJ.src + (size_t)((K0) + k) * JJ.ldn + n); \
            if (JJ.gain) { const float gk = JJ.gain[(K0) + k]; x.x *= gk; x.y *= gk; x.z *= gk; x.w *= gk; } v[i] = x; } } while (0)
        int t = blockIdx.x;
        if (t < NT_CONVERT) { PREP_FIND(t, Jn, k0n, n0n); PREP_LOAD(Jn, k0n, n0n); }
        for (; t < NT_CONVERT; t += gridDim.x) {
            J = Jn; k0 = k0n; n0 = n0n;
#pragma unroll
            for (int i = 0; i < 4; ++i) { const int idx = tid + 512 * i, k = idx >> 4, c4 = idx & 15; LAS float* tp = tile + k * 65 + 4 * c4; tp[0] = v[i].x; tp[1] = v[i].y; tp[2] = v[i].z; tp[3] = v[i].w; }
            __syncthreads();
            if (t + (int)gridDim.x < NT_CONVERT) { PREP_FIND(t + (int)gridDim.x, Jn, k0n, n0n); PREP_LOAD(Jn, k0n, n0n); }
#pragma unroll
            for (int i = 0; i < 2; ++i) {
                const int idx = tid + 512 * i, n = idx >> 4, kg = idx & 15;
                float f[8];
#pragma unroll
                for (int jj = 0; jj < 8; ++jj) f[jj] = tile[(8 * kg + jj) * 65 + n];
                u32x4 o = {pack2(f[0], f[1]), pack2(f[2], f[3]), pack2(f[4], f[5]), pack2(f[6], f[7])};
                const int nn = n0 + n, row = J.remap ? ((nn >> 7) * 256 + J.off + (nn & 127)) : nn;
                *(u32x4*)(J.dst + (size_t)row * J.K + k0 + 8 * kg) = o;
            }
            __syncthreads();
        }
#undef PREP_FIND
#undef PREP_LOAD
    }
}

__device__ __forceinline__ void phase_norm(const float* src, const float* g, bf16_t* dst) {
    const int wave = otid() >> 6, lane = otid() & 63;
    for (int row = blockIdx.x * 8 + wave; row < MTOK; row += gridDim.x * 8) {
        const float4* s = (const float4*)(src + (size_t)row * DM);
        float4 v[8]; float ss = 0.f;
#pragma unroll
        for (int i = 0; i < 8; ++i) { v[i] = s[lane + 64 * i]; ss += v[i].x * v[i].x + v[i].y * v[i].y + v[i].z * v[i].z + v[i].w * v[i].w; }
        ss = wave_sum(ss);
        const float r = rsqrtf(ss * (1.0f / 2048.0f) + EPSN);
#pragma unroll
        for (int i = 0; i < 8; ++i) {
            const float4 gg = ((const float4*)g)[lane + 64 * i];
            u32x2 o = {pack2(v[i].x * r * gg.x, v[i].y * r * gg.y), pack2(v[i].z * r * gg.z, v[i].w * r * gg.w)};
            *(u32x2*)(dst + (size_t)row * DM + 4 * (lane + 64 * i)) = o;
        }
    }
}
__device__ __forceinline__ void phase_final_norm(float* io, const float* g) {
    const int wave = otid() >> 6, lane = otid() & 63;
    for (int row = blockIdx.x * 8 + wave; row < MTOK; row += gridDim.x * 8) {
        float4* s = (float4*)(io + (size_t)row * DM);
        float4 v[8]; float ss = 0.f;
#pragma unroll
        for (int i = 0; i < 8; ++i) { v[i] = s[lane + 64 * i]; ss += v[i].x * v[i].x + v[i].y * v[i].y + v[i].z * v[i].z + v[i].w * v[i].w; }
        ss = wave_sum(ss);
        const float r = rsqrtf(ss * (1.0f / 2048.0f) + EPSN);
#pragma unroll
        for (int i = 0; i < 8; ++i) {
            const float4 gg = ((const float4*)g)[lane + 64 * i];
            s[lane + 64 * i] = make_float4(v[i].x * r * gg.x, v[i].y * r * gg.y, v[i].z * r * gg.z, v[i].w * r * gg.w);
        }
    }
}

template <int NT, int MODE>
__device__ __forceinline__ void phase_skinny(LAS unsigned char* lds, const bf16_t* A, const bf16_t* Bt, float* G, const float* bias, const float* SS) {
    const int wave = otid() >> 6, lane = otid() & 63, fr = lane & 15, fq = lane >> 4, half = wave >> 2, w4 = wave & 3;
    LAS f32x4* xch = (LAS f32x4*)lds;
    for (int rt0 = blockIdx.x * 4; rt0 < MTOK / 16; rt0 += gridDim.x * 4) {
        const int rt = rt0 + w4;
        f32x4 acc[NT];
#pragma unroll
        for (int n = 0; n < NT; ++n) acc[n] = (f32x4){0.f, 0.f, 0.f, 0.f};
        const bf16_t* ap = A + (size_t)(rt * 16 + fr) * DM + 8 * fq + 1024 * half;
        const bf16_t* bp = Bt + (size_t)fr * DM + 8 * fq + 1024 * half;
#pragma unroll 8
        for (int ks = 0; ks < 32; ++ks) {
            const bf16x8 a = ld8(ap + 32 * ks);
#pragma unroll
            for (int n = 0; n < NT; ++n) { const bf16x8 b = ld8(bp + (size_t)n * 16 * DM + 32 * ks); acc[n] = mfma16(b, a, acc[n]); }
        }
        if (half) {
#pragma unroll
            for (int n = 0; n < NT; ++n) xch[(w4 * NT + n) * 64 + lane] = acc[n];
        }
        __syncthreads();
        if (!half) {
#pragma unroll
            for (int n = 0; n < NT; ++n) acc[n] += xch[(w4 * NT + n) * 64 + lane];
            const int token = rt * 16 + fr;
            const float rs = rsqrtf(SS[token] * (1.0f / 2048.0f) + EPSN);
            if (MODE == 0) {
                if (fq < 2) { const f32x4 b = *(const f32x4*)(bias + 4 * fq); *(f32x4*)(G + (size_t)token * 8 + 4 * fq) = acc[0] * rs + b; }
            } else {
#pragma unroll
                for (int n = 0; n < NT; ++n) { f32x4 o; for (int j = 0; j < 4; ++j) o[j] = sigm(acc[n][j] * rs); *(f32x4*)(G + (size_t)token * 48 + 16 * n + 4 * fq) = o; }
            }
        }
        __syncthreads();
    }
}

__device__ __forceinline__ void conv_wave_item(const Params& P, int item, int lane) {
    const bf16_t* BIG = (const bf16_t*)(P.ws + OFF_BIG); bf16_t* QK = (bf16_t*)(P.ws + OFF_AUX1); bf16_t* KT = (bf16_t*)(P.ws + OFF_KT);
    const float* cw = P.in[11];
    const int tgp = item >> 5, cgp = item & 31, tg = lane & 7, cg = lane >> 3;
    const int tok0 = tgp * 64 + 8 * tg, c0 = cgp * 64 + 8 * cg, pos0 = tok0 & 4095;
    float w[4][8];
#pragma unroll
    for (int jj = 0; jj < 4; ++jj) { const float4 a = *(const float4*)(cw + jj * 2048 + c0), b = *(const float4*)(cw + jj * 2048 + c0 + 4);
        w[jj][0] = a.x; w[jj][1] = a.y; w[jj][2] = a.z; w[jj][3] = a.w; w[jj][4] = b.x; w[jj][5] = b.y; w[jj][6] = b.z; w[jj][7] = b.w; }
    bf16x8 xr[11];
#pragma unroll
    for (int r = 0; r < 11; ++r) {
        const bool ok = (r >= 3) || (pos0 != 0);
        const int t = ok ? (tok0 - 3 + r) : tok0;
        const bf16x8 v = ld8(BIG + (size_t)t * 6144 + 2048 + c0);
        xr[r] = ok ? v : (bf16x8){0, 0, 0, 0, 0, 0, 0, 0};
    }
    const float ksc = (c0 >= 1024) ? 0.0625f : 1.0f;
    float o[8][8];
#pragma unroll
    for (int i = 0; i < 8; ++i)
#pragma unroll
        for (int j = 0; j < 8; ++j) {
            float a = 0.f;
#pragma unroll
            for (int jj = 0; jj < 4; ++jj) a += w[jj][j] * bfs(xr[i + jj][j]);
            o[i][j] = silu(a) * ksc;
        }
#pragma unroll
    for (int i = 0; i < 8; ++i) {
        u32x4 v = {pack2(o[i][0], o[i][1]), pack2(o[i][2], o[i][3]), pack2(o[i][4], o[i][5]), pack2(o[i][6], o[i][7])};
        *(u32x4*)(QK + (size_t)(tok0 + i) * 2048 + c0) = v;
    }
    if (c0 >= 1024) {
        const int b = tok0 >> 12;
#pragma unroll
        for (int j = 0; j < 8; ++j) {
            u32x4 v = {pack2(o[0][j], o[1][j]), pack2(o[2][j], o[3][j]), pack2(o[4][j], o[5][j]), pack2(o[6][j], o[7][j])};
            *(u32x4*)(KT + (size_t)(b * 1024 + (c0 - 1024) + j) * 4096 + pos0) = v;
        }
    }
}

__device__ __forceinline__ void gmlp_item(const Params& P, LAS unsigned char* lds, int item2) {
    const int j2_ = (item2 & 255) >> 3, item = ((item2 & 7) << 4) + (j2_ >> 1), g0 = (j2_ & 1) * 4;
    const int tid = otid(), wave = tid >> 6, lane = tid & 63, fr = lane & 15, fq = lane >> 4;
    LAS bf16_t* VT = (LAS bf16_t*)lds;
    LAS float* rstd = (LAS float*)(lds + 34816);
    const bf16_t* BIG = (const bf16_t*)(P.ws + OFF_BIG); bf16_t* ABUF = (bf16_t*)(P.ws + OFF_ABUF);
    const float* gn = P.in[8]; const float* wsp = P.in[9]; const float* bsp = P.in[10];
    const int T0 = item * 128;
    for (int r = 0; r < 16; ++r) {
        const int row = wave * 16 + r;
        const bf16_t* p = BIG + (size_t)(T0 + row) * 6144 + 1024 + 16 * lane;
        const bf16x8 a = ld8(p), b = ld8(p + 8);
        float ss = 0.f;
#pragma unroll
        for (int j = 0; j < 8; ++j) { const float x = bfs(a[j]), y = bfs(b[j]); ss += x * x + y * y; }
        ss = wave_sum(ss);
        if (lane == 0) rstd[row] = rsqrtf(ss * (1.0f / 1024.0f) + EPSN);
    }
    __syncthreads();
    for (int g = g0; g < g0 + 4; ++g) {
        {
            const int s = tid & 127, eg0 = tid >> 7; const float rs = rstd[s];
#pragma unroll
            for (int it = 0; it < 4; ++it) {
                const int eg = eg0 + 4 * it;
                const bf16x8 v = ld8(BIG + (size_t)(T0 + s) * 6144 + 1024 + g * 128 + 8 * eg);
                const float4 g0 = *(const float4*)(gn + g * 128 + 8 * eg), g1 = *(const float4*)(gn + g * 128 + 8 * eg + 4);
                const float gg[8] = {g0.x, g0.y, g0.z, g0.w, g1.x, g1.y, g1.z, g1.w};
#pragma unroll
                for (int jj = 0; jj < 8; ++jj) VT[(8 * eg + jj) * 136 + s] = (bf16_t)f2bf(bfs(v[jj]) * rs * gg[jj]);
            }
        }
        __syncthreads();
        f32x4 acc[8];
#pragma unroll
        for (int e = 0; e < 8; ++e) acc[e] = (f32x4){0.f, 0.f, 0.f, 0.f};
        const int t = wave * 16 + fr;
        for (int ks = 0; ks < 4; ++ks) {
            if (32 * ks <= wave * 16 + 15) {
                const float* wp = wsp + ((size_t)(g * 128 + t)) * 128 + 32 * ks + 8 * fq;
                const float4 w0 = *(const float4*)wp, w1 = *(const float4*)(wp + 4);
                const int s0 = 32 * ks + 8 * fq;
                const bf16x8 Y = mk8(s0 + 0 <= t ? w0.x : 0.f, s0 + 1 <= t ? w0.y : 0.f, s0 + 2 <= t ? w0.z : 0.f, s0 + 3 <= t ? w0.w : 0.f,
                                     s0 + 4 <= t ? w1.x : 0.f, s0 + 5 <= t ? w1.y : 0.f, s0 + 6 <= t ? w1.z : 0.f, s0 + 7 <= t ? w1.w : 0.f);
#pragma unroll
                for (int e = 0; e < 8; ++e) { const bf16x8 X = lds8(VT + (16 * e + fr) * 136 + 32 * ks + 8 * fq); acc[e] = mfma16(X, Y, acc[e]); }
            }
        }
        const float bsv = bsp[g * 128 + t]; const size_t tok = (size_t)(T0 + t);
        u32x2 uall[8];
#pragma unroll
        for (int e = 0; e < 8; ++e) uall[e] = *(const u32x2*)(BIG + tok * 6144 + g * 128 + 16 * e + 4 * fq);
#pragma unroll
        for (int e = 0; e < 8; ++e) {
            const int e0 = 16 * e + 4 * fq;
            const u32x2 uu = uall[e];
            u32x2 o = {pack2(bflo(uu.x) * (acc[e][0] + bsv), bfhi(uu.x) * (acc[e][1] + bsv)), pack2(bflo(uu.y) * (acc[e][2] + bsv), bfhi(uu.y) * (acc[e][3] + bsv))};
            *(u32x2*)(ABUF + tok * 2048 + g * 128 + e0) = o;
        }
        __syncthreads();
    }
}

__device__ __forceinline__ void phase_conv_gmlp(const Params& P, LAS unsigned char* lds) {
    for (int it = blockIdx.x; it < 256; it += gridDim.x) gmlp_item(P, lds, it);
    const int wave = otid() >> 6, lane = otid() & 63;
    for (int it = blockIdx.x * 8 + wave; it < 8192; it += gridDim.x * 8) conv_wave_item(P, it, lane);
}

constexpr int ML_KS = 0, ML_PS = 67584, ML_VT = 102400, ML_VTW = 106752, ML_CB = 111104, ML_N = 119552, ML_A = 120576, ML_MT = 121088, ML_B = 121600, ML_WS = 122112;
constexpr int ML_CB2 = 122624, ML_N2 = 131072, ML_SC2 = 132096 - ML_A;
__device__ __forceinline__ void mlstm_scalars(LAS float* sa, LAS float* sMt, LAS float* sb, float f0, float f1, float i0, float i1, float m, int lane) {
    const float l0 = (f0 >= 0.f) ? -log1pf(__expf(-f0)) : (f0 - log1pf(__expf(f0)));
    const float l1 = (f1 >= 0.f) ? -log1pf(__expf(-f1)) : (f1 - log1pf(__expf(f1)));
    float v = l0 + l1;
#pragma unroll
    for (int o = 1; o < 64; o <<= 1) { const float y = __shfl_up(v, o); if (lane >= o) v += y; }
    const float excl = v - (l0 + l1);
    const float b0 = excl + l0, b1 = excl + l0 + l1;
    const float a0 = i0 - b0, a1 = i1 - b1;
    float q = fmaxf(a0, a1);
#pragma unroll
    for (int o = 1; o < 64; o <<= 1) { const float y = __shfl_up(q, o); if (lane >= o) q = fmaxf(q, y); }
    float qe = __shfl_up(q, 1); if (lane == 0) qe = -3.0e38f;
    const float pm0 = fmaxf(qe, a0), pm1 = fmaxf(pm0, a1);
    sa[2 * lane] = a0; sa[2 * lane + 1] = a1; sb[2 * lane] = b0; sb[2 * lane + 1] = b1;
    sMt[2 * lane] = fmaxf(pm0, m); sMt[2 * lane + 1] = fmaxf(pm1, m);
}
__device__ __forceinline__ void mlstm_item(const Params& P, LAS unsigned char* lds, int item) {
    const int tid = otid(), wave = tid >> 6, lane = tid & 63, fr = lane & 15, fq = lane >> 4;
    LAS bf16_t* Ks = (LAS bf16_t*)(lds + ML_KS);
    LAS bf16_t* Ps = (LAS bf16_t*)(lds + ML_PS);
    LAS bf16_t* VT = (LAS bf16_t*)(lds + ML_VT);
    LAS bf16_t* VTW = (LAS bf16_t*)(lds + ML_VTW);
    const bf16_t* BIG = (const bf16_t*)(P.ws + OFF_BIG); const bf16_t* QK = (const bf16_t*)(P.ws + OFF_AUX1);
    const float* G0 = (const float*)(P.ws + OFF_GATES); float* HT = (float*)(P.ws + OFF_AUX2);
    const int bh_ = ((item & 7) << 1) + ((item >> 7) & 1), es = (item >> 3) & 15, h = bh_ & 3, b = bh_ >> 2;
    { LAS bf16_t* Cb0 = (LAS bf16_t*)(lds + ML_CB); LAS float* n0 = (LAS float*)(lds + ML_N);
      for (int i = tid; i < 16 * 264; i += 512) Cb0[i] = 0;
      if (tid < 256) n0[tid] = 0.f; }
    f32x4 Cacc[2] = {(f32x4){0.f, 0.f, 0.f, 0.f}, (f32x4){0.f, 0.f, 0.f, 0.f}}, Nacc[2] = {(f32x4){0.f, 0.f, 0.f, 0.f}, (f32x4){0.f, 0.f, 0.f, 0.f}};
    float m = 0.f;
    bf16x8 gk[8], gq[8], gv = (bf16x8){0, 0, 0, 0, 0, 0, 0, 0};
    float pf0 = 0.f, pf1 = 0.f, pi0 = 0.f, pi1 = 0.f;
#define ML_FETCH(TB) do { const int tb_ = (TB); \
        _Pragma("unroll") for (int i = 0; i < 8; ++i) { const int idx = tid + 512 * i; gk[i] = ld8(QK + (size_t)(tb_ + (idx >> 5)) * 2048 + 1024 + h * 256 + 8 * (idx & 31)); } \
        _Pragma("unroll") for (int ks = 0; ks < 8; ++ks) gq[ks] = ld8(QK + (size_t)(tb_ + 16 * wave + fr) * 2048 + h * 256 + 32 * ks + 8 * fq); \
        if (tid < 256) gv = ld8(BIG + (size_t)(tb_ + (tid & 127)) * 6144 + 4096 + h * 256 + es * 16 + 8 * (tid >> 7)); \
        if (wave == 0) { pf0 = G0[(size_t)(tb_ + 2 * lane) * 8 + 4 + h]; pf1 = G0[(size_t)(tb_ + 2 * lane + 1) * 8 + 4 + h]; pi0 = G0[(size_t)(tb_ + 2 * lane) * 8 + h]; pi1 = G0[(size_t)(tb_ + 2 * lane + 1) * 8 + h]; } } while (0)
    ML_FETCH(b * 4096);
    if (wave == 0) mlstm_scalars((LAS float*)(lds + ML_A), (LAS float*)(lds + ML_MT), (LAS float*)(lds + ML_B), pf0, pf1, pi0, pi1, m, lane);
    __syncthreads();
    for (int c = 0; c < 32; ++c) {
        const int T0 = b * 4096 + c * 128, par = c & 1;
        LAS float* sa = (LAS float*)(lds + ML_A + par * ML_SC2); LAS float* sMt = (LAS float*)(lds + ML_MT + par * ML_SC2);
        LAS float* sb = (LAS float*)(lds + ML_B + par * ML_SC2); LAS float* sws = (LAS float*)(lds + ML_WS + par * ML_SC2);
        LAS bf16_t* Cb = (LAS bf16_t*)(lds + (par ? ML_CB2 : ML_CB)); LAS bf16_t* CbN = (LAS bf16_t*)(lds + (par ? ML_CB : ML_CB2));
        LAS float* nvec = (LAS float*)(lds + (par ? ML_N2 : ML_N)); LAS float* nvecN = (LAS float*)(lds + (par ? ML_N : ML_N2));
        const float MtL = sMt[127];
        if (tid < 128) sws[tid] = __expf(sa[tid] - MtL);
#pragma unroll
        for (int i = 0; i < 8; ++i) {
            const int idx = tid + 512 * i, s = idx >> 5, dp = idx & 31;
            *(LAS bf16x8*)(Ks + s * 264 + 8 * dp) = gk[i];
        }
        if (tid < 256) {
            const int s = tid & 127, hf = tid >> 7;
            const bf16x8 v = gv;
            const float w = __expf(sa[s] - MtL);
            const int sp = (s & ~31) + 8 * ((s >> 2) & 3) + 4 * ((s >> 4) & 1) + (s & 3);
#pragma unroll
            for (int jj = 0; jj < 8; ++jj) { VT[(8 * hf + jj) * 136 + sp] = (bf16_t)v[jj]; VTW[(8 * hf + jj) * 136 + s] = (bf16_t)f2bf(bfs(v[jj]) * w); }
        }
        bf16x8 qf[8];
#pragma unroll
        for (int ks = 0; ks < 8; ++ks) qf[ks] = gq[ks];
        if (c < 31) ML_FETCH(T0 + 128);
        __syncthreads();
        const int t = 16 * wave + fr;
        const float Mt_t = sMt[t];
        float rsum = 0.f;
        f32x4 a1 = (f32x4){0.f, 0.f, 0.f, 0.f};
        for (int kk = 0; kk <= (wave >> 1); ++kk) {
            f32x4 acc0 = (f32x4){0.f, 0.f, 0.f, 0.f}, acc1 = (f32x4){0.f, 0.f, 0.f, 0.f};
#pragma unroll
            for (int ks = 0; ks < 8; ++ks) {
                const bf16x8 X0 = lds8(Ks + (32 * kk + fr) * 264 + 32 * ks + 8 * fq), X1 = lds8(Ks + (32 * kk + 16 + fr) * 264 + 32 * ks + 8 * fq);
                acc0 = mfma16(X0, qf[ks], acc0); acc1 = mfma16(X1, qf[ks], acc1);
            }
            float pv[2][4];
#pragma unroll
            for (int hh = 0; hh < 2; ++hh) {
                const f32x4 acc = hh ? acc1 : acc0;
                const int s0 = 32 * kk + 16 * hh + 4 * fq;
                const f32x4 av = *(const LAS f32x4*)(sa + s0);
#pragma unroll
                for (int j = 0; j < 4; ++j) { const float d = (s0 + j <= t) ? __expf(av[j] - Mt_t) : 0.f; pv[hh][j] = acc[j] * d; rsum += pv[hh][j]; }
            }
            const bf16x8 Y = mk8(pv[0][0], pv[0][1], pv[0][2], pv[0][3], pv[1][0], pv[1][1], pv[1][2], pv[1][3]);
            a1 = mfma16(lds8(VT + fr * 136 + 32 * kk + 8 * fq), Y, a1);
        }
        rsum = xsum4(rsum);
        {
            f32x4 a2 = (f32x4){0.f, 0.f, 0.f, 0.f};
            float qn = 0.f;
#pragma unroll
            for (int ks = 0; ks < 8; ++ks) {
                const bf16x8 X = lds8(Cb + fr * 264 + 32 * ks + 8 * fq);
                a2 = mfma16(X, qf[ks], a2);
                const f32x4 n0 = *(const LAS f32x4*)(nvec + 32 * ks + 8 * fq), n1 = *(const LAS f32x4*)(nvec + 32 * ks + 8 * fq + 4);
#pragma unroll
                for (int jj = 0; jj < 4; ++jj) qn += bfs(qf[ks][jj]) * n0[jj] + bfs(qf[ks][4 + jj]) * n1[jj];
            }
            qn = xsum4(qn);
            const float wi = __expf(m - Mt_t);
            const float den = rsum + wi * qn;
            const float dn = fmaxf(fabsf(den), __expf(-(sb[t] + Mt_t)));
            const float inv = 1.0f / dn;
            f32x4 o; for (int j = 0; j < 4; ++j) o[j] = (a1[j] + wi * a2[j]) * inv;
            *(f32x4*)(HT + (size_t)(T0 + t) * 1024 + h * 256 + es * 16 + 4 * fq) = o;
        }
        {
            const float wprev = __expf(m - MtL);
            Cacc[0] *= wprev; Cacc[1] *= wprev; Nacc[0] *= wprev; Nacc[1] *= wprev;
#pragma unroll
            for (int kk = 0; kk < 4; ++kk) {
                const bf16x8 X = lds8(VTW + fr * 136 + 32 * kk + 8 * fq);
                const f32x4 w0 = *(const LAS f32x4*)(sws + 32 * kk + 8 * fq), w1 = *(const LAS f32x4*)(sws + 32 * kk + 8 * fq + 4);
                const bf16x8 XWf = mk8(w0[0], w0[1], w0[2], w0[3], w1[0], w1[1], w1[2], w1[3]);
                const bf16x8 XW = (fr == 0) ? XWf : (bf16x8){0, 0, 0, 0, 0, 0, 0, 0};
#pragma unroll
                for (int dt = 0; dt < 2; ++dt) {
                    const int dcol = 16 * (2 * wave + dt) + fr;
                    const LAS bf16_t* yp = Ks + (32 * kk + 8 * fq + (fr >> 2)) * 264 + 16 * (2 * wave + dt) + 4 * (fr & 3);
                    const s16x4 ylo = lds_tr4(yp), yhi = lds_tr4(yp + 4 * 264);
                    const bf16x8 Y = {ylo[0], ylo[1], ylo[2], ylo[3], yhi[0], yhi[1], yhi[2], yhi[3]};
                    Cacc[dt] = mfma16(X, Y, Cacc[dt]);
                    Nacc[dt] = mfma16(XW, Y, Nacc[dt]);
                }
            }
#pragma unroll
            for (int dt = 0; dt < 2; ++dt) {
                const int dcol = 16 * (2 * wave + dt) + fr;
#pragma unroll
                for (int j = 0; j < 4; ++j) CbN[(4 * fq + j) * 264 + dcol] = (bf16_t)f2bf(Cacc[dt][j]);
                if (fq == 0) nvecN[dcol] = Nacc[dt][0];
            }
            m = sb[127] + MtL;
        }
        if (wave == 0 && c < 31)
            mlstm_scalars((LAS float*)(lds + ML_A + (par ^ 1) * ML_SC2), (LAS float*)(lds + ML_MT + (par ^ 1) * ML_SC2), (LAS float*)(lds + ML_B + (par ^ 1) * ML_SC2), pf0, pf1, pi0, pi1, m, lane);
        __syncthreads();
    }
#undef ML_FETCH
}
__device__ __forceinline__ void phase_mlstm(const Params& P, LAS unsigned char* lds) {
    for (int it = blockIdx.x; it < 256; it += gridDim.x) { mlstm_item(P, lds, it); __syncthreads(); }
}

__device__ __forceinline__ void phase_htnorm(const Params& P) {
    const int wave = otid() >> 6, lane = otid() & 63;
    const float* HT = (const float*)(P.ws + OFF_AUX2); const bf16_t* BIG = (const bf16_t*)(P.ws + OFF_BIG); bf16_t* ABUF = (bf16_t*)(P.ws + OFF_ABUF);
    const float* mn = P.in[12];
    for (int row = blockIdx.x * 8 + wave; row < MTOK; row += gridDim.x * 8) {
        float4 vv[4], gg[4]; u32x2 ov[4];
#pragma unroll
        for (int h = 0; h < 4; ++h) { gg[h] = *(const float4*)(mn + h * 256 + 4 * lane); vv[h] = *(const float4*)(HT + (size_t)row * 1024 + h * 256 + 4 * lane); ov[h] = *(const u32x2*)(BIG + (size_t)row * 6144 + 5120 + h * 256 + 4 * lane); }
#pragma unroll
        for (int h = 0; h < 4; ++h) {
            const float4 v = vv[h];
            float ss = v.x * v.x + v.y * v.y + v.z * v.z + v.w * v.w;
            ss = wave_sum(ss);
            const float r = rsqrtf(ss * (1.0f / 256.0f) + EPSN);
            const float4 g = gg[h];
            const u32x2 oo = ov[h];
            u32x2 o = {pack2(sigm(bflo(oo.x)) * v.x * r * g.x, sigm(bfhi(oo.x)) * v.y * r * g.y), pack2(sigm(bflo(oo.y)) * v.z * r * g.z, sigm(bfhi(oo.y)) * v.w * r * g.w)};
            *(u32x2*)(ABUF + (size_t)row * 2048 + 1024 + h * 256 + 4 * lane) = o;
        }
    }
}


__device__ __forceinline__ int kv_col(int br, int kv, int g) { return 2048 + ((br * 2 + kv) * 4 + g) * 128; }

__device__ __forceinline__ void vt_wave_item(const Params& P, int item, int lane) {
    const bf16_t* BIG = (const bf16_t*)(P.ws + OFF_BIG); bf16_t* VTG = (bf16_t*)(P.ws + OFF_KT);
    const int tgp = item >> 4, cgp = item & 15;
    const int brm = cgp >> 3, g = (cgp >> 1) & 3, half = cgp & 1;
    const int tg = lane & 7, cg = lane >> 3;
    const int tok0 = tgp * 64 + 8 * tg, b = tok0 >> 12, pos0 = tok0 & 4095;
    const int col = kv_col(brm + 1, 1, g) + half * 64 + 8 * cg;
    bf16x8 x[8];
#pragma unroll
    for (int i = 0; i < 8; ++i) x[i] = ld8(BIG + (size_t)(tok0 + i) * 5120 + col);
    const size_t rb = (size_t)(((b * 2 + brm) * 4 + g) * 128 + half * 64 + 8 * cg);
#pragma unroll
    for (int j = 0; j < 8; ++j) {
        bf16x8 v; for (int i = 0; i < 8; ++i) v[i] = x[i][j];
        *(bf16x8*)(VTG + (rb + j) * 4096 + pos0) = v;
    }
}

__device__ __forceinline__ void cmp_item(const Params& P, LAS unsigned char* lds, int item) {
    const int tid = otid(), wave = tid >> 6, lane = tid & 63, fr = lane & 15, fq = lane >> 4;
    LAS float* pos = (LAS float*)lds;
    LAS bf16_t* H = (LAS bf16_t*)(lds + 16384);
    const bf16_t* BIG = (const bf16_t*)(P.ws + OFF_BIG);
    const int blk_ = item & 255, j_ = blk_ >> 3, grp_ = ((blk_ & 7) << 2) + ((item >> 8) << 1) + (j_ >> 4);
    const int rt = j_ & 15, g = grp_ & 3, b = (grp_ >> 2) & 3, kv = grp_ >> 4;
    const bf16_t* W1 = (const bf16_t*)(P.ws + OFF_WC1) + (size_t)kv * 128 * 4096;
    const bf16_t* W2 = (const bf16_t*)(P.ws + OFF_WC2) + (size_t)kv * 128 * 128;
    const float* pe = P.in[15] + (size_t)kv * 4096;
    for (int i = tid; i < 1024; i += 512) *(LAS f32x4*)(pos + 4 * i) = *(const f32x4*)(pe + 4 * i);
    __syncthreads();
    int cr = rt * 16 + fr; if (cr > 254) cr = 254;
    const bf16_t* ap = BIG + (size_t)(b * 4096 + 16 * cr) * 5120 + kv_col(0, kv, g) + 8 * fq;
    const bf16_t* wp = W1 + (size_t)(16 * wave + fr) * 4096 + 8 * fq;
    f32x4 acc = (f32x4){0.f, 0.f, 0.f, 0.f};
#pragma unroll 8
    for (int ks = 0; ks < 128; ++ks) {
        const int l = ks >> 2, d0 = (ks & 3) * 32;
        const bf16x8 xv = ld8(ap + (size_t)l * 5120 + d0);
        const f32x4 p0 = *(const LAS f32x4*)(pos + l * 128 + d0 + 8 * fq), p1 = *(const LAS f32x4*)(pos + l * 128 + d0 + 8 * fq + 4);
        const bf16x8 Y = mk8(bfs(xv[0]) + p0[0], bfs(xv[1]) + p0[1], bfs(xv[2]) + p0[2], bfs(xv[3]) + p0[3], bfs(xv[4]) + p1[0], bfs(xv[5]) + p1[1], bfs(xv[6]) + p1[2], bfs(xv[7]) + p1[3]);
        const bf16x8 X = ld8(wp + 32 * ks);
        acc = mfma16(X, Y, acc);
    }
    { u32x2 o = {pack2(gelu_t(acc[0]), gelu_t(acc[1])), pack2(gelu_t(acc[2]), gelu_t(acc[3]))}; *(LAS u32x2*)(H + fr * 136 + 16 * wave + 4 * fq) = o; }
    __syncthreads();
    f32x4 a2 = (f32x4){0.f, 0.f, 0.f, 0.f};
    if (kv == 0) {
#pragma unroll
        for (int ks = 0; ks < 4; ++ks) { const bf16x8 X = ld8(W2 + (size_t)(16 * wave + fr) * 128 + 32 * ks + 8 * fq), Y = lds8(H + fr * 136 + 32 * ks + 8 * fq); a2 = mfma16(X, Y, a2); }
        bf16_t* KC = (bf16_t*)(P.ws + OFF_KCMP);
        u32x2 o = {pack2(a2[0], a2[1]), pack2(a2[2], a2[3])};
        *(u32x2*)(KC + (size_t)((b * 4 + g) * 256 + rt * 16 + fr) * 128 + 16 * wave + 4 * fq) = o;
    } else {
#pragma unroll
        for (int ks = 0; ks < 4; ++ks) { const bf16x8 Y = ld8(W2 + (size_t)(16 * wave + fr) * 128 + 32 * ks + 8 * fq), X = lds8(H + fr * 136 + 32 * ks + 8 * fq); a2 = mfma16(X, Y, a2); }
        bf16_t* VC = (bf16_t*)(P.ws + OFF_VCMPT);
        u32x2 o = {pack2(a2[0], a2[1]), pack2(a2[2], a2[3])};
        *(u32x2*)(VC + (size_t)((b * 4 + g) * 128 + 16 * wave + fr) * 256 + rt * 16 + 4 * fq) = o;
    }
    __syncthreads();
}
__device__ __forceinline__ void phase_compress(const Params& P, LAS unsigned char* lds) {
    for (int it = blockIdx.x; it < 512; it += gridDim.x) cmp_item(P, lds, it);
    const int wave = otid() >> 6, lane = otid() & 63;
    for (int it = blockIdx.x * 8 + wave; it < 4096; it += gridDim.x * 8) vt_wave_item(P, it, lane);
}

constexpr int AT_KB = 0, AT_VT = 17408, AT_PS = 35840, AT_IMP = 72704, AT_SEL = 138240;
struct KVRegs { bf16x8 k[2], v[2]; };
__device__ __forceinline__ void at_fetch(KVRegs& R, const bf16_t* ksrc, size_t kpitch, const bf16_t* vsrc, size_t vpitch, int tid, bool wantv) {
#pragma unroll
    for (int i = 0; i < 2; ++i) {
        const int p = tid + 512 * i;
        R.k[i] = ld8(ksrc + (size_t)(p >> 4) * kpitch + 8 * (p & 15));
        if (wantv) R.v[i] = ld8(vsrc + (size_t)(p >> 3) * vpitch + 8 * (p & 7));
    }
}
__device__ __forceinline__ void at_stage(LAS unsigned char* lds, const KVRegs& R, int tid, bool wantv, int bofs = 0) {
    LAS bf16_t* Kb = (LAS bf16_t*)(lds + bofs + AT_KB); LAS bf16_t* Vb = (LAS bf16_t*)(lds + bofs + AT_VT);
#pragma unroll
    for (int i = 0; i < 2; ++i) {
        const int p = tid + 512 * i;
        *(LAS bf16x8*)(Kb + (p >> 4) * 136 + 8 * (p & 15)) = R.k[i];
        if (wantv) {
            const int c8 = p & 7, cc = c8 & 3, base = (p >> 3) * 72 + 32 * (c8 >> 2) + 16 * (cc & 1) + 4 * (cc >> 1);
            const u32x4 vv = __builtin_bit_cast(u32x4, R.v[i]);
            *(LAS u32x2*)(Vb + base) = (u32x2){vv[0], vv[1]};
            *(LAS u32x2*)(Vb + base + 8) = (u32x2){vv[2], vv[3]};
        }
    }
}
__device__ __forceinline__ void at_scores2(LAS unsigned char* lds, const bf16x8 (&qf)[2][4], f32x4 (&sc)[2][4], int fr, int fq, int bofs = 0) {
    const LAS bf16_t* Kb = (const LAS bf16_t*)(lds + bofs + AT_KB);
#pragma unroll
    for (int kt = 0; kt < 4; ++kt) {
        f32x4 a0 = (f32x4){0.f, 0.f, 0.f, 0.f}, a1 = (f32x4){0.f, 0.f, 0.f, 0.f};
#pragma unroll
        for (int ks = 0; ks < 4; ++ks) { const bf16x8 X = lds8(Kb + (16 * kt + fr) * 136 + 32 * ks + 8 * fq); a0 = mfma16(X, qf[0][ks], a0); a1 = mfma16(X, qf[1][ks], a1); }
        sc[0][kt] = a0; sc[1][kt] = a1;
    }
}
__device__ __forceinline__ void at_pv2(LAS unsigned char* lds, const f32x4 (&p)[2][4], f32x4 (&o)[2][8], int wave, int fr, int fq, int bofs = 0) {
    const LAS bf16_t* Vb = (const LAS bf16_t*)(lds + bofs + AT_VT);
#pragma unroll
    for (int kk = 0; kk < 2; ++kk) {
        const bf16x8 Y0 = mk8(p[0][2 * kk][0], p[0][2 * kk][1], p[0][2 * kk][2], p[0][2 * kk][3], p[0][2 * kk + 1][0], p[0][2 * kk + 1][1], p[0][2 * kk + 1][2], p[0][2 * kk + 1][3]);
        const bf16x8 Y1 = mk8(p[1][2 * kk][0], p[1][2 * kk][1], p[1][2 * kk][2], p[1][2 * kk][3], p[1][2 * kk + 1][0], p[1][2 * kk + 1][1], p[1][2 * kk + 1][2], p[1][2 * kk + 1][3]);
#pragma unroll
        for (int dt = 0; dt < 8; ++dt) { const bf16x8 X = lds8(Vb + (16 * dt + fr) * 72 + 32 * kk + 8 * fq); o[0][dt] = mfma16(X, Y0, o[0][dt]); o[1][dt] = mfma16(X, Y1, o[1][dt]); }
    }
}
__device__ __forceinline__ void at_online2(LAS unsigned char* lds, const bf16x8 (&qf)[2][4], float (&mrun)[2], float (&lrun)[2], f32x4 (&o)[2][8], const int (&lo)[2], const int (&hi)[2], const bool (&rowok)[2], bool fullvis, int wave, int fr, int fq, int bofs) {
    f32x4 sc[2][4];
    at_scores2(lds, qf, sc, fr, fq, bofs);
    float bm[2];
#pragma unroll
    for (int rt = 0; rt < 2; ++rt) {
        if (!fullvis) {
            const bool mok = hi[rt] >= lo[rt];
            const int moff = mok ? -lo[rt] : -100000; const unsigned mspan = mok ? (unsigned)(hi[rt] - lo[rt]) : 0u;
#pragma unroll
            for (int kt = 0; kt < 4; ++kt)
#pragma unroll
                for (int j = 0; j < 4; ++j) sc[rt][kt][j] = ((unsigned)(16 * kt + j + moff) <= mspan) ? sc[rt][kt][j] : -3.0e38f;
        }
        float b = -3.0e38f;
#pragma unroll
        for (int kt = 0; kt < 4; ++kt)
#pragma unroll
            for (int j = 0; j < 4; ++j) b = fmaxf(b, sc[rt][kt][j]);
        bm[rt] = b;
    }
    if (__any((bm[0] > mrun[0] + 6.0f) || (bm[1] > mrun[1] + 6.0f))) {
#pragma unroll
        for (int rt = 0; rt < 2; ++rt) {
            const float mnew = fmaxf(mrun[rt], xmax4(bm[rt])), mns = (mnew < -1.0e37f) ? 0.f : mnew;
            const float alpha = __builtin_amdgcn_exp2f(mrun[rt] - mns);
            lrun[rt] *= alpha; mrun[rt] = mnew;
#pragma unroll
            for (int dt = 0; dt < 8; ++dt) o[rt][dt] *= alpha;
        }
    }
#pragma unroll
    for (int rt = 0; rt < 2; ++rt) {
        const float mns = (mrun[rt] < -1.0e37f) ? 0.f : mrun[rt];
        const float mex = (fullvis && !rowok[rt]) ? 3.0e38f : mns;
        float ps = 0.f;
#pragma unroll
        for (int kt = 0; kt < 4; ++kt)
#pragma unroll
            for (int j = 0; j < 4; ++j) { const float e = __builtin_amdgcn_exp2f(sc[rt][kt][j] - mex); sc[rt][kt][j] = e; ps += e; }
        lrun[rt] += ps;
    }
    at_pv2(lds, sc, o, wave, fr, fq, bofs);
}

template <bool FIRST>
__device__ __forceinline__ void y_accum(bf16_t* yp0, bf16_t* yp1, const f32x4 (&o)[2][8], float s0, float s1) {
    u32x2 p[2][8];
    if (!FIRST) {
#pragma unroll
        for (int dt = 0; dt < 8; ++dt) { p[0][dt] = *(const u32x2*)(yp0 + 16 * dt); p[1][dt] = *(const u32x2*)(yp1 + 16 * dt); }
    }
#pragma unroll
    for (int rt = 0; rt < 2; ++rt) {
        bf16_t* yp = rt ? yp1 : yp0; const float scale = rt ? s1 : s0;
#pragma unroll
        for (int dt = 0; dt < 8; ++dt) {
            float a0 = o[rt][dt][0] * scale, a1 = o[rt][dt][1] * scale, a2 = o[rt][dt][2] * scale, a3 = o[rt][dt][3] * scale;
            if (!FIRST) { a0 += bflo(p[rt][dt].x); a1 += bfhi(p[rt][dt].x); a2 += bflo(p[rt][dt].y); a3 += bfhi(p[rt][dt].y); }
            u32x2 v = {pack2(a0, a1), pack2(a2, a3)};
            *(u32x2*)(yp + 16 * dt) = v;
        }
    }
}

__device__ __forceinline__ void attn_item(const Params& P, LAS unsigned char* lds, int item) {
    const int tid = otid(), wave = tid >> 6, lane = tid & 63, fr = lane & 15, fq = lane >> 4;
    const bf16_t* BIG = (const bf16_t*)(P.ws + OFF_BIG); const bf16_t* VTG = (const bf16_t*)(P.ws + OFF_KT);
    const bf16_t* KC = (const bf16_t*)(P.ws + OFF_KCMP); const bf16_t* VC = (const bf16_t*)(P.ws + OFF_VCMPT);
    const float* GT = (const float*)(P.ws + OFF_GATES); bf16_t* Y = (bf16_t*)(P.ws + OFF_ABUF);
    LAS float* impW = (LAS float*)(lds + AT_IMP);
    LAS unsigned* selw = (LAS unsigned*)(lds + AT_SEL);
    const int kk_ = item >> 8, blk_ = item & 255, j_ = blk_ >> 3;
    const int qt = (kk_ & 1) ? 63 - j_ : j_, pair_ = ((blk_ & 7) << 1) + (kk_ >> 1), g = pair_ & 3, b = pair_ >> 2;
    const int t0 = qt * 64, tokb = b * 4096;
    const int head = g * 4 + (wave >> 1), qoff = 32 * (wave & 1);
    const int cur = qt;
    int pos[2]; pos[0] = t0 + qoff + fr; pos[1] = pos[0] + 16;
    bf16x8 qf[2][4];
#pragma unroll
    for (int rt = 0; rt < 2; ++rt)
#pragma unroll
        for (int ks = 0; ks < 4; ++ks) qf[rt][ks] = ld8(BIG + (size_t)(tokb + pos[rt]) * 5120 + head * 128 + 32 * ks + 8 * fq);
    KVRegs R;
    const bf16_t* kc0 = KC + (size_t)((b * 4 + g) * 256) * 128;
    const bf16_t* vc0 = VC + (size_t)((b * 4 + g) * 128) * 256;
    {
        int cmaxq[2]; cmaxq[0] = (pos[0] - 31) >> 4; cmaxq[1] = (pos[1] - 31) >> 4;
        float mx[2] = {-3.0e38f, -3.0e38f}, sum[2] = {0.f, 0.f};
        const int nblk = min(4, ((4 * qt + 2) >> 6) + 1);
        at_fetch(R, kc0, 128, vc0, 256, tid, false);
#pragma unroll 1
        for (int blk = 0; blk < nblk; ++blk) {
            __syncthreads();
            at_stage(lds, R, tid, false);
            __syncthreads();
            if (blk + 1 < nblk) at_fetch(R, kc0 + (size_t)(blk + 1) * 64 * 128, 128, vc0, 256, tid, false);
            else at_fetch(R, kc0, 128, vc0, 256, tid, true);
            f32x4 s4[2][4]; at_scores2(lds, qf, s4, fr, fq);
#pragma unroll
            for (int rt = 0; rt < 2; ++rt) {
                const int lim = cmaxq[rt] - 64 * blk - 4 * fq;
                float bm = -3.0e38f;
#pragma unroll
                for (int kt = 0; kt < 4; ++kt)
#pragma unroll
                    for (int j = 0; j < 4; ++j) { const float s = (16 * kt + j <= lim) ? s4[rt][kt][j] : -3.0e38f; s4[rt][kt][j] = s; bm = fmaxf(bm, s); }
                bm = xmax4(bm);
                const float mnew = fmaxf(mx[rt], bm), mns = (mnew < -1.0e37f) ? 0.f : mnew;
                float ps = 0.f;
#pragma unroll
                for (int kt = 0; kt < 4; ++kt)
#pragma unroll
                    for (int j = 0; j < 4; ++j) ps += __builtin_amdgcn_exp2f(s4[rt][kt][j] - mns);
                sum[rt] = sum[rt] * __builtin_amdgcn_exp2f(mx[rt] - mns) + ps; mx[rt] = mnew;
            }
        }
        float inv[2], mxs[2];
#pragma unroll
        for (int rt = 0; rt < 2; ++rt) {
            const float s = xsum4(sum[rt]);
            inv[rt] = s > 0.f ? 1.0f / s : 0.f; mxs[rt] = (mx[rt] < -1.0e37f) ? 0.f : mx[rt];
        }
        f32x4 oc[2][8];
#pragma unroll
        for (int rt = 0; rt < 2; ++rt)
#pragma unroll
            for (int dt = 0; dt < 8; ++dt) oc[rt][dt] = (f32x4){0.f, 0.f, 0.f, 0.f};
        float eprev[2] = {0.f, 0.f};
        if (nblk < 4) {
            for (int r = 0; r < 32; ++r) { const int J = 16 * nblk + lane; if (J < 64) impW[(wave * 32 + r) * 64 + J] = 0.f; }
        }
#pragma unroll 1
        for (int blk = 0; blk < nblk; ++blk) {
            __syncthreads();
            at_stage(lds, R, tid, true);
            __syncthreads();
            if (blk + 1 < nblk) at_fetch(R, kc0 + (size_t)(blk + 1) * 64 * 128, 128, vc0 + (blk + 1) * 64, 256, tid, true);
            f32x4 s4[2][4]; at_scores2(lds, qf, s4, fr, fq);
#pragma unroll
            for (int rt = 0; rt < 2; ++rt) {
                const int lim = cmaxq[rt] - 64 * blk - 4 * fq;
#pragma unroll
                for (int kt = 0; kt < 4; ++kt) {
#pragma unroll
                    for (int j = 0; j < 4; ++j) s4[rt][kt][j] = (16 * kt + j <= lim) ? __builtin_amdgcn_exp2f(s4[rt][kt][j] - mxs[rt]) * inv[rt] : 0.f;
                    const float a = s4[rt][kt][0] + s4[rt][kt][1] + s4[rt][kt][2] + s4[rt][kt][3], e = 0.5f * s4[rt][kt][3];
                    const float src = (fq == 3) ? eprev[rt] : e;
                    const float got = __shfl(src, (lane + 48) & 63);
                    impW[(wave * 32 + 16 * rt + fr) * 64 + 16 * blk + 4 * kt + fq] = a - e + got;
                    eprev[rt] = e;
                }
            }
            at_pv2(lds, s4, oc, wave, fr, fq);
        }
        y_accum<true>(Y + (size_t)(tokb + pos[0]) * 2048 + head * 128 + 4 * fq, Y + (size_t)(tokb + pos[1]) * 2048 + head * 128 + 4 * fq, oc,
                      GT[(size_t)(tokb + pos[0]) * 48 + 0 * 16 + head], GT[(size_t)(tokb + pos[1]) * 48 + 0 * 16 + head]);
    }
    __syncthreads();
    {
#pragma unroll 1
        for (int i = 0; i < 8; ++i) {
            const int q = 8 * wave + i;
            float v = 0.f;
#pragma unroll
            for (int r = 0; r < 4; ++r) v += impW[((2 * r + (q >> 5)) * 32 + (q & 31)) * 64 + lane];
            const int J = lane;
            if (J == 0 || J == cur || J == cur - 1) v = 1.0e9f; else if (J > cur) v = -1.0e9f;
            int rank = 0;
            for (int o = 0; o < 64; ++o) { const float vo = __shfl(v, o); rank += (vo > v || (vo == v && o < J)) ? 1 : 0; }
            const unsigned long long mask = __ballot((rank < 16) && (J <= cur));
            if (lane == 0) { selw[2 * q] = (unsigned)mask; selw[2 * q + 1] = (unsigned)(mask >> 32); }
        }
    }
    __syncthreads();
    unsigned long long un = 0ull;
#pragma unroll 1
    for (int q = 0; q < 64; ++q) un |= ((unsigned long long)selw[2 * q + 1] << 32) | selw[2 * q];
    {
        unsigned long long mysel[2];
#pragma unroll
        for (int rt = 0; rt < 2; ++rt) mysel[rt] = ((unsigned long long)selw[2 * (qoff + 16 * rt + fr) + 1] << 32) | selw[2 * (qoff + 16 * rt + fr)];
        float mrun[2] = {-3.0e38f, -3.0e38f}, lrun[2] = {0.f, 0.f};
        f32x4 o[2][8];
#pragma unroll
        for (int rt = 0; rt < 2; ++rt)
#pragma unroll
            for (int dt = 0; dt < 8; ++dt) o[rt][dt] = (f32x4){0.f, 0.f, 0.f, 0.f};
        const bf16_t* kb = BIG + (size_t)tokb * 5120 + kv_col(1, 0, g);
        const bf16_t* vb = VTG + (size_t)(((b * 2 + 0) * 4 + g) * 128) * 4096;
        unsigned long long rem = un;
        int jb = __builtin_ctzll(rem); rem &= rem - 1;
        at_fetch(R, kb + (size_t)jb * 64 * 5120, 5120, vb + jb * 64, 4096, tid, true);
        __syncthreads();
        at_stage(lds, R, tid, true, 0);
        int jn = rem ? (int)__builtin_ctzll(rem) : -1;
        if (jn >= 0) at_fetch(R, kb + (size_t)jn * 64 * 5120, 5120, vb + jn * 64, 4096, tid, true);
        __syncthreads();
        int cb = 0;
#pragma unroll 1
        for (;;) {
            int jn2 = -1;
            if (jn >= 0) {
                at_stage(lds, R, tid, true, cb ? 0 : AT_IMP);
                rem &= rem - 1; jn2 = rem ? (int)__builtin_ctzll(rem) : -1;
                if (jn2 >= 0) at_fetch(R, kb + (size_t)jn2 * 64 * 5120, 5120, vb + jn2 * 64, 4096, tid, true);
            }
            int lo[2], hi[2]; bool rowok[2];
#pragma unroll
            for (int rt = 0; rt < 2; ++rt) { rowok[rt] = (mysel[rt] >> jb) & 1ull; lo[rt] = rowok[rt] ? 0 : 1000; hi[rt] = pos[rt] - 64 * jb - 4 * fq; }
            at_online2(lds, qf, mrun, lrun, o, lo, hi, rowok, jb < cur, wave, fr, fq, cb ? AT_IMP : 0);
            __syncthreads();
            if (jn < 0) break;
            jb = jn; jn = jn2; cb ^= 1;
        }
        {
            const float g0 = GT[(size_t)(tokb + pos[0]) * 48 + 1 * 16 + head], g1 = GT[(size_t)(tokb + pos[1]) * 48 + 1 * 16 + head];
            const float l0 = xsum4(lrun[0]), l1 = xsum4(lrun[1]);
            y_accum<false>(Y + (size_t)(tokb + pos[0]) * 2048 + head * 128 + 4 * fq, Y + (size_t)(tokb + pos[1]) * 2048 + head * 128 + 4 * fq, o,
                           l0 > 0.f ? g0 / l0 : 0.f, l1 > 0.f ? g1 / l1 : 0.f);
        }
    }
    {
        float mrun[2] = {-3.0e38f, -3.0e38f}, lrun[2] = {0.f, 0.f};
        f32x4 o[2][8];
#pragma unroll
        for (int rt = 0; rt < 2; ++rt)
#pragma unroll
            for (int dt = 0; dt < 8; ++dt) o[rt][dt] = (f32x4){0.f, 0.f, 0.f, 0.f};
        const bf16_t* kb = BIG + (size_t)tokb * 5120 + kv_col(2, 0, g);
        const bf16_t* vb = VTG + (size_t)(((b * 2 + 1) * 4 + g) * 128) * 4096;
        const int lo0 = t0 - 511, jlo = lo0 < 0 ? 0 : (lo0 >> 6);
        at_fetch(R, kb + (size_t)jlo * 64 * 5120, 5120, vb + jlo * 64, 4096, tid, true);
        at_stage(lds, R, tid, true, 0);
        if (jlo < cur) at_fetch(R, kb + (size_t)(jlo + 1) * 64 * 5120, 5120, vb + (jlo + 1) * 64, 4096, tid, true);
        __syncthreads();
        int cb = 0;
#pragma unroll 1
        for (int jb = jlo; jb <= cur; ++jb) {
            if (jb < cur) {
                at_stage(lds, R, tid, true, cb ? 0 : AT_IMP);
                if (jb + 1 < cur) at_fetch(R, kb + (size_t)(jb + 2) * 64 * 5120, 5120, vb + (jb + 2) * 64, 4096, tid, true);
            }
            int lo[2], hi[2]; bool rowok[2] = {true, true};
#pragma unroll
            for (int rt = 0; rt < 2; ++rt) { hi[rt] = pos[rt] - 64 * jb - 4 * fq; lo[rt] = hi[rt] - 511; }
            at_online2(lds, qf, mrun, lrun, o, lo, hi, rowok, (jb < cur) && (jb >= cur - 7), wave, fr, fq, cb ? AT_IMP : 0);
            __syncthreads();
            cb ^= 1;
        }
        {
            const float g0 = GT[(size_t)(tokb + pos[0]) * 48 + 2 * 16 + head], g1 = GT[(size_t)(tokb + pos[1]) * 48 + 2 * 16 + head];
            const float l0 = xsum4(lrun[0]), l1 = xsum4(lrun[1]);
            y_accum<false>(Y + (size_t)(tokb + pos[0]) * 2048 + head * 128 + 4 * fq, Y + (size_t)(tokb + pos[1]) * 2048 + head * 128 + 4 * fq, o,
                           l0 > 0.f ? g0 / l0 : 0.f, l1 > 0.f ? g1 / l1 : 0.f);
        }
    }
    __syncthreads();
}
__device__ __forceinline__ void phase_attn(const Params& P, LAS unsigned char* lds) {
    for (int it = blockIdx.x; it < 1024; it += gridDim.x) attn_item(P, lds, it);
}


#ifndef FBAR_SLEEP
#define FBAR_SLEEP 127
#endif
#ifndef FBAR_SLEEP2
#define FBAR_SLEEP2 0
#endif
constexpr int N_PHASES = 25;
constexpr int LDS_BYTES = 139264;

template <class Epi>
__device__ __forceinline__ void run_gemm(LAS unsigned char* lds, const bf16_t* A, const bf16_t* Bt, int N, int K, const Epi& E) {
    pg8::Gemm g{A, Bt, MTOK, N, K};
    pg8::StaticOrder S; S.init(MTOK, N, (int)gridDim.x, (int)blockIdx.x);
    pg8::gemm_phase<Epi, pg8::StaticOrder, false>((PG8_LAS unsigned char*)lds, g, S, E, nullptr);
}

__device__ __forceinline__ unsigned xbar_setup(unsigned char* ws) {
    const unsigned* slot = (const unsigned*)(ws + OFF_XB);
    const int lane = threadIdx.x & 63;
    const unsigned mine = __hip_atomic_load(slot + blockIdx.x, __ATOMIC_RELAXED, __HIP_MEMORY_SCOPE_AGENT) & 0xFu;
    unsigned nx = 0, seen = 0;
    for (unsigned i = lane; i < gridDim.x; i += 64) { const unsigned x = __hip_atomic_load(slot + i, __ATOMIC_RELAXED, __HIP_MEMORY_SCOPE_AGENT) & 0xFu; nx += (x == mine) ? 1u : 0u; seen |= 1u << x; }
#pragma unroll
    for (int o = 32; o; o >>= 1) { nx += __shfl_xor(nx, o); seen |= __shfl_xor(seen, o); }
    return mine | (nx << 4) | ((unsigned)__builtin_popcount(seen) << 16);
}
__device__ __forceinline__ void xbar_sync(unsigned char* ws, LAS unsigned char* lds, unsigned k) {
    __syncthreads();
    if (threadIdx.x == 0) {
        const unsigned info = *(const LAS unsigned*)(lds + 139008);
        unsigned* sub = (unsigned*)(ws + OFF_XB + 1024 + 256 * (info & 0xFu)); unsigned* top = (unsigned*)(ws + OFF_XB + 1024 + 256 * 16);
        const unsigned nx = (info >> 4) & 0xFFFu, nxcc = info >> 16;
        const unsigned old = __hip_atomic_fetch_add(sub, 1u, __ATOMIC_RELAXED, __HIP_MEMORY_SCOPE_AGENT);
        if (old + 1u == nx * k) {
            __builtin_amdgcn_fence(__ATOMIC_RELEASE, "agent");
            asm volatile("s_waitcnt vmcnt(0)" ::: "memory");
            __hip_atomic_fetch_add(top, 1u, __ATOMIC_RELAXED, __HIP_MEMORY_SCOPE_AGENT);
        }
        const unsigned want = nxcc * k;
        unsigned spins = 0;
        while (__hip_atomic_load(top, __ATOMIC_RELAXED, __HIP_MEMORY_SCOPE_AGENT) < want && ++spins < (1u << 21)) __builtin_amdgcn_s_sleep(FBAR_SLEEP);
        __builtin_amdgcn_fence(__ATOMIC_ACQUIRE, "agent");
        asm volatile("s_waitcnt vmcnt(0)" ::: "memory");
    }
    __syncthreads();
}

__device__ __forceinline__ int stage_rstd(LAS unsigned char* lds, const float* SS, int N) {
    pg8::StaticOrder S; S.init(MTOK, N, (int)gridDim.x, (int)blockIdx.x);
    Unit u0; if (!S.next(0, u0)) u0.pm = 0;
    LAS float* l = (LAS float*)(lds + 131072);
    const int tid = otid();
    if (tid < 256) l[tid] = rsqrtf(SS[u0.pm * 256 + tid] * (1.0f / 2048.0f) + EPSN);
    __syncthreads();
    return u0.pm;
}

__global__ void __launch_bounds__(512, 2) mega(Params P) {
    extern __shared__ __attribute__((aligned(16))) unsigned char shm[];
    LAS unsigned char* lds = (LAS unsigned char*)shm;
    cg::grid_group grid = cg::this_grid();
    unsigned char* ws = P.ws;
    bf16_t* ABUF = (bf16_t*)(ws + OFF_ABUF); bf16_t* BIG = (bf16_t*)(ws + OFF_BIG);
    float* H = P.out;
    unsigned xk = 0;
    for (int ph = P.ph_lo; ph < P.ph_hi; ++ph) {
        int f = -1, sub = -1;
        if (ph >= 1 && ph <= 3) { f = 0; sub = ph - 1; }
        else if (ph >= 10 && ph <= 12) { f = 1; sub = ph - 10; }
        else if (ph >= 13 && ph <= 15) { f = 2; sub = ph - 13; }
        else if (ph >= 21 && ph <= 23) { f = 3; sub = ph - 21; }
        int reps = 1;
#ifdef PROBE_REPS
        if (ph == 0) reps += REP_PREP;
        if (ph == 7) reps += REP_ML;
        if (ph == 18 || ph == 19) reps += REP_AT;
        if (sub == 1 || ph == 5 || ph == 17) reps += REP_GEMM;
        if (ph == 6 || ph == 8) reps += REP_L0X;
#ifdef REP_DOWN3
        if (ph == 23) reps += REP_DOWN3;
#endif
#endif
        if (sub == 0 || ph == 4 || ph == 16) continue;
        float* SSQ = (float*)(ws + OFF_SS); bf16_t* AUX1B = (bf16_t*)(ws + OFF_AUX1);
        for (int rep = 0; rep < reps; ++rep) {
        if (rep) grid.sync();
        if (ph == 0) phase_prep(P, lds);
        else if (f >= 0) {
            if (sub == 1) {
                const int si = (f == 0) ? 0 : (f == 1) ? 2 : (f == 2) ? 3 : 5;
                const int pm0 = stage_rstd(lds, SSQ + (size_t)si * MTOK, 11264);
                EpiSwiGLU E{BIG, SSQ + (size_t)si * MTOK, (const LAS float*)(lds + 131072), pm0};
                run_gemm(lds, (f == 1 || f == 3) ? AUX1B : ABUF, (const bf16_t*)(ws + OFF_WGU + f * SZ_GU), 11264, 2048, E);
            } else {
                const int so = (f == 0) ? 1 : (f == 1) ? 3 : 4;
                if (f == 3) { EpiResid<false> E{H, H, nullptr, nullptr, 0.5f / (float)reps}; run_gemm(lds, BIG, (const bf16_t*)(ws + OFF_WDN + f * SZ_DN), 2048, 5632, E); }
                else { EpiResid<true> E{f == 0 ? P.in[0] : H, H, ABUF, SSQ + (size_t)so * MTOK, 0.5f}; run_gemm(lds, BIG, (const bf16_t*)(ws + OFF_WDN + f * SZ_DN), 2048, 5632, E); }
            }
        }
        else if (ph == 5) {
            phase_skinny<1, 0>(lds, ABUF, (const bf16_t*)(ws + OFF_WABIN) + (size_t)6144 * 2048, (float*)(ws + OFF_GATES), P.in[7], SSQ + (size_t)1 * MTOK);
            const int pm0 = stage_rstd(lds, SSQ + (size_t)1 * MTOK, 6144);
            EpiProj0 E{BIG, SSQ + (size_t)1 * MTOK, (const LAS float*)(lds + 131072), pm0}; run_gemm(lds, ABUF, (const bf16_t*)(ws + OFF_WABIN), 6144, 2048, E);
        }
        else if (ph == 6) phase_conv_gmlp(P, lds);
        else if (ph == 7) phase_mlstm(P, lds);
        else if (ph == 8) phase_htnorm(P);
        else if (ph == 9) { EpiResid<true> E{H, H, AUX1B, SSQ + (size_t)2 * MTOK, 1.0f}; run_gemm(lds, ABUF, (const bf16_t*)(ws + OFF_WABOUT), 2048, 2048, E); }
        else if (ph == 17) {
            phase_skinny<3, 1>(lds, ABUF, (const bf16_t*)(ws + OFF_WNSAIN) + (size_t)5120 * 2048, (float*)(ws + OFF_GATES), nullptr, SSQ + (size_t)4 * MTOK);
            const int pm0 = stage_rstd(lds, SSQ + (size_t)4 * MTOK, 5120);
            EpiProj1 E{BIG, (const float*)(ws + OFF_ROPE), SSQ + (size_t)4 * MTOK, (const LAS float*)(lds + 131072), pm0}; run_gemm(lds, ABUF, (const bf16_t*)(ws + OFF_WNSAIN), 5120, 2048, E);
        }
        else if (ph == 18) phase_compress(P, lds);
        else if (ph == 19) phase_attn(P, lds);
        else if (ph == 20) { EpiResid<true> E{H, H, AUX1B, SSQ + (size_t)5 * MTOK, 1.0f}; run_gemm(lds, ABUF, (const bf16_t*)(ws + OFF_WNSAOUT), 2048, 2048, E); }
        else if (ph == 24) phase_final_norm(H, P.in[19]);
        }
#ifdef FBAR_SLEEP
        if (ph + 1 < P.ph_hi) { if (ph == 0) { grid.sync(); if (threadIdx.x < 64) { const unsigned xi = xbar_setup(ws); if (threadIdx.x == 0) *(LAS unsigned*)(lds + 139008) = xi; } } else { ++xk; xbar_sync(ws, lds, xk); } }
#else
        if (ph + 1 < P.ph_hi) grid.sync();
#endif
#ifdef PROBE_SYNCS
        if (ph == 5) { for (int i = 0; i < PROBE_SYNCS; ++i) grid.sync(); }
#endif
    }
}

extern "C" void kernel_launch(void* const* d_in, const int* in_sizes, int n_in, void* d_out, int out_size, void* d_ws, size_t ws_size, hipStream_t stream) {
    static int grid = 0;
    if (grid == 0) {
        if (n_in != 20 || out_size != MTOK * DM || ws_size < WS_END) { fprintf(stderr, "kernel_launch: unexpected shapes (n_in %d out %d ws %zu need %zu)\n", n_in, out_size, ws_size, (size_t)WS_END); grid = -1; return; }
        int dev = 0, cus = 0, per_cu = 0;
        hipGetDevice(&dev);
        hipDeviceGetAttribute(&cus, hipDeviceAttributeMultiprocessorCount, dev);
        if (hipFuncSetAttribute((const void*)mega, hipFuncAttributeMaxDynamicSharedMemorySize, LDS_BYTES) != hipSuccess) { fprintf(stderr, "kernel_launch: hipFuncSetAttribute failed\n"); grid = -1; return; }
        if (hipOccupancyMaxActiveBlocksPerMultiprocessor(&per_cu, (const void*)mega, 512, LDS_BYTES) != hipSuccess || per_cu < 1) { fprintf(stderr, "kernel_launch: occupancy query says %d\n", per_cu); per_cu = 1; }
        (void)hipGetLastError();
        grid = cus * per_cu;
        if (grid > 256) grid = 256;
    }
    if (grid < 0) return;
    Params p{};
    for (int i = 0; i < 20; ++i) p.in[i] = (const float*)d_in[i];
    p.out = (float*)d_out; p.ws = (unsigned char*)d_ws;
#ifndef MULTI_LAUNCH
    p.ph_lo = 0; p.ph_hi = N_PHASES;
    void* args[] = {&p};
    hipError_t e = hipLaunchCooperativeKernel((const void*)mega, dim3(grid), dim3(512), args, LDS_BYTES, stream);
    if (e != hipSuccess) fprintf(stderr, "cooperative launch failed: %s (grid %d)\n", hipGetErrorString(e), grid);
#else
    for (int ph = 0; ph < N_PHASES; ++ph) {
        p.ph_lo = ph; p.ph_hi = ph + 1;
        void* args[] = {&p};
        hipError_t e = hipLaunchCooperativeKernel((const void*)mega, dim3(grid), dim3(512), args, LDS_BYTES, stream);
        if (e != hipSuccess) { fprintf(stderr, "launch %d failed: %s\n", ph, hipGetErrorString(e)); break; }
    }
#endif
}
```
